# Optimizing an MI355X kernel written in HIP

```python
import jax, jax.numpy as jnp
from jax import lax
import numpy as np

D_MODEL = 2048
BATCH = 4
SEQ = 2048
DEPTH = 4
DEC_BATCH = 8
DEC_SEQ = 16
PAST_LEN = 4096

CHUNK = 64
HEAD_DIM = 64
D_MIX = D_MODEL
SWA_WIDTH = D_MIX // 4
SWA_HEADS = SWA_WIDTH // HEAD_DIM
SWA_KV_HEADS = SWA_HEADS // 4
SWA_GROUP = SWA_HEADS // SWA_KV_HEADS
SWA_KV_WIDTH = SWA_KV_HEADS * HEAD_DIM
WINDOW = 128
SWA_PREV_CHUNKS = WINDOW // CHUNK
D_LRU = D_MIX // 2
LRU_BLOCK_W = 64
LRU_BLOCKS = D_LRU // LRU_BLOCK_W
LRU_C = 8.0
CONV_WIDTH = 4
BAND_WIDTH = D_MIX - SWA_WIDTH - D_LRU
BAND_HEADS = BAND_WIDTH // HEAD_DIM
BAND_PREV_CHUNKS = 8
BAND_REACH = BAND_PREV_CHUNKS * CHUNK
REL_CLIP = 128
D_FF = 4 * D_MODEL
N_MOD = 6
RMS_EPS = 1e-6
NEG_INF = -1e30
PROJ_SIZES = (SWA_WIDTH, SWA_KV_WIDTH, SWA_KV_WIDTH, D_LRU, D_LRU, BAND_WIDTH, BAND_WIDTH, BAND_WIDTH)
D_IN = sum(PROJ_SIZES)
PROJ_SPLITS = tuple(int(s) for s in np.cumsum(PROJ_SIZES)[:-1])

kernel_name = 'hybrid_stream_encoder_step'


def rmsnorm(x, g):
    xf = x.astype(jnp.float32)
    y = xf * lax.rsqrt(jnp.mean(xf * xf, axis=-1, keepdims=True) + RMS_EPS)
    return (y * g.astype(jnp.float32)).astype(x.dtype)


def ada_mod(c, w_mod, b_mod):
    m = (jax.nn.silu(c) @ w_mod + b_mod).reshape(c.shape[0], N_MOD, 1, D_MODEL)
    return [m[:, j] for j in range(N_MOD)]


def mixer_input(x, shift, scale, g_pre, w_in):
    return (rmsnorm(x, g_pre) * (1 + scale) + shift) @ w_in


def split_proj(z):
    b, t = z.shape[:2]
    qa, ka, va, xb, gb, qc, kc, vc = jnp.split(z, PROJ_SPLITS, axis=-1)
    return (qa.reshape(b, t, SWA_KV_HEADS, SWA_GROUP, HEAD_DIM),
            ka.reshape(b, t, SWA_KV_HEADS, HEAD_DIM),
            va.reshape(b, t, SWA_KV_HEADS, HEAD_DIM),
            xb, gb,
            qc.reshape(b, t, BAND_HEADS, 1, HEAD_DIM),
            kc.reshape(b, t, BAND_HEADS, HEAD_DIM),
            vc.reshape(b, t, BAND_HEADS, HEAD_DIM))


def attend(q, k, v, bias, sink):
    s = jnp.einsum('bnqhgd,bnkhd->bnhgqk', q, k).astype(jnp.float32) * (HEAD_DIM ** -0.5)
    if bias is not None:
        s = s + bias.astype(jnp.float32)
    if sink is not None:
        sink_col = jnp.broadcast_to(sink.astype(jnp.float32)[:, :, None, None], s.shape[:-1] + (1,))
        p = jax.nn.softmax(jnp.concatenate([s, sink_col], axis=-1), axis=-1)[..., :-1]
    else:
        p = jax.nn.softmax(s, axis=-1)
    return jnp.einsum('bnhgqk,bnkhd->bnqhgd', p.astype(v.dtype), v)


def band_gather(t, n_prev):
    T = t.shape[1]
    pad = n_prev * CHUNK
    tp = jnp.pad(t, ((0, 0), (pad, 0)) + ((0, 0),) * (t.ndim - 2))
    idx = (jnp.arange(T // CHUNK) * CHUNK)[:, None] + jnp.arange(pad + CHUNK)[None, :]
    return tp[:, idx], idx >= pad


def chunk_queries(q):
    b, t = q.shape[:2]
    return q.reshape((b, t // CHUNK, CHUNK) + q.shape[2:])


def rel_bias(table, n_q, n_k, offset):
    d = jnp.arange(n_q)[:, None] + offset - jnp.arange(n_k)[None, :]
    return table[:, jnp.clip(d, -REL_CLIP, REL_CLIP) + REL_CLIP]


def swa_prompt(q, k, v, sink):
    b, t = q.shape[:2]
    kb, valid = band_gather(k, SWA_PREV_CHUNKS)
    vb, _ = band_gather(v, SWA_PREV_CHUNKS)
    mask = jnp.where(valid, 0.0, NEG_INF)[None, :, None, None, None, :]
    return attend(chunk_queries(q), kb, vb, mask, sink).reshape(b, t, SWA_WIDTH)


def swa_sample(q, k, v, ck, cv, sink):
    b, t = q.shape[:2]
    kk = jnp.concatenate([ck.astype(k.dtype), k], axis=1)[:, None]
    vv = jnp.concatenate([cv.astype(v.dtype), v], axis=1)[:, None]
    return attend(q[:, None], kk, vv, None, sink).reshape(b, t, SWA_WIDTH)


def band_prompt(q, k, v, table):
    b, t = q.shape[:2]
    kb, valid = band_gather(k, BAND_PREV_CHUNKS)
    vb, _ = band_gather(v, BAND_PREV_CHUNKS)
    mask = jnp.where(valid, 0.0, NEG_INF)[None, :, None, None, None, :]
    rb = rel_bias(table, CHUNK, BAND_REACH + CHUNK, BAND_REACH).astype(jnp.float32)[None, None, :, None]
    return attend(chunk_queries(q), kb, vb, rb + mask, None).reshape(b, t, BAND_WIDTH)


def band_sample(q, k, v, ck, cv, table):
    b, t = q.shape[:2]
    n_past = ck.shape[1]
    kk = jnp.concatenate([ck.astype(k.dtype), k], axis=1)[:, None]
    vv = jnp.concatenate([cv.astype(v.dtype), v], axis=1)[:, None]
    rb = rel_bias(table, t, n_past + t, n_past)[None, None, :, None]
    return attend(q[:, None], kk, vv, rb, None).reshape(b, t, BAND_WIDTH)


def lru_combine(left, right):
    a1, u1 = left
    a2, u2 = right
    return a1 * a2, a2 * u1 + u2


def rg_lru(xb, gb, conv_prefix, h0, conv_w, conv_b, w_r, b_r, w_i, b_i, lam):
    b, t, d = xb.shape
    x_ext = jnp.concatenate([conv_prefix.astype(xb.dtype), xb], axis=1)
    xc = conv_b
    for j in range(CONV_WIDTH):
        xc = xc + conv_w[j] * x_ext[:, j:j + t]
    xg = xc.reshape(b, t, LRU_BLOCKS, LRU_BLOCK_W)
    r = jax.nn.sigmoid((jnp.einsum('btnc,ncd->btnd', xg, w_r) + b_r).astype(jnp.float32)).reshape(b, t, d)
    i = jax.nn.sigmoid((jnp.einsum('btnc,ncd->btnd', xg, w_i) + b_i).astype(jnp.float32)).reshape(b, t, d)
    log_a = -LRU_C * r * jax.nn.softplus(-lam.astype(jnp.float32))
    a = jnp.exp(log_a)
    u = jnp.sqrt(-jnp.expm1(2.0 * log_a)) * (i * xc.astype(jnp.float32))
    u = u.at[:, 0].add(a[:, 0] * h0.astype(jnp.float32))
    _, h = lax.associative_scan(lru_combine, (a, u), axis=1)
    y = h.astype(xb.dtype) * jax.nn.gelu(gb)
    return y, h[:, -1].astype(xb.dtype), x_ext[:, -(CONV_WIDTH - 1):]


def finish_layer(x, mixed, gate_a, shift_m, scale_m, gate_m, w_out, g_post_mix, g_pre_mlp, w_up, w_down, g_post_mlp):
    x = x + gate_a * rmsnorm(mixed @ w_out, g_post_mix)
    h = rmsnorm(x, g_pre_mlp) * (1 + scale_m) + shift_m
    f = jnp.square(jax.nn.relu(h @ w_up)) @ w_down
    return x + gate_m * rmsnorm(f, g_post_mlp)


def setup_inputs(seed: int = 0) -> dict:
    key = jax.random.key(seed)
    ks = jax.random.split(key, 32)
    f32 = jnp.float32

    def nrm(k, shape, s):
        return s * jax.random.normal(k, shape, f32)

    swa_len = min(WINDOW, PAST_LEN)
    band_len = min(BAND_REACH, PAST_LEN)
    a_pow = jax.random.uniform(ks[21], (DEPTH, D_LRU), f32, 0.9, 0.999)
    a_base = a_pow ** (1.0 / LRU_C)
    lam = jnp.log(a_base) - jnp.log1p(-a_base)
    return {
        'x_prompt': nrm(ks[0], (BATCH, SEQ, D_MODEL), 1.0),
        'x_sample': nrm(ks[1], (DEC_BATCH, DEC_SEQ, D_MODEL), 1.0),
        'c_prompt': nrm(ks[2], (BATCH, D_MODEL), 1.0),
        'c_sample': nrm(ks[3], (DEC_BATCH, D_MODEL), 1.0),
        'cache_swa_k': nrm(ks[4], (DEPTH, DEC_BATCH, swa_len, SWA_KV_HEADS, HEAD_DIM), 1.0),
        'cache_swa_v': nrm(ks[5], (DEPTH, DEC_BATCH, swa_len, SWA_KV_HEADS, HEAD_DIM), 1.0),
        'cache_band_k': nrm(ks[6], (DEPTH, DEC_BATCH, band_len, BAND_HEADS, HEAD_DIM), 1.0),
        'cache_band_v': nrm(ks[7], (DEPTH, DEC_BATCH, band_len, BAND_HEADS, HEAD_DIM), 1.0),
        'state_lru_h': nrm(ks[8], (DEPTH, DEC_BATCH, D_LRU), 0.5),
        'state_lru_conv': nrm(ks[9], (DEPTH, DEC_BATCH, CONV_WIDTH - 1, D_LRU), 1.0),
        'w_mod': nrm(ks[10], (DEPTH, D_MODEL, N_MOD * D_MODEL), 0.5 * D_MODEL ** -0.5),
        'b_mod': nrm(ks[11], (DEPTH, N_MOD * D_MODEL), 0.01),
        'g_pre_mix': 1.0 + nrm(ks[12], (DEPTH, D_MODEL), 0.05),
        'w_in': nrm(ks[13], (DEPTH, D_MODEL, D_IN), D_MODEL ** -0.5),
        'swa_sink': nrm(ks[14], (DEPTH, SWA_HEADS), 0.5),
        'lru_conv_w': nrm(ks[15], (DEPTH, CONV_WIDTH, D_LRU), CONV_WIDTH ** -0.5),
        'lru_conv_b': nrm(ks[16], (DEPTH, D_LRU), 0.01),
        'lru_w_r': nrm(ks[17], (DEPTH, LRU_BLOCKS, LRU_BLOCK_W, LRU_BLOCK_W), LRU_BLOCK_W ** -0.5),
        'lru_b_r': nrm(ks[18], (DEPTH, LRU_BLOCKS, LRU_BLOCK_W), 0.01),
        'lru_w_i': nrm(ks[19], (DEPTH, LRU_BLOCKS, LRU_BLOCK_W, LRU_BLOCK_W), LRU_BLOCK_W ** -0.5),
        'lru_b_i': nrm(ks[20], (DEPTH, LRU_BLOCKS, LRU_BLOCK_W), 0.01),
        'lru_lambda': lam,
        'band_rel_bias': nrm(ks[22], (DEPTH, BAND_HEADS, 2 * REL_CLIP + 1), 0.1),
        'w_out': nrm(ks[23], (DEPTH, D_MIX, D_MODEL), D_MIX ** -0.5),
        'g_post_mix': 1.0 + nrm(ks[24], (DEPTH, D_MODEL), 0.05),
        'g_pre_mlp': 1.0 + nrm(ks[25], (DEPTH, D_MODEL), 0.05),
        'w_up': nrm(ks[26], (DEPTH, D_MODEL, D_FF), D_MODEL ** -0.5),
        'w_down': nrm(ks[27], (DEPTH, D_FF, D_MODEL), D_FF ** -0.5),
        'g_post_mlp': 1.0 + nrm(ks[28], (DEPTH, D_MODEL), 0.05),
    }


def reference(x_prompt, x_sample, c_prompt, c_sample, cache_swa_k, cache_swa_v, cache_band_k, cache_band_v,
              state_lru_h, state_lru_conv, w_mod, b_mod, g_pre_mix, w_in, swa_sink, lru_conv_w, lru_conv_b,
              lru_w_r, lru_b_r, lru_w_i, lru_b_i, lru_lambda, band_rel_bias, w_out, g_post_mix, g_pre_mlp,
              w_up, w_down, g_post_mlp):
    xp, xs = x_prompt, x_sample
    bp, tp = xp.shape[:2]
    swa_keep = min(WINDOW, tp)
    band_keep = min(BAND_REACH, tp)
    swa_kp, swa_vp, band_kp, band_vp, lru_hp, lru_cp = [], [], [], [], [], []
    swa_ks, swa_vs, band_ks, band_vs, lru_hs, lru_cs = [], [], [], [], [], []
    for l in range(DEPTH):
        sink = swa_sink[l].reshape(SWA_KV_HEADS, SWA_GROUP)
        lru_w = (lru_conv_w[l], lru_conv_b[l], lru_w_r[l], lru_b_r[l], lru_w_i[l], lru_b_i[l], lru_lambda[l])
        post_w = (w_out[l], g_post_mix[l], g_pre_mlp[l], w_up[l], w_down[l], g_post_mlp[l])

        sa, sc, ga, sm, scm, gm = ada_mod(c_prompt, w_mod[l], b_mod[l])
        qa, ka, va, xb, gb, qc, kc, vc = split_proj(mixer_input(xp, sa, sc, g_pre_mix[l], w_in[l]))
        oa = swa_prompt(qa, ka, va, sink)
        ob, h_last, conv_last = rg_lru(xb, gb, jnp.zeros((bp, CONV_WIDTH - 1, D_LRU), xb.dtype),
                                       jnp.zeros((bp, D_LRU), xb.dtype), *lru_w)
        oc = band_prompt(qc, kc, vc, band_rel_bias[l])
        xp = finish_layer(xp, jnp.concatenate([oa, ob, oc], axis=-1), ga, sm, scm, gm, *post_w)
        swa_kp.append(ka[:, tp - swa_keep:])
        swa_vp.append(va[:, tp - swa_keep:])
        band_kp.append(kc[:, tp - band_keep:])
        band_vp.append(vc[:, tp - band_keep:])
        lru_hp.append(h_last)
        lru_cp.append(conv_last)

        sa, sc, ga, sm, scm, gm = ada_mod(c_sample, w_mod[l], b_mod[l])
        qa, ka, va, xb, gb, qc, kc, vc = split_proj(mixer_input(xs, sa, sc, g_pre_mix[l], w_in[l]))
        oa = swa_sample(qa, ka, va, cache_swa_k[l], cache_swa_v[l], sink)
        ob, h_last, conv_last = rg_lru(xb, gb, state_lru_conv[l], state_lru_h[l], *lru_w)
        oc = band_sample(qc, kc, vc, cache_band_k[l], cache_band_v[l], band_rel_bias[l])
        xs = finish_layer(xs, jnp.concatenate([oa, ob, oc], axis=-1), ga, sm, scm, gm, *post_w)
        swa_ks.append(ka)
        swa_vs.append(va)
        band_ks.append(kc)
        band_vs.append(vc)
        lru_hs.append(h_last)
        lru_cs.append(conv_last)

    return (xp, xs,
            jnp.stack(swa_kp), jnp.stack(swa_vp), jnp.stack(band_kp), jnp.stack(band_vp),
            jnp.stack(lru_hp), jnp.stack(lru_cp),
            jnp.stack(swa_ks), jnp.stack(swa_vs), jnp.stack(band_ks), jnp.stack(band_vs),
            jnp.stack(lru_hs), jnp.stack(lru_cs))
```

```cpp
#include <hip/hip_runtime.h>
#include <cstdio>
#include <cstdint>
#include <cmath>
#define MK_SINGLE 0
namespace pg8 {
#define PG8_LAS __attribute__((address_space(3)))
typedef unsigned short bf16_t;
typedef short bf16x8 __attribute__((ext_vector_type(8)));
typedef float f32x4 __attribute__((ext_vector_type(4)));
typedef unsigned u32x4 __attribute__((ext_vector_type(4)));
constexpr int BM = 256, BK = 64, HALF = 128, HTB = HALF * BK * 2  , STAGE_BYTES = 8 * HTB, NXCD = 8, WGM = 8;

__host__ __device__ __forceinline__ int lds_byte(int r, int c) { const int st = (r >> 4) * 2 + (c >> 5), rr = r & 15, cc = c & 31, ob = rr * 64 + cc * 2; return st * 1024 + (ob ^ (((ob >> 9) & 1) << 5)); }
__host__ __device__ __forceinline__ void stage_rc(int b, int& R, int& C) { const int st = b / 1024, sb = b % 1024, swz = sb ^ (((sb >> 9) & 1) << 5); R = (st >> 1) * 16 + swz / 64; C = (st & 1) * 32 + (swz % 64) / 2; }
__host__ __device__ __forceinline__ int perm32(int rho) { const int n = rho >> 4, i = rho & 15; return 8 * (i >> 2) + 4 * n + (i & 3); }

struct Unit { int pm, pn; };
struct Gemm { const bf16_t* A; const bf16_t* Bt; int M, N, K; };

struct StaticOrder {
    int nM, nN, nwg, G, c;
    __host__ __device__ void init(int M, int N, int G_, int c_) { nM = M / BM; nN = N / BM; nwg = nM * nN; G = G_; c = c_; }
    __host__ __device__ bool next(int i, Unit& u) const {
        const long L = (long)i * G + c; if (L >= nwg) return false;
        int wgid = (int)L; { const int q = nwg / NXCD, r = nwg % NXCD, xcd = wgid % NXCD, off = wgid / NXCD; wgid = (xcd < r ? xcd * (q + 1) : r * (q + 1) + (xcd - r) * q) + off; }
        const int nig = WGM * nN, gid = wgid / nig, fm = gid * WGM, gsz = (nM - fm) < WGM ? (nM - fm) : WGM;
        u.pm = fm + ((wgid % nig) % gsz); u.pn = (wgid % nig) / gsz; return true;
    }
    __device__ __forceinline__ void a_ready(const Unit&) const {}
    __device__ __forceinline__ void done(const Unit&) const {}
};

__device__ __forceinline__ unsigned cvt_pk_bf16(float lo, float hi) { unsigned r; asm volatile("v_cvt_pk_bf16_f32 %0, %1, %2" : "=v"(r) : "v"(lo), "v"(hi)); return r; }
typedef float f32x2 __attribute__((ext_vector_type(2)));

constexpr int X_DM = 2048, X_MP = 8192, X_MS = 128, X_DIN = 4352, X_DFF = 8192, X_NL = 4;
constexpr size_t O_YP = 0, O_YS = O_YP + (size_t)X_MP * X_DM, O_SKP = O_YS + (size_t)X_MS * X_DM, O_SVP = O_SKP + (size_t)X_NL * 4 * 128 * 128,
                 O_BKP = O_SVP + (size_t)X_NL * 4 * 128 * 128, O_BVP = O_BKP + (size_t)X_NL * 4 * 512 * 512, O_LHP = O_BVP + (size_t)X_NL * 4 * 512 * 512,
                 O_LCP = O_LHP + (size_t)X_NL * 4 * 1024, O_SKS = O_LCP + (size_t)X_NL * 4 * 3 * 1024, O_SVS = O_SKS + (size_t)X_NL * 8 * 16 * 128,
                 O_BKS = O_SVS + (size_t)X_NL * 8 * 16 * 128, O_BVS = O_BKS + (size_t)X_NL * 8 * 16 * 512, O_LHS = O_BVS + (size_t)X_NL * 8 * 16 * 512,
                 O_LCS = O_LHS + (size_t)X_NL * 8 * 1024, O_END = O_LCS + (size_t)X_NL * 8 * 3 * 1024;

struct EpiF32 {
    static constexpr bool PERM = false, AFTER_DRAIN = false;
    float* C; int ldc;
    __device__ __forceinline__ void operator()(const f32x4 (&acc)[2][2][4][2], const Unit& u, int wr, int wc, int fr, int fq) const {
        const int row0 = u.pm * BM + wr * 64 + fr, col0 = u.pn * BM + wc * 32 + 4 * fq;
#pragma unroll
        for (int ai = 0; ai < 2; ++ai)
#pragma unroll
            for (int m = 0; m < 4; ++m) { float* rowp = C + (size_t)(row0 + ai * HALF + m * 16) * ldc + col0;
#pragma unroll
                for (int bj = 0; bj < 2; ++bj)
#pragma unroll
                    for (int n = 0; n < 2; ++n) *(f32x4*)(rowp + bj * HALF + n * 16) = acc[ai][bj][m][n]; }
    }
};
struct EpiRelu2 {
    static constexpr bool PERM = true, AFTER_DRAIN = false;
    bf16_t* O; int ldc;
    __device__ __forceinline__ void operator()(const f32x4 (&acc)[2][2][4][2], const Unit& u, int wr, int wc, int fr, int fq) const {
        const int row0 = u.pm * BM + wr * 64 + fr, col0 = u.pn * BM + wc * 32 + 8 * fq;
#pragma unroll
        for (int ai = 0; ai < 2; ++ai)
#pragma unroll
            for (int m = 0; m < 4; ++m) { bf16_t* rowp = O + (size_t)(row0 + ai * HALF + m * 16) * ldc + col0;
#pragma unroll
                for (int bj = 0; bj < 2; ++bj) { f32x4 v0 = acc[ai][bj][m][0], v1 = acc[ai][bj][m][1];
                    v0 = __builtin_elementwise_max(v0, (f32x4){0.f, 0.f, 0.f, 0.f}); v1 = __builtin_elementwise_max(v1, (f32x4){0.f, 0.f, 0.f, 0.f});
                    v0 = v0 * v0; v1 = v1 * v1;
                    u32x4 w; w.x = cvt_pk_bf16(v0[0], v0[1]); w.y = cvt_pk_bf16(v0[2], v0[3]); w.z = cvt_pk_bf16(v1[0], v1[1]); w.w = cvt_pk_bf16(v1[2], v1[3]);
                    *(u32x4*)(rowp + bj * HALF) = w; } }
    }
};
struct EpiInProj {
    static constexpr bool PERM = true, AFTER_DRAIN = false;
    bf16_t* Z; float* out; int layer;
    __device__ __forceinline__ void operator()(const f32x4 (&acc)[2][2][4][2], const Unit& u, int wr, int wc, int fr, int fq) const {
        const int row0 = u.pm * BM + wr * 64 + fr, col0 = u.pn * BM + wc * 32 + 8 * fq;
#pragma unroll
        for (int ai = 0; ai < 2; ++ai)
#pragma unroll
            for (int m = 0; m < 4; ++m) { bf16_t* rowp = Z + (size_t)(row0 + ai * HALF + m * 16) * X_DIN + col0;
#pragma unroll
                for (int bj = 0; bj < 2; ++bj) { const f32x4 v0 = acc[ai][bj][m][0], v1 = acc[ai][bj][m][1];
                    u32x4 w; w.x = cvt_pk_bf16(v0[0], v0[1]); w.y = cvt_pk_bf16(v0[2], v0[3]); w.z = cvt_pk_bf16(v1[0], v1[1]); w.w = cvt_pk_bf16(v1[2], v1[3]);
                    *(u32x4*)(rowp + bj * HALF) = w; } }
        const int pn = u.pn, pm = u.pm;
        const bool rows_state = (pm == 32) || ((pm & 7) >= 6);
        const bool cols_state = (pn >= 2 && pn <= 6) || (pn >= 13);
        if (rows_state && cols_state) {
            const int L = layer;
#pragma unroll
            for (int ai = 0; ai < 2; ++ai)
#pragma unroll
                for (int m = 0; m < 4; ++m) {
                    const int row = row0 + ai * HALF + m * 16;
                    const bool samp = row >= X_MP;
                    int b, t;
                    if (!samp) { b = row >> 11; t = row & 2047; } else { const int rs = row - X_MP; b = rs >> 4; t = rs & 15; }
                    const bool rowok = row < X_MP + X_MS;
#pragma unroll
                    for (int bj = 0; bj < 2; ++bj) {
                        const int col = col0 + bj * HALF;
                        float* dst = nullptr;
                        if (pn == 2) {
                            const int c = wc * 32 + 8 * fq;
                            if (!samp) { if (t >= 1920) dst = out + (bj ? O_SVP : O_SKP) + ((size_t)(L * 4 + b) * 128 + (t - 1920)) * 128 + c; }
                            else dst = out + (bj ? O_SVS : O_SKS) + ((size_t)(L * 8 + b) * 16 + t) * 128 + c;
                        } else if (pn <= 6) {
                            const int ch = col - 768;
                            if (!samp) { if (t >= 2045) dst = out + O_LCP + ((size_t)(L * 4 + b) * 3 + (t - 2045)) * 1024 + ch; }
                            else if (t >= 13) dst = out + O_LCS + ((size_t)(L * 8 + b) * 3 + (t - 13)) * 1024 + ch;
                        } else {
                            const bool isV = pn >= 15; const int c = col - (isV ? 3840 : 3328);
                            if (!samp) { if (t >= 1536) dst = out + (isV ? O_BVP : O_BKP) + ((size_t)(L * 4 + b) * 512 + (t - 1536)) * 512 + c; }
                            else dst = out + (isV ? O_BVS : O_BKS) + ((size_t)(L * 8 + b) * 16 + t) * 512 + c;
                        }
                        if (dst != nullptr && rowok) { *(f32x4*)dst = acc[ai][bj][m][0]; *(f32x4*)(dst + 4) = acc[ai][bj][m][1]; }
                    }
                }
        }
    }
};
template <class Epi, class Sched, bool ALIGN_EPI = false, bool SP2 = false>
__device__ __forceinline__ void gemm_phase(PG8_LAS unsigned char* lds, const Gemm g, const Sched& S, const Epi& E, int tid_in) {
    int tid_ = tid_in; asm volatile("" : "+v"(tid_));
    const int tid = tid_, wid = __builtin_amdgcn_readfirstlane(tid >> 6), lane = tid & 63, wr = wid >> 2, wc = wid & 3, fr = lane & 15, fq = lane >> 4;
    int K_ = g.K; asm volatile("" : "+s"(K_));
    const int K = K_, nt = K / BK;
    unsigned voffA[2], voffB[2];
#pragma unroll
    for (int i = 0; i < 2; ++i) { int R, C; stage_rc(tid * 16 + i * 8192, R, C); const int Rb = Epi::PERM ? ((R & ~31) + perm32(R & 31)) : R;
        voffA[i] = (unsigned)(R * K + C) * 2u; voffB[i] = (unsigned)(Rb * K + C) * 2u; }
    const size_t kstep = (size_t)(BK * 2);
    const size_t hstep = (size_t)HALF * K * 2;
    const size_t tstep = 2 * hstep;
    const unsigned ldsw = (unsigned)wid * 1024u;
    const int aoff = lds_byte(wr * 64 + fr, fq * 8), boff = lds_byte(wc * 32 + fr, fq * 8);
#define PG8_SA(b, h) (((b) * 2 + (h)) * HTB)
#define PG8_SB(b, h) ((4 + (b) * 2 + (h)) * HTB)
#define PG8_STAGE(bufoff, gbase, voff) do { _Pragma("unroll") for (int _i = 0; _i < 2; ++_i) \
        __builtin_amdgcn_global_load_lds((const unsigned*)((const char*)(gbase) + (voff)[_i]), (PG8_LAS unsigned*)(lds + (bufoff) + ldsw + _i * 8192), 16, 0, 0); } while (0)
#define PG8_LDA(dst, b, h) do { _Pragma("unroll") for (int m = 0; m < 4; ++m) _Pragma("unroll") for (int k = 0; k < 2; ++k) dst[m][k] = *(const PG8_LAS bf16x8*)(lds + PG8_SA(b, h) + aoff + m * 2048 + k * 1024); } while (0)
#define PG8_LDB(dst, b, h) do { _Pragma("unroll") for (int n = 0; n < 2; ++n) _Pragma("unroll") for (int k = 0; k < 2; ++k) dst[n][k] = *(const PG8_LAS bf16x8*)(lds + PG8_SB(b, h) + boff + n * 2048 + k * 1024); } while (0)
#define PG8_MMA(ai, bj, At, Bt) do { __builtin_amdgcn_s_setprio(1); _Pragma("unroll") for (int m = 0; m < 4; ++m) _Pragma("unroll") for (int n = 0; n < 2; ++n) _Pragma("unroll") for (int k = 0; k < 2; ++k) \
        acc[ai][bj][m][n] = __builtin_amdgcn_mfma_f32_16x16x32_bf16(Bt[n][k], At[m][k], acc[ai][bj][m][n], 0, 0, 0); __builtin_amdgcn_s_setprio(0); } while (0)
#define PG8_WAIT_V(n) asm volatile("s_waitcnt vmcnt(" #n ")" ::: "memory")
#define PG8_WAIT_L(n) asm volatile("s_waitcnt lgkmcnt(" #n ")" ::: "memory")
#define PG8_BAR __builtin_amdgcn_s_barrier()
#define PG8_SCHED __builtin_amdgcn_sched_barrier(0)
    Unit cur, nxt; int ui = 0;
    if (!S.next(0, cur)) return;
    f32x4 acc[2][2][4][2];
#pragma unroll
    for (int a = 0; a < 2; ++a)
#pragma unroll
        for (int b = 0; b < 2; ++b)
#pragma unroll
            for (int m = 0; m < 4; ++m)
#pragma unroll
                for (int n = 0; n < 2; ++n) acc[a][b][m][n] = (f32x4){0.f, 0.f, 0.f, 0.f};
    bf16x8 At[4][2], B0[2][2], B1[2][2];
    const char* cA = (const char*)g.A + (size_t)cur.pm * tstep; const char* cB = (const char*)g.Bt + (size_t)cur.pn * tstep;
    S.a_ready(cur);
    if constexpr (SP2) {
        PG8_STAGE(PG8_SB(0, 0), cB, voffB); PG8_STAGE(PG8_SB(0, 1), cB + hstep, voffB); PG8_STAGE(PG8_SA(0, 0), cA, voffA); PG8_STAGE(PG8_SA(0, 1), cA + hstep, voffA);
        if (wr == 1) PG8_BAR;
        PG8_WAIT_V(2); PG8_BAR;
        PG8_STAGE(PG8_SB(1, 0), cB + kstep, voffB); PG8_STAGE(PG8_SA(1, 0), cA + kstep, voffA); PG8_STAGE(PG8_SB(1, 1), cB + hstep + kstep, voffB);
        PG8_WAIT_V(6); PG8_BAR;
    } else {
        PG8_STAGE(PG8_SB(0, 0), cB, voffB); PG8_STAGE(PG8_SA(0, 0), cA, voffA); PG8_STAGE(PG8_SB(0, 1), cB + hstep, voffB); PG8_STAGE(PG8_SA(0, 1), cA + hstep, voffA);
        if (wr == 1) PG8_BAR;
        PG8_WAIT_V(4); PG8_BAR;
        PG8_STAGE(PG8_SB(1, 0), cB + kstep, voffB); PG8_STAGE(PG8_SA(1, 0), cA + kstep, voffA); PG8_STAGE(PG8_SB(1, 1), cB + hstep + kstep, voffB);
        PG8_WAIT_V(6); PG8_BAR;
    }
    for (;;) {
        const bool has_next = S.next(ui + 1, nxt);
        const char* nA = has_next ? (const char*)g.A + (size_t)nxt.pm * tstep : cA; const char* nB = has_next ? (const char*)g.Bt + (size_t)nxt.pn * tstep : cB;
        for (int t = 0; t < nt; t += 2) {
            const bool last = (t == nt - 2);
            const char* a1 = cA + (size_t)(t + 1) * kstep;
            const char* a2 = last ? nA : cA + (size_t)(t + 2) * kstep; const char* b2 = last ? nB : cB + (size_t)(t + 2) * kstep;
            const char* a3 = a2 + kstep; const char* b3 = b2 + kstep;
            if (last && has_next) S.a_ready(nxt);
            if constexpr (SP2) {
            PG8_LDB(B0, 0, 0); PG8_LDB(B1, 0, 1); PG8_SCHED; PG8_LDA(At, 0, 0); PG8_STAGE(PG8_SA(1, 1), a1 + hstep, voffA);
            PG8_WAIT_V(8); PG8_WAIT_L(0); PG8_BAR; PG8_MMA(0, 0, At, B0); PG8_MMA(0, 1, At, B1); PG8_BAR; PG8_SCHED;
            PG8_LDA(At, 0, 1); PG8_STAGE(PG8_SB(0, 0), b2, voffB); PG8_STAGE(PG8_SB(0, 1), b2 + hstep, voffB); PG8_STAGE(PG8_SA(0, 0), a2, voffA);
            PG8_WAIT_V(8); PG8_WAIT_L(0); PG8_BAR; PG8_MMA(1, 0, At, B0); PG8_MMA(1, 1, At, B1); PG8_BAR; PG8_SCHED;
            PG8_LDB(B0, 1, 0); PG8_LDB(B1, 1, 1); PG8_SCHED; PG8_LDA(At, 1, 0); PG8_STAGE(PG8_SA(0, 1), a2 + hstep, voffA);
            PG8_WAIT_V(8); PG8_WAIT_L(0); PG8_BAR; PG8_MMA(0, 0, At, B0); PG8_MMA(0, 1, At, B1); PG8_BAR; PG8_SCHED;
            PG8_LDA(At, 1, 1); PG8_STAGE(PG8_SB(1, 0), b3, voffB); PG8_STAGE(PG8_SB(1, 1), b3 + hstep, voffB); PG8_STAGE(PG8_SA(1, 0), a3, voffA);
            PG8_WAIT_V(8); PG8_WAIT_L(0); PG8_BAR; PG8_MMA(1, 0, At, B0); PG8_MMA(1, 1, At, B1); PG8_BAR; PG8_SCHED;
            } else {
            PG8_LDB(B0, 0, 0); PG8_SCHED; PG8_LDA(At, 0, 0); PG8_STAGE(PG8_SA(1, 1), a1 + hstep, voffA);
            PG8_WAIT_L(8); PG8_BAR; PG8_WAIT_L(0); PG8_MMA(0, 0, At, B0); PG8_BAR; PG8_SCHED;
            PG8_LDB(B1, 0, 1); PG8_STAGE(PG8_SB(0, 0), b2, voffB);
            PG8_BAR; PG8_WAIT_L(0); PG8_MMA(0, 1, At, B1); PG8_BAR;
            PG8_LDA(At, 0, 1); PG8_STAGE(PG8_SA(0, 0), a2, voffA);
            PG8_BAR; PG8_WAIT_L(0); PG8_MMA(1, 0, At, B0); PG8_BAR; PG8_SCHED;
            PG8_STAGE(PG8_SB(0, 1), b2 + hstep, voffB);
            PG8_WAIT_V(6); PG8_BAR; PG8_MMA(1, 1, At, B1); PG8_BAR;
            PG8_LDB(B0, 1, 0); PG8_SCHED; PG8_LDA(At, 1, 0); PG8_STAGE(PG8_SA(0, 1), a2 + hstep, voffA);
            PG8_WAIT_L(8); PG8_BAR; PG8_WAIT_L(0); PG8_MMA(0, 0, At, B0); PG8_BAR; PG8_SCHED;
            PG8_LDB(B1, 1, 1); PG8_STAGE(PG8_SB(1, 0), b3, voffB);
            PG8_BAR; PG8_WAIT_L(0); PG8_MMA(0, 1, At, B1); PG8_BAR;
            PG8_LDA(At, 1, 1); PG8_STAGE(PG8_SA(1, 0), a3, voffA);
            PG8_BAR; PG8_WAIT_L(0); PG8_MMA(1, 0, At, B0); PG8_BAR; PG8_SCHED;
            PG8_STAGE(PG8_SB(1, 1), b3 + hstep, voffB);
            PG8_WAIT_V(6); PG8_BAR; PG8_MMA(1, 1, At, B1); PG8_BAR;
            }
        }
        if constexpr (ALIGN_EPI) { if (wr == 0) PG8_BAR; }
        if constexpr (!Epi::AFTER_DRAIN) { E(acc, cur, wr, wc, fr, fq); S.done(cur); }
        if (!has_next) break;
#pragma unroll
        for (int a = 0; a < 2; ++a)
#pragma unroll
            for (int b = 0; b < 2; ++b)
#pragma unroll
                for (int m = 0; m < 4; ++m)
#pragma unroll
                    for (int n = 0; n < 2; ++n) acc[a][b][m][n] = (f32x4){0.f, 0.f, 0.f, 0.f};
        cur = nxt; cA = nA; cB = nB; ++ui;
        if constexpr (ALIGN_EPI) { if (wr == 1) PG8_BAR; }
    }
    PG8_WAIT_V(0);
    if constexpr (!ALIGN_EPI) { if (wr == 0) PG8_BAR; }
    PG8_BAR;
    if constexpr (Epi::AFTER_DRAIN) { E.fused(acc, cur, wr, wc, fr, fq, lds, wid, lane); S.done(cur); }
#undef PG8_SA
#undef PG8_SB
#undef PG8_STAGE
#undef PG8_LDA
#undef PG8_LDB
#undef PG8_MMA
#undef PG8_WAIT_V
#undef PG8_WAIT_L
#undef PG8_BAR
#undef PG8_SCHED
}
}
#define GAS __attribute__((address_space(1)))
#define LAS __attribute__((address_space(3)))
typedef unsigned short bf16;
typedef unsigned v4u __attribute__((ext_vector_type(4)));
typedef float f32x4 __attribute__((ext_vector_type(4)));
typedef short bf16x8 __attribute__((ext_vector_type(8)));
typedef GAS unsigned gu32;
typedef GAS unsigned long long gu64;
#define RLX_AGENT __ATOMIC_RELAXED, __HIP_MEMORY_SCOPE_AGENT
#define LDS_WAIT() asm volatile("s_waitcnt lgkmcnt(0)" ::: "memory")
#define VM_WAIT() asm volatile("s_waitcnt vmcnt(0)" ::: "memory")
__device__ __forceinline__ unsigned long long rt() { return __builtin_amdgcn_s_memrealtime(); }
__device__ __forceinline__ unsigned f2bf(float f) { unsigned u = __builtin_bit_cast(unsigned, f); return (u + 0x7fffu + ((u >> 16) & 1u)) >> 16; }
__device__ __forceinline__ unsigned pk2(float lo, float hi) { return f2bf(lo) | (f2bf(hi) << 16); }
#define XB_TMO      128
#define XB_XCNT(j)  (256  + 64 * (j))
#define XB_XSUB(j)  (1280 + 64 * (j))
#define XB_XGEN(j)  (2304 + 64 * (j))
#define XB_TOP      3328
#define XB_TOPGEN   3392
#define XCD_BAR_WORDS 3456
#define XB_SPIN_CAP (1u << 18)

__device__ __forceinline__ unsigned xb_ld(unsigned* p)              { return __hip_atomic_load(p, __ATOMIC_RELAXED, __HIP_MEMORY_SCOPE_AGENT); }
__device__ __forceinline__ unsigned xb_add(unsigned* p, unsigned v) { return __hip_atomic_fetch_add(p, v, __ATOMIC_RELAXED, __HIP_MEMORY_SCOPE_AGENT); }
__device__ __forceinline__ unsigned xb_xcc_id() { return (unsigned)__builtin_amdgcn_s_getreg((3 << 11) | 20) & 0xFu; }
#define XB_SPIN(cond, bar) do { unsigned _sp = 0; while (cond) { __builtin_amdgcn_s_sleep(1); \
    if ((++_sp & 255u) == 0u) { if (xb_ld(&(bar)[XB_TMO])) break; if (_sp > XB_SPIN_CAP) { atomicAdd(&(bar)[XB_TMO], 1u); break; } } } } while (0)

struct XcdBarrier {
    unsigned* bar; unsigned x;
    volatile LAS unsigned* st;
};

__device__ __forceinline__ XcdBarrier xcd_barrier_post(unsigned* bar, volatile LAS unsigned* st, bool t0  ) {
    XcdBarrier b; b.bar = bar; b.x = xb_xcc_id(); b.st = st;
    if (t0) (void)xb_add(&bar[XB_XCNT(b.x)], 1u);
    return b;
}
__device__ __forceinline__ void xcd_barrier_complete(unsigned* bar, unsigned x, unsigned& nloc, unsigned& nx) {
    const unsigned G = gridDim.x * gridDim.y * gridDim.z;
    unsigned sum, cnt, mine, sp = 0u;
    for (;;) {
        sum = 0u; cnt = 0u; mine = 0u;
#pragma unroll
        for (unsigned j = 0; j < 16; ++j) { const unsigned c = xb_ld(&bar[XB_XCNT(j)]); sum += c; cnt += (c > 0u) ? 1u : 0u; mine = (j == x) ? c : mine; }
        if (sum == G) break;
        __builtin_amdgcn_s_sleep(1);
        if ((++sp & 255u) == 0u) { if (xb_ld(&bar[XB_TMO])) break; if (sp > XB_SPIN_CAP) { atomicAdd(&bar[XB_TMO], 1u); break; } }
    }
    nloc = mine > 0u ? mine : 1u; nx = cnt > 0u ? cnt : 1u;
}

__device__ __forceinline__ void xcd_barrier(const XcdBarrier& b, bool t0  ) {
    asm volatile("s_waitcnt vmcnt(0)" ::: "memory");
    __syncthreads();
    if (t0) {
        unsigned* bar = b.bar;
        __builtin_amdgcn_s_waitcnt(0);
        unsigned nloc = b.st[0], nx = b.st[1];
        if (nloc == 0u) { xcd_barrier_complete(bar, b.x, nloc, nx); b.st[0] = nloc; b.st[1] = nx; }
        const unsigned old = xb_add(&bar[XB_XSUB(b.x)], 1u);
        const unsigned gen = old / nloc;
        if (old + 1u == (gen + 1u) * nloc) {
            __builtin_amdgcn_fence(__ATOMIC_RELEASE, "agent");
            asm volatile("s_waitcnt vmcnt(0)" ::: "memory");
            const unsigned og = xb_add(&bar[XB_TOP], 1u);
            const unsigned tg = og / nx;
            if (og + 1u == (tg + 1u) * nx) xb_add(&bar[XB_TOPGEN], 1u);
            else XB_SPIN(xb_ld(&bar[XB_TOPGEN]) == tg, bar);
            __builtin_amdgcn_fence(__ATOMIC_ACQUIRE, "agent");
            xb_add(&bar[XB_XGEN(b.x)], 1u);
            asm volatile("s_waitcnt vmcnt(0)" ::: "memory");
        } else {
            XB_SPIN(xb_ld(&bar[XB_XGEN(b.x)]) == gen, bar);
            __builtin_amdgcn_fence(__ATOMIC_ACQUIRE, "agent");
            asm volatile("s_waitcnt vmcnt(0)" ::: "memory");
        }
    }
    __syncthreads();
}

constexpr int DM = 2048, BP = 4, TP = 2048, MP = BP * TP, BS = 8, TS = 16, MS = BS * TS, MR = MP + MS, MT = 8448;
constexpr int DIN = 4352, DFF = 8192, NL = 4, NMOD = 6 * DM;
constexpr int C_QA = 0, C_KA = 512, C_VA = 640, C_XB = 768, C_GB = 1792, C_QC = 2816, C_KC = 3328, C_VC = 3840;
constexpr float RMS_EPS = 1e-6f, LOG2E = 1.4426950408889634f;
using pg8::O_YP; using pg8::O_YS; using pg8::O_LHP; using pg8::O_LHS; using pg8::O_END;
constexpr int NWAVES = 8;
constexpr size_t MiB = 1u << 20;
constexpr size_t WS_CTL = 0, CTL_ZERO_BYTES = 1 * MiB;
constexpr size_t WS_MOD = 1 * MiB;
constexpr size_t WS_WIN = 4 * MiB;
constexpr size_t WS_WOUT = 72 * MiB;
constexpr size_t WS_WUP = 104 * MiB;
constexpr size_t WS_WDN = 232 * MiB;
constexpr size_t WS_H = 360 * MiB;
constexpr size_t WS_Z = 393 * MiB;
constexpr size_t WS_MIX = 464 * MiB;
constexpr size_t WS_T = 497 * MiB;
constexpr size_t WS_F1 = 563 * MiB;
constexpr size_t WS_END = 695 * MiB;
static_assert(WS_MOD + (size_t)NL * 12 * NMOD * 4 <= WS_WIN && WS_WIN + (size_t)NL * DIN * DM * 2 <= WS_WOUT && WS_WOUT + (size_t)NL * DM * DM * 2 <= WS_WUP &&
              WS_WUP + (size_t)NL * DFF * DM * 2 <= WS_WDN && WS_WDN + (size_t)NL * DFF * DM * 2 <= WS_H && WS_H + (size_t)MT * DM * 2 <= WS_Z &&
              WS_Z + (size_t)MT * DIN * 2 <= WS_MIX && WS_MIX + (size_t)MT * DM * 2 <= WS_T && WS_T + (size_t)MT * DM * 4 <= WS_F1 && WS_F1 + (size_t)MT * DFF * 2 <= WS_END, "d_ws map");
constexpr int CW_BAR = 4096;
constexpr int RING_BYTES = 131072, LDSCTL_OFF = RING_BYTES, MISC_OFF = LDSCTL_OFF + 320, LDS_BYTES = 147456;

typedef float f32x16 __attribute__((ext_vector_type(16)));
typedef unsigned u32x2 __attribute__((ext_vector_type(2)));
__device__ __forceinline__ float bf2f(unsigned short b) { return __uint_as_float((unsigned)b << 16); }
__device__ __forceinline__ unsigned pkbf(float lo, float hi) { typedef float f2_t __attribute__((ext_vector_type(2))); typedef __bf16 b2_t __attribute__((ext_vector_type(2)));
    f2_t v = {lo, hi}; b2_t b = __builtin_convertvector(v, b2_t); return __builtin_bit_cast(unsigned, b); }
__device__ __forceinline__ v4u pack8(const f32x4 a, const f32x4 b) { v4u w; w.x = pkbf(a[0], a[1]); w.y = pkbf(a[2], a[3]); w.z = pkbf(b[0], b[1]); w.w = pkbf(b[2], b[3]); return w; }
__device__ __forceinline__ float wave_sum(float v) {
#pragma unroll
    for (int o = 1; o < 64; o <<= 1) v += __shfl_xor(v, o);
    return v;
}
__device__ __forceinline__ int hw_lane() { int l; asm volatile("v_mbcnt_lo_u32_b32 %0, -1, 0\n\tv_mbcnt_hi_u32_b32 %0, -1, %0" : "=v"(l)); return l; }
__device__ __forceinline__ float fexp2(float x) { return __builtin_amdgcn_exp2f(x); }
__device__ __forceinline__ float frcp(float x) { return __builtin_amdgcn_rcpf(x); }
__device__ __forceinline__ float sigmoidf_fast(float x) { return frcp(1.0f + fexp2(-x * LOG2E)); }

__device__ __forceinline__ void p0_transpose_item(const float* W, int K, int N, bf16* WT, LAS float* scr, int item, int lane) {
    const int nblk = N / 32, kb = item / nblk, nb = item % nblk, k0 = 64 * kb, n0 = 32 * nb;
#pragma unroll 8
    for (int i = 0; i < 32; ++i) { const int kk = 2 * i + (lane >> 5); scr[kk * 33 + (lane & 31)] = W[(size_t)(k0 + kk) * N + n0 + (lane & 31)]; }
    LDS_WAIT(); asm volatile("" ::: "memory");
    const int c = lane & 7;
#pragma unroll
    for (int j = 0; j < 4; ++j) { const int n = (lane >> 3) + 8 * j; const LAS float* s = scr + (8 * c) * 33 + n;
        v4u o; o.x = pk2(s[0 * 33], s[1 * 33]); o.y = pk2(s[2 * 33], s[3 * 33]); o.z = pk2(s[4 * 33], s[5 * 33]); o.w = pk2(s[6 * 33], s[7 * 33]);
        *(GAS v4u*)(WT + (size_t)(n0 + n) * K + k0 + 8 * c) = o; }
    LDS_WAIT(); asm volatile("" ::: "memory");
}
__device__ __forceinline__ void p0_mods(LAS unsigned char* lds, const float* c_p, const float* c_s, const float* w_mod, const float* b_mod, float* MOD, int G, int bid, int tid) {
    const int lane = tid & 63, wave = __builtin_amdgcn_readfirstlane(tid >> 6);
    LAS float* S = (LAS float*)lds;
    LAS float* PS = (LAS float*)lds;
    for (int item = bid; item < 256; item += G) {
        __syncthreads();
        for (int e = tid; e < 12 * 2048; e += 512) { const int row = e >> 11, k = e & 2047; const float c = row < 4 ? c_p[row * 2048 + k] : c_s[(row - 4) * 2048 + k]; S[k * 12 + row] = c / (1.0f + expf(-c)); }
        __syncthreads();
        const int l = item >> 6, cg = item & 63, col0 = cg * 192;
        const float* W = w_mod + (size_t)l * DM * NMOD + col0 + lane;
        float acc[12][3];
#pragma unroll
        for (int r = 0; r < 12; ++r) { acc[r][0] = 0.f; acc[r][1] = 0.f; acc[r][2] = 0.f; }
        const int k0 = wave * 256;
#pragma unroll 4
        for (int kk = 0; kk < 256; ++kk) {
            const int k = k0 + kk; const float* wrow = W + (size_t)k * NMOD; const float w0 = wrow[0], w1 = wrow[64], w2 = wrow[128];
            const LAS f32x4* sp = (const LAS f32x4*)(S + k * 12); const f32x4 s0 = sp[0], s1 = sp[1], s2 = sp[2];
#pragma unroll
            for (int r = 0; r < 4; ++r) { acc[r][0] += s0[r] * w0; acc[r][1] += s0[r] * w1; acc[r][2] += s0[r] * w2;
                                          acc[4 + r][0] += s1[r] * w0; acc[4 + r][1] += s1[r] * w1; acc[4 + r][2] += s1[r] * w2;
                                          acc[8 + r][0] += s2[r] * w0; acc[8 + r][1] += s2[r] * w1; acc[8 + r][2] += s2[r] * w2; }
        }
        __syncthreads();
#pragma unroll
        for (int r = 0; r < 12; ++r)
#pragma unroll
            for (int j = 0; j < 3; ++j) PS[(wave * 12 + r) * 192 + j * 64 + lane] = acc[r][j];
        __syncthreads();
        for (int e = tid; e < 12 * 192; e += 512) { const int r = e / 192, c = e % 192; float s = b_mod[(size_t)l * NMOD + col0 + c];
#pragma unroll
            for (int w = 0; w < 8; ++w) s += PS[(w * 12 + r) * 192 + c];
            MOD[((size_t)l * 12 + r) * NMOD + col0 + c] = s; }
    }
    __syncthreads();
}

#define ROW_LD(dst, ptr) do { const f32x4* _p = (const f32x4*)(ptr) + lane; _Pragma("unroll") for (int _j = 0; _j < 8; ++_j) dst[_j] = _p[64 * _j]; } while (0)
__device__ __forceinline__ float row_sumsq(const f32x4 (&v)[8]) { float s = 0.f;
#pragma unroll
    for (int j = 0; j < 8; ++j) s += (v[j][0] * v[j][0] + v[j][1] * v[j][1]) + (v[j][2] * v[j][2] + v[j][3] * v[j][3]);
    return wave_sum(s); }
__device__ __forceinline__ void norm_mod_store(const f32x4 (&v)[8], float rstd, const float* g, const float* scale, const float* shift, bf16* hrow, int lane) {
    const f32x4* g4 = (const f32x4*)g + lane; const f32x4* sc4 = (const f32x4*)scale + lane; const f32x4* sh4 = (const f32x4*)shift + lane;
    u32x2* o = (u32x2*)hrow + lane;
#pragma unroll
    for (int j = 0; j < 8; ++j) { const f32x4 gg = g4[64 * j], sc = sc4[64 * j], sh = sh4[64 * j]; const f32x4 h = v[j] * rstd * gg * (sc + 1.0f) + sh;
        u32x2 w; w.x = pkbf(h[0], h[1]); w.y = pkbf(h[2], h[3]); o[64 * j] = w; }
}
__device__ __forceinline__ int mod_row_of(int row) { return row < MP ? (row >> 11) : 4 + ((row - MP) >> 4); }

constexpr int AK_PITCH = 144, AV_PITCH = 80, AK_BYTES = 32 * AK_PITCH  , AV_BYTES = 64 * AV_PITCH  , ATBL_BYTES = 1088;
struct AttnWave { bool active; bool wr; const bf16* qrow; bf16* orow; int qpos; float m0, l0; };
#define MFMA32(a, b, c) __builtin_amdgcn_mfma_f32_32x32x16_bf16((a), (b), (c), 0, 0, 0)
#define MFMA16(a, b, c) __builtin_amdgcn_mfma_f32_16x16x32_bf16((a), (b), (c), 0, 0, 0)

template <int NTASK>
__device__ __forceinline__ void attn_stage_store(const v4u (&st)[NTASK], LAS unsigned char* kb, LAS unsigned char* vb, int gtid, int nthr) {
#pragma unroll
    for (int i = 0; i < NTASK; ++i) {
        const int task = gtid + nthr * i; const bool isV = task >= 256; const int idx = task & 255, key = idx >> 3, dc = idx & 7;
        if (!isV) { *(LAS v4u*)(kb + key * AK_PITCH + dc * 16) = st[i]; }
        else {
            LAS unsigned short* vp = (LAS unsigned short*)(vb + (dc * 8) * AV_PITCH + key * 2);
#pragma unroll
            for (int e = 0; e < 4; ++e) { const unsigned w = st[i][e]; vp[(2 * e) * (AV_PITCH / 2)] = (unsigned short)(w & 0xffffu); vp[(2 * e + 1) * (AV_PITCH / 2)] = (unsigned short)(w >> 16); }
        }
    }
}
template <bool SHARED, bool BIAS, class Src, class Rel>
__device__ __forceinline__ void attn_run(LAS unsigned char* kbuf, LAS unsigned char* vbuf, const LAS float* tbl, int gtid, int ntiles, int kbase, int partial_tile,
                                         const Src& src, const Rel& rel, const AttnWave& W) {
    constexpr int NTHR = SHARED ? 512 : 64, NTASK = 512 / NTHR, NBUF = SHARED ? 2 : 1;
    const int lane = hw_lane(), r = lane & 31, h = lane >> 5;
    const int fr = (r & 0x13) | ((r & 4) << 1) | ((r & 8) >> 1);
    bf16x8 qf[4];
#pragma unroll
    for (int ks = 0; ks < 4; ++ks) qf[ks] = (bf16x8){0, 0, 0, 0, 0, 0, 0, 0};
    if (W.active) {
#pragma unroll
        for (int ks = 0; ks < 4; ++ks) qf[ks] = *(const bf16x8*)(W.qrow + ks * 16 + h * 8);
    }
    float m = W.m0, l = W.l0;
    f32x16 o0, o1;
#pragma unroll
    for (int i = 0; i < 16; ++i) { o0[i] = 0.f; o1[i] = 0.f; }
    v4u st[NTASK];
#pragma unroll
    for (int i = 0; i < NTASK; ++i) { const int task = gtid + NTHR * i; const int idx = task & 255; st[i] = src(0, task >= 256, idx >> 3, idx & 7); }
    attn_stage_store<NTASK>(st, kbuf, vbuf, gtid, NTHR);
    if (SHARED) __syncthreads();
    for (int t = 0; t < ntiles; ++t) {
        const bool more = (t + 1 < ntiles);
        if (more) {
#pragma unroll
            for (int i = 0; i < NTASK; ++i) { const int task = gtid + NTHR * i; const int idx = task & 255; st[i] = src(t + 1, task >= 256, idx >> 3, idx & 7); }
        }
        if (W.active && rel(t)) {
            const LAS unsigned char* kb = kbuf + (NBUF == 2 ? (t & 1) * AK_BYTES : 0);
            const LAS unsigned char* vb = vbuf + (NBUF == 2 ? (t & 1) * AV_BYTES : 0);
            f32x16 x;
#pragma unroll
            for (int i = 0; i < 16; ++i) x[i] = 0.f;
#pragma unroll
            for (int ks = 0; ks < 4; ++ks) { const bf16x8 kf = *(const LAS bf16x8*)(kb + fr * AK_PITCH + ks * 32 + h * 16); x = MFMA32(kf, qf[ks], x); }
            float tt[16];
            const float c = 0.125f * LOG2E;
            if (BIAS) {
                const int dbase = W.qpos - (kbase + 32 * t) - 8 * h;
#pragma unroll
                for (int i = 0; i < 16; ++i) { int d = dbase - ((i & 7) + 16 * (i >> 3)); d = d < -128 ? -128 : (d > 128 ? 128 : d); tt[i] = x[i] * c + tbl[d + 128]; }
            } else {
#pragma unroll
                for (int i = 0; i < 16; ++i) tt[i] = x[i] * c;
            }
            if (t == partial_tile) {
#pragma unroll
                for (int i = 8; i < 16; ++i) tt[i] = -1e30f;
            }
            float mt = tt[0];
#pragma unroll
            for (int i = 1; i < 16; ++i) mt = fmaxf(mt, tt[i]);
            mt = fmaxf(mt, __shfl_xor(mt, 32));
            const float mn = fmaxf(m, mt); const float alpha = fexp2(m - mn); m = mn;
            float ps = 0.f;
#pragma unroll
            for (int i = 0; i < 16; ++i) { tt[i] = fexp2(tt[i] - mn); ps += tt[i]; }
            l = l * alpha + ps;
#pragma unroll
            for (int i = 0; i < 16; ++i) { o0[i] *= alpha; o1[i] *= alpha; }
#pragma unroll
            for (int s = 0; s < 2; ++s) {
                v4u pw; pw.x = pkbf(tt[8 * s], tt[8 * s + 1]); pw.y = pkbf(tt[8 * s + 2], tt[8 * s + 3]); pw.z = pkbf(tt[8 * s + 4], tt[8 * s + 5]); pw.w = pkbf(tt[8 * s + 6], tt[8 * s + 7]);
                const bf16x8 pf = __builtin_bit_cast(bf16x8, pw);
                const bf16x8 v0 = *(const LAS bf16x8*)(vb + r * AV_PITCH + s * 32 + h * 16);
                const bf16x8 v1 = *(const LAS bf16x8*)(vb + (r + 32) * AV_PITCH + s * 32 + h * 16);
                o0 = MFMA32(v0, pf, o0); o1 = MFMA32(v1, pf, o1);
            }
        }
        if (more) attn_stage_store<NTASK>(st, kbuf + (NBUF == 2 ? ((t + 1) & 1) * AK_BYTES : 0), vbuf + (NBUF == 2 ? ((t + 1) & 1) * AV_BYTES : 0), gtid, NTHR);
        if (SHARED) __syncthreads();
    }
    if (W.active) {
        const float lt = l + __shfl_xor(l, 32); const float inv = 1.0f / lt;
        if (W.wr) {
#pragma unroll
            for (int g = 0; g < 4; ++g) {
                u32x2 w0; w0.x = pkbf(o0[4 * g] * inv, o0[4 * g + 1] * inv); w0.y = pkbf(o0[4 * g + 2] * inv, o0[4 * g + 3] * inv);
                u32x2 w1; w1.x = pkbf(o1[4 * g] * inv, o1[4 * g + 1] * inv); w1.y = pkbf(o1[4 * g + 2] * inv, o1[4 * g + 3] * inv);
                *(u32x2*)(W.orow + 8 * g + 4 * h) = w0; *(u32x2*)(W.orow + 32 + 8 * g + 4 * h) = w1;
            }
        }
    }
}
struct RelAll { __device__ __forceinline__ bool operator()(int) const { return true; } };
struct RelBandP { int lo, hi; __device__ __forceinline__ bool operator()(int t) const { return t >= lo && t <= hi; } };
struct SrcZ { const bf16* zb; int kpos_first, kcol, vcol;
    __device__ __forceinline__ v4u operator()(int t, bool isV, int key, int dc) const { const int col = kcol + (isV ? (vcol - kcol) : 0); return *(const v4u*)(zb + (size_t)(kpos_first + 32 * t + key) * DIN + col + dc * 8); } };
struct SrcCache { const float* ck; const float* cv; int hstride  ; int ncache; const bf16* znew; int kcol, vcol;
    __device__ __forceinline__ v4u operator()(int t, bool isV, int key, int dc) const {
        const long vd = isV ? (long)(cv - ck) : 0l; const int col = kcol + (isV ? (vcol - kcol) : 0);
        if (t < ncache) { const float* p = ck + vd + (size_t)(32 * t + key) * hstride + dc * 8; const f32x4 a = *(const f32x4*)p, b = *(const f32x4*)(p + 4); return pack8(a, b); }
        if (key < 16) return *(const v4u*)(znew + (size_t)key * DIN + col + dc * 8);
        return (v4u){0u, 0u, 0u, 0u}; } };

struct LruUnit {
    const bf16* zseq;
    const float* prefix;
    int n;
    int chn;
    float c8, cw0, cw1, cw2, cw3, cb, rb, ib;
    bf16x8 bfr[8], bfi[8];
};
__device__ __forceinline__ void lru_setup(LruUnit& U, int l, int n, int dq, const float* conv_w, const float* conv_b, const float* w_r, const float* b_r, const float* w_i, const float* b_i, const float* lam) {
    const int lane = hw_lane(), ch = lane & 15, kq = lane >> 4;
    U.n = n; U.chn = 64 * n + 16 * dq + ch;
    const float* Wr = w_r + ((size_t)(l * 16 + n) * 64) * 64 + 16 * dq + ch;
    const float* Wi = w_i + ((size_t)(l * 16 + n) * 64) * 64 + 16 * dq + ch;
    const float* cw = conv_w + (size_t)l * 4 * 1024 + 64 * n;
    const float* cbp = conv_b + (size_t)l * 1024 + 64 * n;
    float sr = 0.f, si = 0.f;
#pragma unroll
    for (int chalf = 0; chalf < 2; ++chalf) {
        float wr8[8], wi8[8];
#pragma unroll
        for (int jj = 0; jj < 8; ++jj) { const int c = 32 * chalf + 8 * kq + jj; wr8[jj] = Wr[c * 64]; wi8[jj] = Wi[c * 64]; const float cbv = cbp[c]; sr += cbv * wr8[jj]; si += cbv * wi8[jj]; }
#pragma unroll
        for (int j = 0; j < 4; ++j) {
            float t8[8];
#pragma unroll
            for (int jj = 0; jj < 8; ++jj) t8[jj] = cw[j * 1024 + 32 * chalf + 8 * kq + jj];
            v4u pr, pi;
#pragma unroll
            for (int e = 0; e < 4; ++e) { pr[e] = pkbf(t8[2 * e] * wr8[2 * e], t8[2 * e + 1] * wr8[2 * e + 1]); pi[e] = pkbf(t8[2 * e] * wi8[2 * e], t8[2 * e + 1] * wi8[2 * e + 1]); }
            U.bfr[j * 2 + chalf] = __builtin_bit_cast(bf16x8, pr); U.bfi[j * 2 + chalf] = __builtin_bit_cast(bf16x8, pi);
        }
    }
    sr += __shfl_xor(sr, 16); sr += __shfl_xor(sr, 32); si += __shfl_xor(si, 16); si += __shfl_xor(si, 32);
    U.rb = sr + b_r[(size_t)(l * 16 + n) * 64 + 16 * dq + ch]; U.ib = si + b_i[(size_t)(l * 16 + n) * 64 + 16 * dq + ch];
    const float lm = lam[(size_t)l * 1024 + U.chn];
    U.c8 = -8.0f * log1pf(expf(-lm));
    U.cw0 = conv_w[((size_t)l * 4 + 0) * 1024 + U.chn]; U.cw1 = conv_w[((size_t)l * 4 + 1) * 1024 + U.chn]; U.cw2 = conv_w[((size_t)l * 4 + 2) * 1024 + U.chn]; U.cw3 = conv_w[((size_t)l * 4 + 3) * 1024 + U.chn];
    U.cb = conv_b[(size_t)l * 1024 + U.chn];
}
__device__ __forceinline__ bf16x8 lru_ld8(const LruUnit& U, int trow, int c0) {
    v4u w;
    if (trow >= 0) w = *(const v4u*)(U.zseq + (size_t)trow * DIN + C_XB + 64 * U.n + c0);
    else if (U.prefix != nullptr) { const float* p = U.prefix + (trow + 3) * 1024 + 64 * U.n + c0; w = pack8(*(const f32x4*)p, *(const f32x4*)(p + 4)); }
    else w = (v4u){0u, 0u, 0u, 0u};
    return __builtin_bit_cast(bf16x8, w);
}
__device__ __forceinline__ float lru_xb(const LruUnit& U, int trow) {
    if (trow >= 0) return bf2f(U.zseq[(size_t)trow * DIN + C_XB + U.chn]);
    if (U.prefix != nullptr) return U.prefix[(trow + 3) * 1024 + U.chn];
    return 0.f;
}
__device__ __forceinline__ void lru_tile(const LruUnit& U, int t0, float& Ac, float& Hc, float (&P)[4], float (&hl)[4]) {
    const int lane = hw_lane(), tk = lane & 15, kq = lane >> 4, tq = kq;
    f32x4 ar = {U.rb, U.rb, U.rb, U.rb}, ai = {U.ib, U.ib, U.ib, U.ib};
#pragma unroll
    for (int j = 0; j < 4; ++j)
#pragma unroll
        for (int chalf = 0; chalf < 2; ++chalf) { const bf16x8 a = lru_ld8(U, t0 + tk - 3 + j, 32 * chalf + 8 * kq); ar = MFMA16(a, U.bfr[j * 2 + chalf], ar); ai = MFMA16(a, U.bfi[j * 2 + chalf], ai); }
    float xv[7];
#pragma unroll
    for (int e = 0; e < 7; ++e) xv[e] = lru_xb(U, t0 + 4 * tq - 3 + e);
    float a[4], u[4];
#pragma unroll
    for (int j = 0; j < 4; ++j) {
        const float xc = U.cb + U.cw0 * xv[j] + U.cw1 * xv[j + 1] + U.cw2 * xv[j + 2] + U.cw3 * xv[j + 3];
        const float rg = sigmoidf_fast(ar[j]), ig = sigmoidf_fast(ai[j]);
        const float la = U.c8 * rg;
        a[j] = fexp2(la * LOG2E);
        const float x2 = 2.0f * la;
        const float om = -x2 * (1.0f + x2 * 0.5f * (1.0f + x2 * (1.0f / 3.0f) * (1.0f + x2 * 0.25f * (1.0f + x2 * 0.2f * (1.0f + x2 * (1.0f / 6.0f) * (1.0f + x2 * (1.0f / 7.0f)))))));
        u[j] = sqrtf(fmaxf(om, 0.f)) * (ig * xc);
    }
    P[0] = a[0]; hl[0] = u[0];
#pragma unroll
    for (int j = 1; j < 4; ++j) { P[j] = P[j - 1] * a[j]; hl[j] = a[j] * hl[j - 1] + u[j]; }
    float A = P[3], H = hl[3];
    { const float Ap = __shfl_up(A, 16), Hp = __shfl_up(H, 16); if (tq >= 1) { H = A * Hp + H; A = A * Ap; } }
    { const float Ap = __shfl_up(A, 32), Hp = __shfl_up(H, 32); if (tq >= 2) { H = A * Hp + H; A = A * Ap; } }
    float Aex = __shfl_up(A, 16), Hex = __shfl_up(H, 16); if (tq == 0) { Aex = 1.0f; Hex = 0.f; }
    const float At = __shfl(A, 48 + tk), Ht = __shfl(H, 48 + tk);
    const float Ae2 = Ac * Aex, He2 = Aex * Hc + Hex;
#pragma unroll
    for (int j = 0; j < 4; ++j) { hl[j] = P[j] * He2 + hl[j]; P[j] = Ae2 * P[j]; }
    Hc = At * Hc + Ht; Ac = Ac * At;
}
__device__ __forceinline__ float gelu_tanh(float g) { const float y = 0.7978845608028654f * (g + 0.044715f * g * g * g); return g * sigmoidf_fast(2.0f * y); }

struct Args { const float* in[29]; float* out; unsigned char* ws; int ph_lo, ph_hi; };
static_assert(sizeof(Args) == 31 * 8 + 8, "Args has no padding");
constexpr int N_PHASES = 2 + 7 * NL;


typedef const __attribute__((address_space(4))) Args* KArgs;
__device__ __forceinline__ KArgs kargs() { KArgs p = (KArgs)__builtin_amdgcn_kernarg_segment_ptr(); asm volatile("" : "+s"(p)); return p; }
#define TIDS() int tid_ = wave0 * 64 + hw_lane(); asm volatile("" : "+v"(tid_)); const int tid = tid_, lane = tid & 63, wave = __builtin_amdgcn_readfirstlane(tid >> 6); (void)tid; (void)lane; (void)wave
#define GWS() int G_ = gridDim.x, bid_ = blockIdx.x; asm volatile("" : "+s"(G_), "+s"(bid_)); const int G = G_, bid = bid_; const int vcu = (G % 8 == 0) ? (bid % 8) * (G / 8) + bid / 8 : bid; const int gw = vcu * NWAVES + wave, NGW = G * NWAVES; (void)gw; (void)NGW

__global__ void __launch_bounds__(NWAVES * 64, 2) mk_fwd(Args args) {
    extern __shared__ __attribute__((aligned(16))) unsigned char lds_raw[];
    LAS unsigned char* lds = (LAS unsigned char*)lds_raw;
    const int wave0 = __builtin_amdgcn_readfirstlane((int)threadIdx.x >> 6);
    { const int tid0 = threadIdx.x; for (int u = tid0; u < (LDS_BYTES - LDSCTL_OFF) / 4; u += NWAVES * 64) ((LAS unsigned*)(lds + LDSCTL_OFF))[u] = 0u; }
    __syncthreads();
    const int lo = args.ph_lo, hi = args.ph_hi;
    const bool use_bar = (hi - lo) > 1;
    XcdBarrier bar; bar.bar = (unsigned*)(args.ws + WS_CTL) + CW_BAR; bar.x = 0; bar.st = nullptr;
    if (use_bar) bar = xcd_barrier_post((unsigned*)(args.ws + WS_CTL) + CW_BAR, (volatile LAS unsigned*)(lds + MISC_OFF) + 8, threadIdx.x == 0);
#define IN(k) (lo <= (k) && (k) < hi)
#define SEAM(k) do { if (IN(k) && IN((k) + 1)) xcd_barrier(bar, wave0 == 0 && hw_lane() == 0); } while (0)

    if (IN(0)) {
        KArgs KA = kargs(); unsigned char* ws = KA->ws; TIDS(); GWS();
        p0_mods(lds, KA->in[2], KA->in[3], KA->in[10], KA->in[11], (float*)(ws + WS_MOD), G, bid, tid);
        const float* w_in = KA->in[13]; const float* w_out = KA->in[23]; const float* w_up = KA->in[26]; const float* w_down = KA->in[27];
        bf16* WIN = (bf16*)(ws + WS_WIN); bf16* WOUT = (bf16*)(ws + WS_WOUT); bf16* WUP = (bf16*)(ws + WS_WUP); bf16* WDN = (bf16*)(ws + WS_WDN);
        LAS float* scr = (LAS float*)(lds + wave * 16384);
        constexpr int I_IN = (DM / 64) * (DIN / 32), I_OUT = (DM / 64) * (DM / 32), I_UP = (DM / 64) * (DFF / 32), I_DN = (DFF / 64) * (DM / 32), I_L = I_IN + I_OUT + I_UP + I_DN;
        for (int it = gw; it < NL * I_L; it += NGW) {
            const int l = it / I_L; int r = it % I_L;
            if (r < I_IN) { p0_transpose_item(w_in + (size_t)l * DM * DIN, DM, DIN, WIN + (size_t)l * DIN * DM, scr, r, lane); continue; } r -= I_IN;
            if (r < I_OUT) { p0_transpose_item(w_out + (size_t)l * DM * DM, DM, DM, WOUT + (size_t)l * DM * DM, scr, r, lane); continue; } r -= I_OUT;
            if (r < I_UP) { p0_transpose_item(w_up + (size_t)l * DM * DFF, DM, DFF, WUP + (size_t)l * DFF * DM, scr, r, lane); continue; } r -= I_UP;
            p0_transpose_item(w_down + (size_t)l * DFF * DM, DFF, DM, WDN + (size_t)l * DM * DFF, scr, r, lane);
        }
    }
    SEAM(0);
    if (IN(1)) {
        KArgs KA = kargs(); unsigned char* ws = KA->ws; TIDS(); GWS();
        const float* x_p = KA->in[0]; const float* x_s = KA->in[1]; const float* g_pre_mix = KA->in[12];
        const float* MOD = (const float*)(ws + WS_MOD); bf16* Hb = (bf16*)(ws + WS_H); bf16* MIXb = (bf16*)(ws + WS_MIX);
        for (int row = gw; row < MT; row += NGW) {
            bf16* hrow = Hb + (size_t)row * DM;
            if (row >= MR) { u32x2* o = (u32x2*)hrow + lane; u32x2* o2 = (u32x2*)(MIXb + (size_t)row * DM) + lane;
#pragma unroll
                for (int j = 0; j < 8; ++j) { o[64 * j] = (u32x2){0u, 0u}; o2[64 * j] = (u32x2){0u, 0u}; }
                continue; }
            const float* xr = row < MP ? x_p + (size_t)row * DM : x_s + (size_t)(row - MP) * DM;
            f32x4 v[8]; ROW_LD(v, xr);
            const float rstd = 1.0f / sqrtf(row_sumsq(v) * (1.0f / DM) + RMS_EPS);
            const float* md = MOD + ((size_t)0 * 12 + mod_row_of(row)) * NMOD;
            norm_mod_store(v, rstd, g_pre_mix, md + DM, md, hrow, lane);
        }
    }
    SEAM(1);

    for (int l = 0; l < NL; ++l) {
        const int pb = 2 + 7 * l;
        if (IN(pb + 0)) {
            KArgs KA = kargs(); unsigned char* ws = KA->ws;
            pg8::Gemm g{(const bf16*)(ws + WS_H), (const bf16*)(ws + WS_WIN) + (size_t)l * DIN * DM, MT, DIN, DM}; pg8::StaticOrder S; { int G_ = gridDim.x, bid_ = blockIdx.x; asm volatile("" : "+s"(G_), "+s"(bid_)); S.init(MT, DIN, G_, bid_); }
            pg8::EpiInProj E{(bf16*)(ws + WS_Z), KA->out, l};
            pg8::gemm_phase<pg8::EpiInProj, pg8::StaticOrder, true, true>(lds, g, S, E, wave0 * 64 + hw_lane());
        }
        SEAM(pb + 0);
        if (IN(pb + 1)) {
            {
            KArgs KA = kargs(); unsigned char* ws = KA->ws; TIDS(); GWS();
            const bf16* Zb = (const bf16*)(ws + WS_Z); bf16* MIXb = (bf16*)(ws + WS_MIX); float* out = KA->out;
            for (int un = bid; un < 256; un += G) {
                __syncthreads();
                const int b = un >> 6, n = (un >> 2) & 15, dq = un & 3;
                LruUnit U; U.zseq = Zb + (size_t)(b * TP) * DIN; U.prefix = nullptr;
                lru_setup(U, l, n, dq, KA->in[15], KA->in[16], KA->in[17], KA->in[18], KA->in[19], KA->in[20], KA->in[21]);
                const int ch = lane & 15, tq = lane >> 4;
                LAS float* ex = (LAS float*)lds;
                float hstart = 0.f;
                for (int R = 0; R < 4; ++R) {
                    float Ac = 1.0f, Hc = 0.f; float P[4][4], hl[4][4];
                    const int tw = R * 512 + wave * 64;
#pragma unroll
                    for (int i = 0; i < 4; ++i) lru_tile(U, tw + 16 * i, Ac, Hc, P[i], hl[i]);
                    LAS float* exw = ex + (R & 1) * 256;
                    if (tq == 0) { exw[(wave * 16 + ch) * 2] = Ac; exw[(wave * 16 + ch) * 2 + 1] = Hc; }
                    __syncthreads();
                    float hs = hstart, hin = 0.f;
#pragma unroll
                    for (int w2 = 0; w2 < 8; ++w2) { const float A2 = exw[(w2 * 16 + ch) * 2], H2 = exw[(w2 * 16 + ch) * 2 + 1]; if (w2 == wave) hin = hs; hs = A2 * hs + H2; }
                    hstart = hs;
#pragma unroll
                    for (int i = 0; i < 4; ++i)
#pragma unroll
                        for (int j = 0; j < 4; ++j) {
                            const int t = tw + 16 * i + 4 * tq + j; const size_t row = (size_t)(b * TP + t);
                            const float hv = hl[i][j] + P[i][j] * hin;
                            const float gb = bf2f(Zb[row * DIN + C_GB + U.chn]);
                            MIXb[row * DM + 512 + U.chn] = (bf16)f2bf(hv * gelu_tanh(gb));
                            if (t == TP - 1) out[O_LHP + (size_t)(l * BP + b) * 1024 + U.chn] = hv;
                        }
                }
            }
            }
            {
            KArgs KA = kargs(); unsigned char* ws = KA->ws; TIDS(); GWS();
            const bf16* Zb = (const bf16*)(ws + WS_Z); bf16* MIXb = (bf16*)(ws + WS_MIX); const float* rel_bias = KA->in[22];
            for (int un = bid; un < 256; un += G) {
                __syncthreads();
                const int b = un >> 6, hd = (un >> 3) & 7, cg = un & 7;
                LAS float* tbl = (LAS float*)(lds + 2 * AK_BYTES + 2 * AV_BYTES);
                for (int e = tid; e < 257; e += 512) tbl[e] = rel_bias[((size_t)l * 8 + hd) * 257 + e] * LOG2E;
                const int first = (4 * cg - 8) > 0 ? (4 * cg - 8) : 0, ntiles = 2 * (4 * cg + 3 - first + 1);
                const int cq = 4 * cg + (wave >> 1), r = lane & 31;
                const size_t qrowi = (size_t)(b * TP + cq * 64 + 32 * (wave & 1) + r);
                AttnWave W; W.active = true; W.wr = true; W.qrow = Zb + qrowi * DIN + C_QC + hd * 64; W.orow = MIXb + qrowi * DM + 1536 + hd * 64;
                W.qpos = cq * 64 + 32 * (wave & 1) + r; W.m0 = -1e30f; W.l0 = 0.f;
                SrcZ src{Zb + (size_t)(b * TP) * DIN, 64 * first, C_KC + hd * 64, C_VC + hd * 64};
                const int klo = (cq - 8) > first ? (cq - 8) : first;
                RelBandP rel{2 * (klo - first), 2 * (cq - first) + 1};
                attn_run<true, true, SrcZ, RelBandP>(lds, lds + 2 * AK_BYTES, tbl, tid, ntiles, 64 * first, -1, src, rel, W);
            }
            }
            {
            KArgs KA = kargs(); unsigned char* ws = KA->ws; TIDS(); GWS();
            const bf16* Zb = (const bf16*)(ws + WS_Z); bf16* MIXb = (bf16*)(ws + WS_MIX); const float* swa_sink = KA->in[14];
            for (int un = bid; un < 256; un += G) {
                __syncthreads();
                const int b = un >> 6, c = (un >> 1) & 31, kvh = un & 1;
                const int first = (c - 2) > 0 ? (c - 2) : 0, ntiles = 2 * (c - first + 1);
                const int gq = wave >> 1, r = lane & 31;
                const size_t qrowi = (size_t)(b * TP + c * 64 + 32 * (wave & 1) + r);
                AttnWave W; W.active = true; W.wr = true; W.qrow = Zb + qrowi * DIN + C_QA + kvh * 256 + gq * 64; W.orow = MIXb + qrowi * DM + kvh * 256 + gq * 64;
                W.qpos = 0; W.m0 = swa_sink[l * 8 + kvh * 4 + gq] * LOG2E; W.l0 = (lane < 32) ? 1.0f : 0.f;
                SrcZ src{Zb + (size_t)(b * TP) * DIN, 64 * first, C_KA + kvh * 64, C_VA + kvh * 64};
                attn_run<true, false, SrcZ, RelAll>(lds, lds + 2 * AK_BYTES, nullptr, tid, ntiles, 0, -1, src, RelAll{}, W);
            }
            }
            {
            KArgs KA = kargs(); unsigned char* ws = KA->ws; TIDS(); GWS();
            const bf16* Zb = (const bf16*)(ws + WS_Z); bf16* MIXb = (bf16*)(ws + WS_MIX); float* out = KA->out;
            for (int un = bid; un < 128; un += G) {
                if (wave < 4) {
                    const int bs = un >> 4, n = un & 15, dq = wave;
                    LruUnit U; U.zseq = Zb + (size_t)(MP + bs * TS) * DIN; U.prefix = KA->in[9] + ((size_t)(l * BS + bs) * 3) * 1024;
                    lru_setup(U, l, n, dq, KA->in[15], KA->in[16], KA->in[17], KA->in[18], KA->in[19], KA->in[20], KA->in[21]);
                    float Ac = 1.0f, Hc = 0.f, P[4], hl[4];
                    lru_tile(U, 0, Ac, Hc, P, hl);
                    const float hin = KA->in[8][(size_t)(l * BS + bs) * 1024 + U.chn];
                    const int tq = lane >> 4;
#pragma unroll
                    for (int j = 0; j < 4; ++j) {
                        const int t = 4 * tq + j; const size_t row = (size_t)(MP + bs * TS + t);
                        const float hv = hl[j] + P[j] * hin;
                        const float gb = bf2f(Zb[row * DIN + C_GB + U.chn]);
                        MIXb[row * DM + 512 + U.chn] = (bf16)f2bf(hv * gelu_tanh(gb));
                        if (t == TS - 1) out[O_LHS + (size_t)(l * BS + bs) * 1024 + U.chn] = hv;
                    }
                }
            }
            }
            {
            KArgs KA = kargs(); unsigned char* ws = KA->ws; TIDS(); GWS();
            const bf16* Zb = (const bf16*)(ws + WS_Z); bf16* MIXb = (bf16*)(ws + WS_MIX); const float* swa_sink = KA->in[14];
            for (int un = bid; un < 16; un += G) {
                __syncthreads();
                const int bs = un >> 1, kvh = un & 1, r = lane & 31;
                const int gq = 2 * (wave & 1) + (r >> 4), t = r & 15;
                const size_t qrowi = (size_t)(MP + bs * TS + t);
                AttnWave W; W.active = wave < 2; W.wr = true; W.qrow = Zb + qrowi * DIN + C_QA + kvh * 256 + gq * 64; W.orow = MIXb + qrowi * DM + kvh * 256 + gq * 64;
                W.qpos = 0; W.m0 = swa_sink[l * 8 + kvh * 4 + gq] * LOG2E; W.l0 = (lane < 32) ? 1.0f : 0.f;
                SrcCache src{KA->in[4] + ((size_t)(l * BS + bs) * 128 * 2 + kvh) * 64, KA->in[5] + ((size_t)(l * BS + bs) * 128 * 2 + kvh) * 64, 2 * 64, 4,
                             Zb + (size_t)(MP + bs * TS) * DIN, C_KA + kvh * 64, C_VA + kvh * 64};
                attn_run<true, false, SrcCache, RelAll>(lds, lds + 2 * AK_BYTES, nullptr, tid, 5, 0, 4, src, RelAll{}, W);
            }
            }
            {
            KArgs KA = kargs(); unsigned char* ws = KA->ws; TIDS(); GWS();
            const bf16* Zb = (const bf16*)(ws + WS_Z); bf16* MIXb = (bf16*)(ws + WS_MIX); const float* rel_bias = KA->in[22];
            for (int un = bid; un < 8; un += G) {
                __syncthreads();
                const int bs = un, hd = wave, r = lane & 31, t = r & 15;
                LAS unsigned char* wb = lds + wave * (AK_BYTES + AV_BYTES + ATBL_BYTES);
                LAS float* tbl = (LAS float*)(wb + AK_BYTES + AV_BYTES);
                for (int e = lane; e < 257; e += 64) tbl[e] = rel_bias[((size_t)l * 8 + hd) * 257 + e] * LOG2E;
                const size_t qrowi = (size_t)(MP + bs * TS + t);
                AttnWave W; W.active = true; W.wr = r < 16; W.qrow = Zb + qrowi * DIN + C_QC + hd * 64; W.orow = MIXb + qrowi * DM + 1536 + hd * 64;
                W.qpos = t; W.m0 = -1e30f; W.l0 = 0.f;
                SrcCache src{KA->in[6] + ((size_t)(l * BS + bs) * 512 * 8 + hd) * 64, KA->in[7] + ((size_t)(l * BS + bs) * 512 * 8 + hd) * 64, 8 * 64, 16,
                             Zb + (size_t)(MP + bs * TS) * DIN, C_KC + hd * 64, C_VC + hd * 64};
                attn_run<false, true, SrcCache, RelAll>(wb, wb + AK_BYTES, tbl, lane, 17, -512, 16, src, RelAll{}, W);
            }
            }
            __syncthreads();
        }
        SEAM(pb + 1);
        if (IN(pb + 2)) {
            KArgs KA = kargs(); unsigned char* ws = KA->ws;
            pg8::Gemm g{(const bf16*)(ws + WS_MIX), (const bf16*)(ws + WS_WOUT) + (size_t)l * DM * DM, MT, DM, DM}; pg8::StaticOrder S; { int G_ = gridDim.x, bid_ = blockIdx.x; asm volatile("" : "+s"(G_), "+s"(bid_)); S.init(MT, DM, G_, bid_); }
            pg8::EpiF32 E{(float*)(ws + WS_T), DM};
            pg8::gemm_phase<pg8::EpiF32, pg8::StaticOrder, true, true>(lds, g, S, E, wave0 * 64 + hw_lane());
        }
        SEAM(pb + 2);
        if (IN(pb + 3)) {
            KArgs KA = kargs(); unsigned char* ws = KA->ws; TIDS(); GWS();
            const float* x_p = KA->in[0]; const float* x_s = KA->in[1]; const float* g_post_mix = KA->in[24]; const float* g_pre_mlp = KA->in[25]; float* out = KA->out;
            const float* MOD = (const float*)(ws + WS_MOD); bf16* Hb = (bf16*)(ws + WS_H); const float* Tb = (const float*)(ws + WS_T);
            for (int row = gw; row < MR; row += NGW) {
                f32x4 tv[8]; ROW_LD(tv, Tb + (size_t)row * DM);
                const float rt_ = 1.0f / sqrtf(row_sumsq(tv) * (1.0f / DM) + RMS_EPS);
                const float* xr = (l == 0) ? (row < MP ? x_p + (size_t)row * DM : x_s + (size_t)(row - MP) * DM) : out + (size_t)row * DM;
                f32x4 xv[8]; ROW_LD(xv, xr);
                const float* md = MOD + ((size_t)l * 12 + mod_row_of(row)) * NMOD;
                const f32x4* ga4 = (const f32x4*)(md + 2 * DM) + lane; const f32x4* gp4 = (const f32x4*)(g_post_mix + (size_t)l * DM) + lane;
                f32x4* o4 = (f32x4*)(out + (size_t)row * DM) + lane;
#pragma unroll
                for (int j = 0; j < 8; ++j) { xv[j] = xv[j] + ga4[64 * j] * (tv[j] * rt_ * gp4[64 * j]); o4[64 * j] = xv[j]; }
                const float rx = 1.0f / sqrtf(row_sumsq(xv) * (1.0f / DM) + RMS_EPS);
                norm_mod_store(xv, rx, g_pre_mlp + (size_t)l * DM, md + 4 * DM, md + 3 * DM, Hb + (size_t)row * DM, lane);
            }
        }
        SEAM(pb + 3);
        if (IN(pb + 4)) {
            KArgs KA = kargs(); unsigned char* ws = KA->ws;
            pg8::Gemm g{(const bf16*)(ws + WS_H), (const bf16*)(ws + WS_WUP) + (size_t)l * DFF * DM, MT, DFF, DM}; pg8::StaticOrder S; { int G_ = gridDim.x, bid_ = blockIdx.x; asm volatile("" : "+s"(G_), "+s"(bid_)); S.init(MT, DFF, G_, bid_); }
            pg8::EpiRelu2 E{(bf16*)(ws + WS_F1), DFF};
            pg8::gemm_phase<pg8::EpiRelu2, pg8::StaticOrder, true, true>(lds, g, S, E, wave0 * 64 + hw_lane());
        }
        SEAM(pb + 4);
        if (IN(pb + 5)) {
            KArgs KA = kargs(); unsigned char* ws = KA->ws;
            pg8::Gemm g{(const bf16*)(ws + WS_F1), (const bf16*)(ws + WS_WDN) + (size_t)l * DM * DFF, MT, DM, DFF}; pg8::StaticOrder S; { int G_ = gridDim.x, bid_ = blockIdx.x; asm volatile("" : "+s"(G_), "+s"(bid_)); S.init(MT, DM, G_, bid_); }
            pg8::EpiF32 E{(float*)(ws + WS_T), DM};
            pg8::gemm_phase<pg8::EpiF32, pg8::StaticOrder, true, true>(lds, g, S, E, wave0 * 64 + hw_lane());
        }
        SEAM(pb + 5);
        if (IN(pb + 6)) {
            KArgs KA = kargs(); unsigned char* ws = KA->ws; TIDS(); GWS();
            const float* g_post_mlp = KA->in[28]; const float* g_pre_mix = KA->in[12]; float* out = KA->out;
            const float* MOD = (const float*)(ws + WS_MOD); bf16* Hb = (bf16*)(ws + WS_H); const float* Tb = (const float*)(ws + WS_T);
            for (int row = gw; row < MR; row += NGW) {
                f32x4 tv[8]; ROW_LD(tv, Tb + (size_t)row * DM);
                const float rt_ = 1.0f / sqrtf(row_sumsq(tv) * (1.0f / DM) + RMS_EPS);
                f32x4 xv[8]; ROW_LD(xv, out + (size_t)row * DM);
                const float* md = MOD + ((size_t)l * 12 + mod_row_of(row)) * NMOD;
                const f32x4* gm4 = (const f32x4*)(md + 5 * DM) + lane; const f32x4* gp4 = (const f32x4*)(g_post_mlp + (size_t)l * DM) + lane;
                f32x4* o4 = (f32x4*)(out + (size_t)row * DM) + lane;
#pragma unroll
                for (int j = 0; j < 8; ++j) { xv[j] = xv[j] + gm4[64 * j] * (tv[j] * rt_ * gp4[64 * j]); o4[64 * j] = xv[j]; }
                if (l + 1 < NL) {
                    const float rx = 1.0f / sqrtf(row_sumsq(xv) * (1.0f / DM) + RMS_EPS);
                    const float* md2 = MOD + ((size_t)(l + 1) * 12 + mod_row_of(row)) * NMOD;
                    norm_mod_store(xv, rx, g_pre_mix + (size_t)(l + 1) * DM, md2 + DM, md2, Hb + (size_t)row * DM, lane);
                }
            }
        }
        SEAM(pb + 6);
    }
#undef IN
#undef SEAM
}

#ifndef MK_SINGLE
#define MK_SINGLE 0
#endif
extern "C" void kernel_launch(void* const* d_in, const int* in_sizes, int n_in, void* d_out, int out_size, void* d_ws, size_t ws_size, hipStream_t stream) {
    static int grid = 0;
    if (grid == 0) {
        if (n_in != 29 || in_sizes[0] != MP * DM || (size_t)out_size != O_END || ws_size < WS_END) {
            fprintf(stderr, "kernel_launch: unexpected shapes: n_in %d in0 %d out %d (want %zu) ws %zu (want %zu); nothing launched\n", n_in, n_in > 0 ? in_sizes[0] : -1, out_size, (size_t)O_END, ws_size, (size_t)WS_END);
            grid = -1; return; }
        int dev = 0, cus = 0, per_cu = 0;
        if (hipGetDevice(&dev) != hipSuccess || hipDeviceGetAttribute(&cus, hipDeviceAttributeMultiprocessorCount, dev) != hipSuccess) { fprintf(stderr, "kernel_launch: device query failed\n"); grid = -1; return; }
        if (hipFuncSetAttribute((const void*)mk_fwd, hipFuncAttributeMaxDynamicSharedMemorySize, LDS_BYTES) != hipSuccess) { fprintf(stderr, "kernel_launch: hipFuncSetAttribute failed\n"); grid = -1; return; }
        if (hipOccupancyMaxActiveBlocksPerMultiprocessor(&per_cu, (const void*)mk_fwd, NWAVES * 64, LDS_BYTES) != hipSuccess || per_cu < 1)
            fprintf(stderr, "kernel_launch: note: occupancy query reports %d workgroups per CU\n", per_cu);
        (void)hipGetLastError();
        grid = cus;
    }
    if (grid < 0) return;
    if (hipMemsetAsync((char*)d_ws + WS_CTL, 0, CTL_ZERO_BYTES, stream) != hipSuccess) { fprintf(stderr, "kernel_launch: memset failed\n"); return; }
    Args a{};
    for (int i = 0; i < 29; ++i) a.in[i] = (const float*)d_in[i];
    a.out = (float*)d_out; a.ws = (unsigned char*)d_ws;
#if MK_SINGLE
    a.ph_lo = 0; a.ph_hi = N_PHASES;
    hipLaunchKernelGGL(mk_fwd, dim3(grid), dim3(NWAVES * 64), LDS_BYTES, stream, a);
#else
    for (int p = 0; p < N_PHASES; ++p) {
        a.ph_lo = p; a.ph_hi = p + 1;
        hipLaunchKernelGGL(mk_fwd, dim3(grid), dim3(NWAVES * 64), LDS_BYTES, stream, a);
    }
#endif
    const hipError_t le = hipPeekAtLastError();
    if (le != hipSuccess) fprintf(stderr, "kernel_launch: launch failed: %s\n", hipGetErrorName(le));
}
```

```cpp
#include <hip/hip_runtime.h>
#include <cstdio>
#include <cstdint>
#include <cmath>
#define MK_SINGLE 1
#define ATT_ROT 1
namespace pg8 {
#define PG8_LAS __attribute__((address_space(3)))
typedef unsigned short bf16_t;
typedef short bf16x8 __attribute__((ext_vector_type(8)));
typedef float f32x4 __attribute__((ext_vector_type(4)));
typedef unsigned u32x4 __attribute__((ext_vector_type(4)));
constexpr int BM = 256, BK = 64, HALF = 128, HTB = HALF * BK * 2  , STAGE_BYTES = 8 * HTB, NXCD = 8, WGM = 8;

__host__ __device__ __forceinline__ int lds_byte(int r, int c) { const int st = (r >> 4) * 2 + (c >> 5), rr = r & 15, cc = c & 31, ob = rr * 64 + cc * 2; return st * 1024 + (ob ^ (((ob >> 9) & 1) << 5)); }
__host__ __device__ __forceinline__ void stage_rc(int b, int& R, int& C) { const int st = b / 1024, sb = b % 1024, swz = sb ^ (((sb >> 9) & 1) << 5); R = (st >> 1) * 16 + swz / 64; C = (st & 1) * 32 + (swz % 64) / 2; }
__host__ __device__ __forceinline__ int perm32(int rho) { const int n = rho >> 4, i = rho & 15; return 8 * (i >> 2) + 4 * n + (i & 3); }

struct Unit { int pm, pn; };
struct Gemm { const bf16_t* A; const bf16_t* Bt; int M, N, K; };

struct StaticOrder {
    int nM, nN, nwg, G, c, rep;
    __host__ __device__ void init(int M, int N, int G_, int c_, int rep_ = 1) { nM = M / BM; nN = N / BM; nwg = nM * nN; G = G_; c = c_; rep = rep_; }
    __host__ __device__ bool next(int i, Unit& u) const {
        long L = (long)i * G + c; if (L >= (long)nwg * rep) return false;
        L %= nwg;
        int wgid = (int)L; { const int q = nwg / NXCD, r = nwg % NXCD, xcd = wgid % NXCD, off = wgid / NXCD; wgid = (xcd < r ? xcd * (q + 1) : r * (q + 1) + (xcd - r) * q) + off; }
        const int nig = WGM * nN, gid = wgid / nig, fm = gid * WGM, gsz = (nM - fm) < WGM ? (nM - fm) : WGM;
        u.pm = fm + ((wgid % nig) % gsz); u.pn = (wgid % nig) / gsz; return true;
    }
    __device__ __forceinline__ void a_ready(const Unit&) const {}
    __device__ __forceinline__ void done(const Unit&) const {}
};

__device__ __forceinline__ unsigned cvt_pk_bf16(float lo, float hi) { unsigned r; asm volatile("v_cvt_pk_bf16_f32 %0, %1, %2" : "=v"(r) : "v"(lo), "v"(hi)); return r; }
typedef float f32x2 __attribute__((ext_vector_type(2)));

constexpr int X_DM = 2048, X_MP = 8192, X_MS = 128, X_DIN = 4352, X_DFF = 8192, X_NL = 4;
constexpr size_t O_YP = 0, O_YS = O_YP + (size_t)X_MP * X_DM, O_SKP = O_YS + (size_t)X_MS * X_DM, O_SVP = O_SKP + (size_t)X_NL * 4 * 128 * 128,
                 O_BKP = O_SVP + (size_t)X_NL * 4 * 128 * 128, O_BVP = O_BKP + (size_t)X_NL * 4 * 512 * 512, O_LHP = O_BVP + (size_t)X_NL * 4 * 512 * 512,
                 O_LCP = O_LHP + (size_t)X_NL * 4 * 1024, O_SKS = O_LCP + (size_t)X_NL * 4 * 3 * 1024, O_SVS = O_SKS + (size_t)X_NL * 8 * 16 * 128,
                 O_BKS = O_SVS + (size_t)X_NL * 8 * 16 * 128, O_BVS = O_BKS + (size_t)X_NL * 8 * 16 * 512, O_LHS = O_BVS + (size_t)X_NL * 8 * 16 * 512,
                 O_LCS = O_LHS + (size_t)X_NL * 8 * 1024, O_END = O_LCS + (size_t)X_NL * 8 * 3 * 1024;

#ifndef EPI_SC1
#define EPI_SC1 0
#endif
__device__ __forceinline__ void st16_wt(void* p, u32x4 w) {
#if EPI_SC1
    asm volatile("global_store_dwordx4 %0, %1, off sc1\n\ts_nop 1" :: "v"(p), "v"(w) : "memory");
#else
    *(u32x4*)p = w;
#endif
}
struct EpiF32 {
    static constexpr bool PERM = false, ADJ = false, AFTER_DRAIN = false;
    float* C; int ldc;
    __device__ __forceinline__ void operator()(const f32x4 (&acc)[2][2][4][2], const Unit& u, int wr, int wc, int fr, int fq) const {
        const int row0 = u.pm * BM + wr * 64 + fr, col0 = u.pn * BM + wc * 32 + 4 * fq;
#pragma unroll
        for (int ai = 0; ai < 2; ++ai)
#pragma unroll
            for (int m = 0; m < 4; ++m) { float* rowp = C + (size_t)(row0 + ai * HALF + m * 16) * ldc + col0;
#pragma unroll
                for (int bj = 0; bj < 2; ++bj)
#pragma unroll
                    for (int n = 0; n < 2; ++n) *(f32x4*)(rowp + bj * HALF + n * 16) = acc[ai][bj][m][n]; }
    }
};
#ifndef EPI_RELU_ASM
#define EPI_RELU_ASM 1
#endif
__device__ __forceinline__ f32x2 relu2_pk(float x, float y) {
    f32x2 m, r;
    asm("v_max_f32 %0, 0, %1" : "=v"(m.x) : "v"(x));
    asm("v_max_f32 %0, 0, %1" : "=v"(m.y) : "v"(y));
    asm("v_pk_mul_f32 %0, %1, %1" : "=v"(r) : "v"(m));
    return r;
}
struct EpiRelu2 {
    static constexpr bool PERM = true, ADJ = true, AFTER_DRAIN = false;
    bf16_t* O; int ldc;
    __device__ __forceinline__ void operator()(const f32x4 (&acc)[2][2][4][2], const Unit& u, int wr, int wc, int fr, int fq) const {
        const int row0 = u.pm * BM + wr * 64 + fr, col0 = u.pn * BM + wc * 64 + 8 * fq;
#pragma unroll
        for (int ai = 0; ai < 2; ++ai)
#pragma unroll
            for (int m = 0; m < 4; ++m) { bf16_t* rowp = O + (size_t)(row0 + ai * HALF + m * 16) * ldc + col0;
#pragma unroll
                for (int bj = 0; bj < 2; ++bj) { f32x4 v0 = acc[ai][bj][m][0], v1 = acc[ai][bj][m][1];
#if EPI_RELU_ASM
                    u32x4 w;
                    { const f32x2 a = relu2_pk(v0[0], v0[1]), b = relu2_pk(v0[2], v0[3]), c = relu2_pk(v1[0], v1[1]), d = relu2_pk(v1[2], v1[3]);
                      w.x = cvt_pk_bf16(a[0], a[1]); w.y = cvt_pk_bf16(b[0], b[1]); w.z = cvt_pk_bf16(c[0], c[1]); w.w = cvt_pk_bf16(d[0], d[1]); }
#else
#pragma unroll
                    for (int e = 0; e < 4; ++e) { v0[e] = v0[e] > 0.f ? v0[e] : 0.f; v1[e] = v1[e] > 0.f ? v1[e] : 0.f; }
                    v0 = v0 * v0; v1 = v1 * v1;
                    u32x4 w; w.x = cvt_pk_bf16(v0[0], v0[1]); w.y = cvt_pk_bf16(v0[2], v0[3]); w.z = cvt_pk_bf16(v1[0], v1[1]); w.w = cvt_pk_bf16(v1[2], v1[3]);
#endif
                    st16_wt(rowp + bj * 32, w); } }
    }
};
struct EpiBf16 {
    static constexpr bool PERM = true, ADJ = true, AFTER_DRAIN = false;
    bf16_t* O; int ldc;
    __device__ __forceinline__ void operator()(const f32x4 (&acc)[2][2][4][2], const Unit& u, int wr, int wc, int fr, int fq) const {
        const int row0 = u.pm * BM + wr * 64 + fr, col0 = u.pn * BM + wc * 64 + 8 * fq;
#pragma unroll
        for (int ai = 0; ai < 2; ++ai)
#pragma unroll
            for (int m = 0; m < 4; ++m) { bf16_t* rowp = O + (size_t)(row0 + ai * HALF + m * 16) * ldc + col0;
#pragma unroll
                for (int bj = 0; bj < 2; ++bj) { const f32x4 v0 = acc[ai][bj][m][0], v1 = acc[ai][bj][m][1];
                    u32x4 w; w.x = cvt_pk_bf16(v0[0], v0[1]); w.y = cvt_pk_bf16(v0[2], v0[3]); w.z = cvt_pk_bf16(v1[0], v1[1]); w.w = cvt_pk_bf16(v1[2], v1[3]);
                    st16_wt(rowp + bj * 32, w); } }
    }
};
struct EpiInProj {
    static constexpr bool PERM = true, ADJ = true, AFTER_DRAIN = false;
    bf16_t* Z; float* out; int layer;
    __device__ __forceinline__ void operator()(const f32x4 (&acc)[2][2][4][2], const Unit& u, int wr, int wc, int fr, int fq) const {
        const int row0 = u.pm * BM + wr * 64 + fr, col0 = u.pn * BM + wc * 64 + 8 * fq;
#pragma unroll
        for (int ai = 0; ai < 2; ++ai)
#pragma unroll
            for (int m = 0; m < 4; ++m) { bf16_t* rowp = Z + (size_t)(row0 + ai * HALF + m * 16) * X_DIN + col0;
#pragma unroll
                for (int bj = 0; bj < 2; ++bj) { const f32x4 v0 = acc[ai][bj][m][0], v1 = acc[ai][bj][m][1];
                    u32x4 w; w.x = cvt_pk_bf16(v0[0], v0[1]); w.y = cvt_pk_bf16(v0[2], v0[3]); w.z = cvt_pk_bf16(v1[0], v1[1]); w.w = cvt_pk_bf16(v1[2], v1[3]);
                    st16_wt(rowp + bj * 32, w); } }
        const int pn = u.pn, pm = u.pm;
        const bool rows_state = (pm == 32) || ((pm & 7) >= 6);
        const bool cols_state = (pn >= 2 && pn <= 6) || (pn >= 13);
        if (rows_state && cols_state) {
            const int L = layer;
#pragma unroll
            for (int ai = 0; ai < 2; ++ai)
#pragma unroll
                for (int m = 0; m < 4; ++m) {
                    const int row = row0 + ai * HALF + m * 16;
                    const bool samp = row >= X_MP;
                    int b, t;
                    if (!samp) { b = row >> 11; t = row & 2047; } else { const int rs = row - X_MP; b = rs >> 4; t = rs & 15; }
                    const bool rowok = row < X_MP + X_MS;
#pragma unroll
                    for (int bj = 0; bj < 2; ++bj) {
                        const int col = col0 + bj * 32;
                        float* dst = nullptr;
                        if (pn == 2) {
                            const bool isV = col >= 640; const int c = col - (isV ? 640 : 512);
                            if (!samp) { if (t >= 1920) dst = out + (isV ? O_SVP : O_SKP) + ((size_t)(L * 4 + b) * 128 + (t - 1920)) * 128 + c; }
                            else dst = out + (isV ? O_SVS : O_SKS) + ((size_t)(L * 8 + b) * 16 + t) * 128 + c;
                        } else if (pn <= 6) {
                            const int ch = col - 768;
                            if (!samp) { if (t >= 2045) dst = out + O_LCP + ((size_t)(L * 4 + b) * 3 + (t - 2045)) * 1024 + ch; }
                            else if (t >= 13) dst = out + O_LCS + ((size_t)(L * 8 + b) * 3 + (t - 13)) * 1024 + ch;
                        } else {
                            const bool isV = pn >= 15; const int c = col - (isV ? 3840 : 3328);
                            if (!samp) { if (t >= 1536) dst = out + (isV ? O_BVP : O_BKP) + ((size_t)(L * 4 + b) * 512 + (t - 1536)) * 512 + c; }
                            else dst = out + (isV ? O_BVS : O_BKS) + ((size_t)(L * 8 + b) * 16 + t) * 512 + c;
                        }
                        if (dst != nullptr && rowok) { *(f32x4*)dst = acc[ai][bj][m][0]; *(f32x4*)(dst + 4) = acc[ai][bj][m][1]; }
                    }
                }
        }
    }
};

struct PanelRms {
    unsigned long long* xbuf;
    unsigned* cnt;
    unsigned* tmo;
    unsigned code;
    __device__ __forceinline__ void run(const f32x4 (&st)[2][4], const Unit& u, int wr, int wc, int fr, int fq, PG8_LAS unsigned char* lds, int wid, int lane) const {
        typedef float f32x2v __attribute__((ext_vector_type(2)));
        PG8_LAS f32x4* P = (PG8_LAS f32x4*)lds;
        PG8_LAS f32x2v* S = (PG8_LAS f32x2v*)(lds + 16384);
#pragma unroll
        for (int ai = 0; ai < 2; ++ai)
#pragma unroll
            for (int m = 0; m < 4; ++m) if (fq == 0) P[(ai * HALF + wr * 64 + m * 16 + fr) * 4 + wc] = st[ai][m];
        asm volatile("s_waitcnt lgkmcnt(0)" ::: "memory"); __builtin_amdgcn_s_barrier(); asm volatile("" ::: "memory");
        const int row = wid * 32 + (lane & 31);
        if (lane < 32) {
            const f32x4 a = P[row * 4 + 0], b = P[row * 4 + 1], c = P[row * 4 + 2], d = P[row * 4 + 3];
            const f32x4 s = (a + b) + (c + d);
            unsigned long long* slot = xbuf + ((size_t)(u.pm * BM + row) * 8 + u.pn) * 2;
            __hip_atomic_store(slot, ((unsigned long long)__float_as_uint(s[1]) << 32) | __float_as_uint(s[0]), __ATOMIC_RELAXED, __HIP_MEMORY_SCOPE_AGENT);
            __hip_atomic_store(slot + 1, ((unsigned long long)__float_as_uint(s[3]) << 32) | __float_as_uint(s[2]), __ATOMIC_RELAXED, __HIP_MEMORY_SCOPE_AGENT);
        }
        asm volatile("s_waitcnt vmcnt(0)" ::: "memory");
        if (lane == 0) __hip_atomic_fetch_add(cnt + 64 * u.pm, 1u, __ATOMIC_RELAXED, __HIP_MEMORY_SCOPE_AGENT);
        if (wid == 0) {
            const unsigned long long t0 = __builtin_amdgcn_s_memrealtime(); const unsigned want = 64u;
            for (;;) {
                if ((unsigned)__builtin_amdgcn_readfirstlane(__hip_atomic_load(cnt + 64 * u.pm, __ATOMIC_RELAXED, __HIP_MEMORY_SCOPE_AGENT)) >= want) break;
                if (__builtin_amdgcn_s_memrealtime() - t0 > 2000000ull) {
                    if (lane == 0) { unsigned expect = 0u; __hip_atomic_compare_exchange_strong(tmo + 1, &expect, code | (unsigned)(u.pm & 0xff), __ATOMIC_RELAXED, __ATOMIC_RELAXED, __HIP_MEMORY_SCOPE_AGENT);
                                     __hip_atomic_store(tmo, 1u, __ATOMIC_RELAXED, __HIP_MEMORY_SCOPE_AGENT); }
                    break; }
                __builtin_amdgcn_s_sleep(2);
            }
            __builtin_amdgcn_fence(__ATOMIC_ACQUIRE, "agent");
        }
        asm volatile("s_waitcnt vmcnt(0) lgkmcnt(0)" ::: "memory"); __builtin_amdgcn_s_barrier(); asm volatile("" ::: "memory");
        if (lane < 32) {
            const unsigned long long* slot = xbuf + (size_t)(u.pm * BM + row) * 8 * 2; float s1 = 0.f, s2 = 0.f, s3 = 0.f, s4 = 0.f;
#pragma unroll
            for (int t = 0; t < 8; ++t) { const unsigned long long w0 = __hip_atomic_load(slot + 2 * t, __ATOMIC_RELAXED, __HIP_MEMORY_SCOPE_AGENT), w1 = __hip_atomic_load(slot + 2 * t + 1, __ATOMIC_RELAXED, __HIP_MEMORY_SCOPE_AGENT);
                s1 += __uint_as_float((unsigned)w0); s2 += __uint_as_float((unsigned)(w0 >> 32)); s3 += __uint_as_float((unsigned)w1); s4 += __uint_as_float((unsigned)(w1 >> 32)); }
            const float rt = 1.0f / sqrtf(s1 * (1.0f / X_DM) + 1e-6f);
            const float q = s2 + 2.0f * rt * s3 + rt * rt * s4;
            S[row] = (f32x2v){rt, 1.0f / sqrtf(fmaxf(q, 0.f) * (1.0f / X_DM) + 1e-6f)};
        }
        asm volatile("s_waitcnt lgkmcnt(0)" ::: "memory"); __builtin_amdgcn_s_barrier(); asm volatile("" ::: "memory");
    }
};
struct EpiFuse {
    static constexpr bool PERM = false, ADJ = false, AFTER_DRAIN = true;
    const float* xin; float* xout; bf16_t* H;
    const float* vc; const float* ve; const float* vf;
    int bstride;
    PanelRms st;
    __device__ __forceinline__ void fused(f32x4 (&acc)[2][2][4][2], const Unit& u, int wr, int wc, int fr, int fq, PG8_LAS unsigned char* lds, int wid, int lane) const {
        typedef float f32x2v __attribute__((ext_vector_type(2))); typedef unsigned u32x2v __attribute__((ext_vector_type(2)));
        PG8_LAS unsigned char* xl = lds + 20480;
        PG8_LAS unsigned* tp = (PG8_LAS unsigned*)xl + (wid * 64 + lane);
        PG8_LAS unsigned* tq = tp + 32 * 512; asm volatile("" : "+v"(tq));
#define TPW(w) (((w) < 32) ? tp[(w) * 512] : tq[((w) - 32) * 512])
        const PG8_LAS f32x2v* S = (const PG8_LAS f32x2v*)(lds + 16384);
        const int col0 = u.pn * BM + wc * 32 + 4 * fq;
        const size_t boff = (size_t)(u.pm >> 3) * bstride + col0;
        float s1[2][4];
#pragma unroll
        for (int ai = 0; ai < 2; ++ai)
#pragma unroll
            for (int m = 0; m < 4; ++m) { float q = 0.f;
#pragma unroll
                for (int bj = 0; bj < 2; ++bj)
#pragma unroll
                    for (int n = 0; n < 2; ++n) { const f32x4 t = acc[ai][bj][m][n]; q += (t[0] * t[0] + t[1] * t[1]) + (t[2] * t[2] + t[3] * t[3]);
                        const int w = ((ai * 4 + m) * 4 + bj * 2 + n) * 2; TPW(w) = cvt_pk_bf16(t[0], t[1]); TPW(w + 1) = cvt_pk_bf16(t[2], t[3]); }
                s1[ai][m] = q; asm volatile("" ::: "memory"); __builtin_amdgcn_sched_barrier(0); }
        asm volatile("s_waitcnt lgkmcnt(0)" ::: "memory"); __builtin_amdgcn_sched_barrier(0);
        f32x4 cv[2][2];
#pragma unroll
        for (int bj = 0; bj < 2; ++bj)
#pragma unroll
            for (int n = 0; n < 2; ++n) cv[bj][n] = *(const f32x4*)(vc + boff + bj * HALF + n * 16);
        f32x4 stt[2][4];
#pragma unroll
        for (int ai = 0; ai < 2; ++ai) {
            f32x4 xv[4][2][2];
#pragma unroll
            for (int m = 0; m < 4; ++m) { const size_t off = (size_t)(u.pm * BM + ai * HALF + wr * 64 + m * 16 + fr) * X_DM + col0;
#pragma unroll
                for (int bj = 0; bj < 2; ++bj)
#pragma unroll
                    for (int n = 0; n < 2; ++n) xv[m][bj][n] = *(const f32x4*)(xin + off + bj * HALF + n * 16); }
#pragma unroll
            for (int m = 0; m < 4; ++m) { float a1 = s1[ai][m], s2 = 0.f, s3 = 0.f, s4 = 0.f;
#pragma unroll
                for (int bj = 0; bj < 2; ++bj)
#pragma unroll
                    for (int n = 0; n < 2; ++n) { const int w = ((ai * 4 + m) * 4 + bj * 2 + n) * 2; const unsigned p0 = TPW(w), p1 = TPW(w + 1);
                        const f32x4 t = {__uint_as_float(p0 << 16), __uint_as_float(p0 & 0xffff0000u), __uint_as_float(p1 << 16), __uint_as_float(p1 & 0xffff0000u)};
                        const f32x4 x = xv[m][bj][n]; const f32x4 ct = cv[bj][n] * t;
                        s2 += (x[0] * x[0] + x[1] * x[1]) + (x[2] * x[2] + x[3] * x[3]);
                        s3 += (x[0] * ct[0] + x[1] * ct[1]) + (x[2] * ct[2] + x[3] * ct[3]); s4 += (ct[0] * ct[0] + ct[1] * ct[1]) + (ct[2] * ct[2] + ct[3] * ct[3]); }
                a1 += __shfl_xor(a1, 16); a1 += __shfl_xor(a1, 32); s2 += __shfl_xor(s2, 16); s2 += __shfl_xor(s2, 32);
                s3 += __shfl_xor(s3, 16); s3 += __shfl_xor(s3, 32); s4 += __shfl_xor(s4, 16); s4 += __shfl_xor(s4, 32);
                stt[ai][m] = (f32x4){a1, s2, s3, s4}; }
            asm volatile("" ::: "memory");
        }
        st.run(stt, u, wr, wc, fr, fq, lds, wid, lane);
        f32x4 ev[2][2], fv[2][2];
#pragma unroll
        for (int bj = 0; bj < 2; ++bj)
#pragma unroll
            for (int n = 0; n < 2; ++n) { ev[bj][n] = H ? *(const f32x4*)(ve + boff + bj * HALF + n * 16) : (f32x4){0.f, 0.f, 0.f, 0.f}; fv[bj][n] = H ? *(const f32x4*)(vf + boff + bj * HALF + n * 16) : (f32x4){0.f, 0.f, 0.f, 0.f}; }
#pragma unroll
        for (int ai = 0; ai < 2; ++ai) {
            f32x4 xv[4][2][2];
#pragma unroll
            for (int m = 0; m < 4; ++m) { const size_t off = (size_t)(u.pm * BM + ai * HALF + wr * 64 + m * 16 + fr) * X_DM + col0;
#pragma unroll
                for (int bj = 0; bj < 2; ++bj)
#pragma unroll
                    for (int n = 0; n < 2; ++n) xv[m][bj][n] = *(const f32x4*)(xin + off + bj * HALF + n * 16); }
#pragma unroll
            for (int m = 0; m < 4; ++m) { const int r = ai * HALF + wr * 64 + m * 16 + fr; const f32x2v sr = S[r]; const size_t off = (size_t)(u.pm * BM + r) * X_DM + col0;
#pragma unroll
                for (int bj = 0; bj < 2; ++bj)
#pragma unroll
                    for (int n = 0; n < 2; ++n) { const int w = ((ai * 4 + m) * 4 + bj * 2 + n) * 2; const unsigned p0 = TPW(w), p1 = TPW(w + 1);
                        const f32x4 t = {__uint_as_float(p0 << 16), __uint_as_float(p0 & 0xffff0000u), __uint_as_float(p1 << 16), __uint_as_float(p1 & 0xffff0000u)};
                        const f32x4 x1 = xv[m][bj][n] + (t * sr.x) * cv[bj][n];
                        *(f32x4*)(xout + off + bj * HALF + n * 16) = x1;
                        if (H) { const f32x4 h = x1 * sr.y * ev[bj][n] + fv[bj][n]; u32x2v w2; w2.x = cvt_pk_bf16(h[0], h[1]); w2.y = cvt_pk_bf16(h[2], h[3]); *(u32x2v*)(H + off + bj * HALF + n * 16) = w2; } } }
            asm volatile("" ::: "memory");
        }
    }
};
#undef TPW
template <class Epi, class Sched, bool ALIGN_EPI = false, bool SP2 = false>
__device__ __forceinline__ void gemm_phase(PG8_LAS unsigned char* lds, const Gemm g, const Sched& S, const Epi& E, int tid_in) {
    int tid_ = tid_in; asm volatile("" : "+v"(tid_));
    const int tid = tid_, wid = __builtin_amdgcn_readfirstlane(tid >> 6), lane = tid & 63, wr = wid >> 2, wc = wid & 3, fr = lane & 15, fq = lane >> 4;
    int K_ = g.K; asm volatile("" : "+s"(K_));
    const int K = K_, nt = K / BK;
    unsigned voffA[2], voffB[2];
#pragma unroll
    for (int i = 0; i < 2; ++i) { int R, C; stage_rc(tid * 16 + i * 8192, R, C); const int Rb = Epi::ADJ ? (64 * (R >> 5) + perm32(R & 31)) : (Epi::PERM ? ((R & ~31) + perm32(R & 31)) : R);
        voffA[i] = (unsigned)(R * K + C) * 2u; voffB[i] = (unsigned)(Rb * K + C) * 2u; }
    const size_t kstep = (size_t)(BK * 2);
    const size_t hstep = (size_t)HALF * K * 2;
    const size_t bhstep = Epi::ADJ ? (size_t)32 * K * 2 : hstep;
    const size_t tstep = 2 * hstep;
    const unsigned ldsw = (unsigned)wid * 1024u;
    const int aoff = lds_byte(wr * 64 + fr, fq * 8), boff = lds_byte(wc * 32 + fr, fq * 8);
#define PG8_SA(b, h) (((b) * 2 + (h)) * HTB)
#define PG8_SB(b, h) ((4 + (b) * 2 + (h)) * HTB)
#define PG8_STAGE(bufoff, gbase, voff) do { _Pragma("unroll") for (int _i = 0; _i < 2; ++_i) \
        __builtin_amdgcn_global_load_lds((const unsigned*)((const char*)(gbase) + (voff)[_i]), (PG8_LAS unsigned*)(lds + (bufoff) + ldsw + _i * 8192), 16, 0, 0); } while (0)
#define PG8_LDA(dst, b, h) do { _Pragma("unroll") for (int m = 0; m < 4; ++m) _Pragma("unroll") for (int k = 0; k < 2; ++k) dst[m][k] = *(const PG8_LAS bf16x8*)(lds + PG8_SA(b, h) + aoff + m * 2048 + k * 1024); } while (0)
#define PG8_LDB(dst, b, h) do { _Pragma("unroll") for (int n = 0; n < 2; ++n) _Pragma("unroll") for (int k = 0; k < 2; ++k) dst[n][k] = *(const PG8_LAS bf16x8*)(lds + PG8_SB(b, h) + boff + n * 2048 + k * 1024); } while (0)
#define PG8_MMA(ai, bj, At, Bt) do { __builtin_amdgcn_s_setprio(1); _Pragma("unroll") for (int m = 0; m < 4; ++m) _Pragma("unroll") for (int n = 0; n < 2; ++n) _Pragma("unroll") for (int k = 0; k < 2; ++k) \
        acc[ai][bj][m][n] = __builtin_amdgcn_mfma_f32_16x16x32_bf16(Bt[n][k], At[m][k], acc[ai][bj][m][n], 0, 0, 0); __builtin_amdgcn_s_setprio(0); } while (0)
#define PG8_WAIT_V(n) asm volatile("s_waitcnt vmcnt(" #n ")" ::: "memory")
#define PG8_WAIT_L(n) asm volatile("s_waitcnt lgkmcnt(" #n ")" ::: "memory")
#define PG8_BAR __builtin_amdgcn_s_barrier()
#define PG8_SCHED __builtin_amdgcn_sched_barrier(0)
    Unit cur, nxt; int ui = 0;
    if (!S.next(0, cur)) return;
    f32x4 acc[2][2][4][2];
#pragma unroll
    for (int a = 0; a < 2; ++a)
#pragma unroll
        for (int b = 0; b < 2; ++b)
#pragma unroll
            for (int m = 0; m < 4; ++m)
#pragma unroll
                for (int n = 0; n < 2; ++n) acc[a][b][m][n] = (f32x4){0.f, 0.f, 0.f, 0.f};
    bf16x8 At[4][2], B0[2][2], B1[2][2];
    const char* cA = (const char*)g.A + (size_t)cur.pm * tstep; const char* cB = (const char*)g.Bt + (size_t)cur.pn * tstep;
    S.a_ready(cur);
    if constexpr (SP2) {
        PG8_STAGE(PG8_SB(0, 0), cB, voffB); PG8_STAGE(PG8_SB(0, 1), cB + bhstep, voffB); PG8_STAGE(PG8_SA(0, 0), cA, voffA); PG8_STAGE(PG8_SA(0, 1), cA + hstep, voffA);
        if (wr == 1) PG8_BAR;
        PG8_WAIT_V(2); PG8_BAR;
        PG8_STAGE(PG8_SB(1, 0), cB + kstep, voffB); PG8_STAGE(PG8_SA(1, 0), cA + kstep, voffA); PG8_STAGE(PG8_SB(1, 1), cB + bhstep + kstep, voffB);
        PG8_WAIT_V(6); PG8_BAR;
    } else {
        PG8_STAGE(PG8_SB(0, 0), cB, voffB); PG8_STAGE(PG8_SA(0, 0), cA, voffA); PG8_STAGE(PG8_SB(0, 1), cB + bhstep, voffB); PG8_STAGE(PG8_SA(0, 1), cA + hstep, voffA);
        if (wr == 1) PG8_BAR;
        PG8_WAIT_V(4); PG8_BAR;
        PG8_STAGE(PG8_SB(1, 0), cB + kstep, voffB); PG8_STAGE(PG8_SA(1, 0), cA + kstep, voffA); PG8_STAGE(PG8_SB(1, 1), cB + bhstep + kstep, voffB);
        PG8_WAIT_V(6); PG8_BAR;
    }
    for (;;) {
        const bool has_next = S.next(ui + 1, nxt);
        const char* nA = has_next ? (const char*)g.A + (size_t)nxt.pm * tstep : cA; const char* nB = has_next ? (const char*)g.Bt + (size_t)nxt.pn * tstep : cB;
        for (int t = 0; t < nt; t += 2) {
            const bool last = (t == nt - 2);
            const char* a1 = cA + (size_t)(t + 1) * kstep;
            const char* a2 = last ? nA : cA + (size_t)(t + 2) * kstep; const char* b2 = last ? nB : cB + (size_t)(t + 2) * kstep;
            const char* a3 = a2 + kstep; const char* b3 = b2 + kstep;
            if (last && has_next) S.a_ready(nxt);
            if constexpr (SP2) {
            PG8_LDB(B0, 0, 0); PG8_LDB(B1, 0, 1); PG8_SCHED; PG8_LDA(At, 0, 0); PG8_STAGE(PG8_SA(1, 1), a1 + hstep, voffA);
            PG8_WAIT_V(8); PG8_WAIT_L(0); PG8_BAR; PG8_MMA(0, 0, At, B0); PG8_MMA(0, 1, At, B1); PG8_BAR; PG8_SCHED;
            PG8_LDA(At, 0, 1); PG8_STAGE(PG8_SB(0, 0), b2, voffB); PG8_STAGE(PG8_SB(0, 1), b2 + bhstep, voffB); PG8_STAGE(PG8_SA(0, 0), a2, voffA);
            PG8_WAIT_V(8); PG8_WAIT_L(0); PG8_BAR; PG8_MMA(1, 0, At, B0); PG8_MMA(1, 1, At, B1); PG8_BAR; PG8_SCHED;
            PG8_LDB(B0, 1, 0); PG8_LDB(B1, 1, 1); PG8_SCHED; PG8_LDA(At, 1, 0); PG8_STAGE(PG8_SA(0, 1), a2 + hstep, voffA);
            PG8_WAIT_V(8); PG8_WAIT_L(0); PG8_BAR; PG8_MMA(0, 0, At, B0); PG8_MMA(0, 1, At, B1); PG8_BAR; PG8_SCHED;
            PG8_LDA(At, 1, 1); PG8_STAGE(PG8_SB(1, 0), b3, voffB); PG8_STAGE(PG8_SB(1, 1), b3 + bhstep, voffB); PG8_STAGE(PG8_SA(1, 0), a3, voffA);
            PG8_WAIT_V(8); PG8_WAIT_L(0); PG8_BAR; PG8_MMA(1, 0, At, B0); PG8_MMA(1, 1, At, B1); PG8_BAR; PG8_SCHED;
            } else {
            PG8_LDB(B0, 0, 0); PG8_SCHED; PG8_LDA(At, 0, 0); PG8_STAGE(PG8_SA(1, 1), a1 + hstep, voffA);
            PG8_WAIT_L(8); PG8_BAR; PG8_WAIT_L(0); PG8_MMA(0, 0, At, B0); PG8_BAR; PG8_SCHED;
            PG8_LDB(B1, 0, 1); PG8_STAGE(PG8_SB(0, 0), b2, voffB);
            PG8_BAR; PG8_WAIT_L(0); PG8_MMA(0, 1, At, B1); PG8_BAR;
            PG8_LDA(At, 0, 1); PG8_STAGE(PG8_SA(0, 0), a2, voffA);
            PG8_BAR; PG8_WAIT_L(0); PG8_MMA(1, 0, At, B0); PG8_BAR; PG8_SCHED;
            PG8_STAGE(PG8_SB(0, 1), b2 + bhstep, voffB);
            PG8_WAIT_V(6); PG8_BAR; PG8_MMA(1, 1, At, B1); PG8_BAR;
            PG8_LDB(B0, 1, 0); PG8_SCHED; PG8_LDA(At, 1, 0); PG8_STAGE(PG8_SA(0, 1), a2 + hstep, voffA);
            PG8_WAIT_L(8); PG8_BAR; PG8_WAIT_L(0); PG8_MMA(0, 0, At, B0); PG8_BAR; PG8_SCHED;
            PG8_LDB(B1, 1, 1); PG8_STAGE(PG8_SB(1, 0), b3, voffB);
            PG8_BAR; PG8_WAIT_L(0); PG8_MMA(0, 1, At, B1); PG8_BAR;
            PG8_LDA(At, 1, 1); PG8_STAGE(PG8_SA(1, 0), a3, voffA);
            PG8_BAR; PG8_WAIT_L(0); PG8_MMA(1, 0, At, B0); PG8_BAR; PG8_SCHED;
            PG8_STAGE(PG8_SB(1, 1), b3 + bhstep, voffB);
            PG8_WAIT_V(6); PG8_BAR; PG8_MMA(1, 1, At, B1); PG8_BAR;
            }
        }
        if constexpr (ALIGN_EPI) { if (wr == 0) PG8_BAR; }
        if constexpr (!Epi::AFTER_DRAIN) { E(acc, cur, wr, wc, fr, fq); S.done(cur); }
        if (!has_next) break;
#pragma unroll
        for (int a = 0; a < 2; ++a)
#pragma unroll
            for (int b = 0; b < 2; ++b)
#pragma unroll
                for (int m = 0; m < 4; ++m)
#pragma unroll
                    for (int n = 0; n < 2; ++n) acc[a][b][m][n] = (f32x4){0.f, 0.f, 0.f, 0.f};
        cur = nxt; cA = nA; cB = nB; ++ui;
        if constexpr (ALIGN_EPI) { if (wr == 1) PG8_BAR; }
    }
    PG8_WAIT_V(0);
    if constexpr (!ALIGN_EPI) { if (wr == 0) PG8_BAR; }
    PG8_BAR;
    if constexpr (Epi::AFTER_DRAIN) { E.fused(acc, cur, wr, wc, fr, fq, lds, wid, lane); S.done(cur); }
#undef PG8_SA
#undef PG8_SB
#undef PG8_STAGE
#undef PG8_LDA
#undef PG8_LDB
#undef PG8_MMA
#undef PG8_WAIT_V
#undef PG8_WAIT_L
#undef PG8_BAR
#undef PG8_SCHED
}
}
#define GAS __attribute__((address_space(1)))
#define LAS __attribute__((address_space(3)))
typedef unsigned short bf16;
typedef unsigned v4u __attribute__((ext_vector_type(4)));
typedef float f32x4 __attribute__((ext_vector_type(4)));
typedef short bf16x8 __attribute__((ext_vector_type(8)));
typedef GAS unsigned gu32;
typedef GAS unsigned long long gu64;
#define RLX_AGENT __ATOMIC_RELAXED, __HIP_MEMORY_SCOPE_AGENT
#define LDS_WAIT() asm volatile("s_waitcnt lgkmcnt(0)" ::: "memory")
#define VM_WAIT() asm volatile("s_waitcnt vmcnt(0)" ::: "memory")
__device__ __forceinline__ unsigned long long rt() { return __builtin_amdgcn_s_memrealtime(); }
__device__ __forceinline__ unsigned f2bf(float f) { unsigned u = __builtin_bit_cast(unsigned, f); return (u + 0x7fffu + ((u >> 16) & 1u)) >> 16; }
__device__ __forceinline__ unsigned pk2(float lo, float hi) { return f2bf(lo) | (f2bf(hi) << 16); }
#define XB_TMO      128
#define XB_XCNT(j)  (256  + 64 * (j))
#define XB_XSUB(j)  (1280 + 64 * (j))
#define XB_XGEN(j)  (2304 + 64 * (j))
#define XB_TOP      3328
#define XB_TOPGEN   3392
#define XCD_BAR_WORDS 3456
#define XB_SPIN_CAP (1u << 18)

__device__ __forceinline__ unsigned xb_ld(unsigned* p)              { return __hip_atomic_load(p, __ATOMIC_RELAXED, __HIP_MEMORY_SCOPE_AGENT); }
__device__ __forceinline__ unsigned xb_add(unsigned* p, unsigned v) { return __hip_atomic_fetch_add(p, v, __ATOMIC_RELAXED, __HIP_MEMORY_SCOPE_AGENT); }
__device__ __forceinline__ unsigned xb_xcc_id() { return (unsigned)__builtin_amdgcn_s_getreg((3 << 11) | 20) & 0xFu; }
#define XB_SPIN(cond, bar) do { unsigned _sp = 0; while (cond) { __builtin_amdgcn_s_sleep(1); \
    if ((++_sp & 255u) == 0u) { if (xb_ld(&(bar)[XB_TMO])) break; if (_sp > XB_SPIN_CAP) { atomicAdd(&(bar)[XB_TMO], 1u); break; } } } } while (0)

struct XcdBarrier {
    unsigned* bar; unsigned x;
    volatile LAS unsigned* st;
};

__device__ __forceinline__ XcdBarrier xcd_barrier_post(unsigned* bar, volatile LAS unsigned* st, bool t0  ) {
    XcdBarrier b; b.bar = bar; b.x = xb_xcc_id(); b.st = st;
    if (t0) (void)xb_add(&bar[XB_XCNT(b.x)], 1u);
    return b;
}
__device__ __forceinline__ void xcd_barrier_complete(unsigned* bar, unsigned x, unsigned& nloc, unsigned& nx) {
    const unsigned G = gridDim.x * gridDim.y * gridDim.z;
    unsigned sum, cnt, mine, sp = 0u;
    for (;;) {
        sum = 0u; cnt = 0u; mine = 0u;
#pragma unroll
        for (unsigned j = 0; j < 16; ++j) { const unsigned c = xb_ld(&bar[XB_XCNT(j)]); sum += c; cnt += (c > 0u) ? 1u : 0u; mine = (j == x) ? c : mine; }
        if (sum == G) break;
        __builtin_amdgcn_s_sleep(1);
        if ((++sp & 255u) == 0u) { if (xb_ld(&bar[XB_TMO])) break; if (sp > XB_SPIN_CAP) { atomicAdd(&bar[XB_TMO], 1u); break; } }
    }
    nloc = mine > 0u ? mine : 1u; nx = cnt > 0u ? cnt : 1u;
}

__device__ __forceinline__ void xcd_barrier(const XcdBarrier& b, bool t0  ) {
    asm volatile("s_waitcnt vmcnt(0)" ::: "memory");
    __syncthreads();
    if (t0) {
        unsigned* bar = b.bar;
        __builtin_amdgcn_s_waitcnt(0);
        unsigned nloc = b.st[0], nx = b.st[1];
        if (nloc == 0u) { xcd_barrier_complete(bar, b.x, nloc, nx); b.st[0] = nloc; b.st[1] = nx; }
        const unsigned old = xb_add(&bar[XB_XSUB(b.x)], 1u);
        const unsigned gen = old / nloc;
        if (old + 1u == (gen + 1u) * nloc) {
            __builtin_amdgcn_fence(__ATOMIC_RELEASE, "agent");
            asm volatile("s_waitcnt vmcnt(0)" ::: "memory");
            const unsigned og = xb_add(&bar[XB_TOP], 1u);
            const unsigned tg = og / nx;
            if (og + 1u == (tg + 1u) * nx) xb_add(&bar[XB_TOPGEN], 1u);
            else XB_SPIN(xb_ld(&bar[XB_TOPGEN]) == tg, bar);
            __builtin_amdgcn_fence(__ATOMIC_ACQUIRE, "agent");
            xb_add(&bar[XB_XGEN(b.x)], 1u);
            asm volatile("s_waitcnt vmcnt(0)" ::: "memory");
        } else {
            XB_SPIN(xb_ld(&bar[XB_XGEN(b.x)]) == gen, bar);
            __builtin_amdgcn_fence(__ATOMIC_ACQUIRE, "agent");
            asm volatile("s_waitcnt vmcnt(0)" ::: "memory");
        }
    }
    __syncthreads();
}

#ifndef FUSE_THIN
#define FUSE_THIN 0
#endif
#ifndef TAIL_MODE
#define TAIL_MODE 0
#endif
#ifndef REP_BAR
#define REP_BAR 1
#endif
#ifndef SWA_ALL
#define SWA_ALL 1
#endif
#ifndef ATT_ROT
#define ATT_ROT 1
#endif
#ifndef P0_KH
#define P0_KH 64
#endif
#ifndef P0_NT_LD
#define P0_NT_LD 0
#endif
#ifndef P0_NT_ST
#define P0_NT_ST 0
#endif
#ifndef P0_DYN
#define P0_DYN 0
#endif
#ifndef COOP_SPLIT
#define COOP_SPLIT 1
#endif
#ifndef P0_DEEP
#define P0_DEEP 0
#endif
#ifndef P0_PROBE
#define P0_PROBE 0
#endif
#ifndef REP_P0M
#define REP_P0M 1
#endif
#ifndef REP_P0
#define REP_P0 1
#endif
#ifndef REP_A
#define REP_A 1
#endif
#ifndef REP_S
#define REP_S 1
#endif
#ifndef REP_B4
#define REP_B4 1
#endif
#ifndef REP_B1
#define REP_B1 1
#endif
#ifndef REP_B2
#define REP_B2 1
#endif
#ifndef REP_B3
#define REP_B3 1
#endif
#ifndef REP_C
#define REP_C 1
#endif
#ifndef REP_E
#define REP_E 1
#endif
#ifndef REP_F
#define REP_F 1
#endif
constexpr int DM = 2048, BP = 4, TP = 2048, MP = BP * TP, BS = 8, TS = 16, MS = BS * TS, MR = MP + MS, MT = 8448;
constexpr int DIN = 4352, DFF = 8192, NL = 4, NMOD = 6 * DM;
constexpr int C_QA = 0, C_KA = 512, C_VA = 640, C_XB = 768, C_GB = 1792, C_QC = 2816, C_KC = 3328, C_VC = 3840;
constexpr float RMS_EPS = 1e-6f, LOG2E = 1.4426950408889634f;
using pg8::O_YP; using pg8::O_YS; using pg8::O_LHP; using pg8::O_LHS; using pg8::O_END;
constexpr int NWAVES = 8;
constexpr size_t MiB = 1u << 20;
constexpr size_t WS_CTL = 0, CTL_ZERO_BYTES = 1 * MiB;
constexpr size_t WS_MOD = 1 * MiB;
constexpr size_t WS_WIN = 4 * MiB;
constexpr size_t WS_WOUT = 72 * MiB;
constexpr size_t WS_WUP = 104 * MiB;
constexpr size_t WS_WDN = 232 * MiB;
constexpr size_t WS_H = 360 * MiB;
constexpr size_t WS_Z = 393 * MiB;
constexpr size_t WS_MIX = 464 * MiB;
constexpr size_t WS_T = 497 * MiB;
constexpr size_t WS_F1 = 563 * MiB;
constexpr size_t WS_XCH = 695 * MiB;
constexpr size_t WS_XR = 703 * MiB;
constexpr size_t WS_END = 736 * MiB;
static_assert(WS_MOD + (size_t)NL * 12 * NMOD * 4 <= WS_WIN && WS_WIN + (size_t)NL * DIN * DM * 2 <= WS_WOUT && WS_WOUT + (size_t)NL * DM * DM * 2 <= WS_WUP &&
              WS_WUP + (size_t)NL * DFF * DM * 2 <= WS_WDN && WS_WDN + (size_t)NL * DFF * DM * 2 <= WS_H && WS_H + (size_t)MT * DM * 2 <= WS_Z &&
              WS_Z + (size_t)MT * DIN * 2 <= WS_MIX && WS_MIX + (size_t)MT * DM * 2 <= WS_T && WS_T + (size_t)MT * DM * 4 <= WS_F1 && WS_F1 + (size_t)MT * DFF * 2 <= WS_END, "d_ws map");
constexpr int CW_SEAM = 16384;
constexpr int CW_Q = 8192;
constexpr int CW_DQ = 9216;
constexpr int CW_BAR = 4096;
constexpr int RING_BYTES = 131072, SCR_BYTES = 163840 - 1024  , LDSCTL_OFF = SCR_BYTES, MISC_OFF = LDSCTL_OFF + 320, LDS_BYTES = 163840;

typedef float f32x16 __attribute__((ext_vector_type(16)));
typedef unsigned u32x2 __attribute__((ext_vector_type(2)));
__device__ __forceinline__ float bf2f(unsigned short b) { return __uint_as_float((unsigned)b << 16); }
__device__ __forceinline__ unsigned pkbf(float lo, float hi) { typedef float f2_t __attribute__((ext_vector_type(2))); typedef __bf16 b2_t __attribute__((ext_vector_type(2)));
    f2_t v = {lo, hi}; b2_t b = __builtin_convertvector(v, b2_t); return __builtin_bit_cast(unsigned, b); }
__device__ __forceinline__ v4u pack8(const f32x4 a, const f32x4 b) { v4u w; w.x = pkbf(a[0], a[1]); w.y = pkbf(a[2], a[3]); w.z = pkbf(b[0], b[1]); w.w = pkbf(b[2], b[3]); return w; }
__device__ __forceinline__ float dpp_add(float v, float w) { return v + w; }
template <int CTRL> __device__ __forceinline__ float dpp_mov(float v) { return __builtin_bit_cast(float, __builtin_amdgcn_update_dpp(0, __builtin_bit_cast(int, v), CTRL, 0xf, 0xf, true)); }
__device__ __forceinline__ float wave_sum(float v) {
    v += dpp_mov<0xB1>(v);
    v += dpp_mov<0x4E>(v);
    v += dpp_mov<0x141>(v);
    v += dpp_mov<0x140>(v);
    const int b = __builtin_bit_cast(int, v);
    const float r0 = __builtin_bit_cast(float, __builtin_amdgcn_readlane(b, 0)), r1 = __builtin_bit_cast(float, __builtin_amdgcn_readlane(b, 16));
    const float r2 = __builtin_bit_cast(float, __builtin_amdgcn_readlane(b, 32)), r3 = __builtin_bit_cast(float, __builtin_amdgcn_readlane(b, 48));
    return (r0 + r1) + (r2 + r3);
}
__device__ __forceinline__ int hw_lane() { int l; asm volatile("v_mbcnt_lo_u32_b32 %0, -1, 0\n\tv_mbcnt_hi_u32_b32 %0, -1, %0" : "=v"(l)); return l; }
__device__ __forceinline__ float fexp2(float x) { return __builtin_amdgcn_exp2f(x); }
__device__ __forceinline__ float frcp(float x) { return __builtin_amdgcn_rcpf(x); }
__device__ __forceinline__ float sigmoidf_fast(float x) { return frcp(1.0f + fexp2(-x * LOG2E)); }

__device__ __forceinline__ void p0_transpose_item(const float* W, int K, int N, bf16* WT, LAS float* scr, int item, int lane) {
    const int nblk = N / 32, kb = item / nblk, nb = item % nblk, k0 = 64 * kb, n0 = 32 * nb;
    const int lr = lane >> 3, lc = lane & 7;
    const float* src = W + (size_t)(k0 + lr) * N + n0 + 4 * lc;
    f32x4 v[8];
#pragma unroll
    for (int i = 0; i < 8; ++i) v[i] = *(const f32x4*)(src + (size_t)(8 * i) * N);
#pragma unroll
    for (int i = 0; i < 8; ++i) *(LAS f32x4*)(scr + (8 * i + lr) * 36 + 4 * lc) = v[i];
    LDS_WAIT(); asm volatile("" ::: "memory");
    const int c = lane & 7;
#pragma unroll
    for (int j = 0; j < 4; ++j) { const int n = (lane >> 3) + 8 * j; const LAS float* s = scr + (8 * c) * 36 + n;
        v4u o; o.x = pkbf(s[0 * 36], s[1 * 36]); o.y = pkbf(s[2 * 36], s[3 * 36]); o.z = pkbf(s[4 * 36], s[5 * 36]); o.w = pkbf(s[6 * 36], s[7 * 36]);
        *(GAS v4u*)(WT + (size_t)(n0 + n) * K + k0 + 8 * c) = o; }
    LDS_WAIT(); asm volatile("" ::: "memory");
}
constexpr int TP_PITCH = 520;
constexpr int P0_NI = P0_KH / 8;
__device__ __forceinline__ void p0_tile_load(const float* W, int N, int item, int tid, f32x4 (&pre)[P0_NI]) {
    const int nblk = N / 256, kb = item / nblk, nb = item % nblk;
    const float* src = W + (size_t)(P0_KH * kb + (tid >> 6)) * N + 256 * nb + 4 * (tid & 63);
#pragma unroll
    for (int i = 0; i < P0_NI; ++i) pre[i] = *(const f32x4*)(src + (size_t)(8 * i) * N);
}
__device__ __forceinline__ void p0_tile_store(const f32x4 (&pre)[P0_NI], int K, int N, bf16* WT, LAS unsigned char* scr, int item, int tid, bool dost = true) {
    const int nblk = N / 256, kb = item / nblk, nb = item % nblk;
    __syncthreads();
#pragma unroll
    for (int i = 0; i < P0_NI; ++i) { u32x2 w; w.x = pkbf(pre[i][0], pre[i][1]); w.y = pkbf(pre[i][2], pre[i][3]); *(LAS u32x2*)(scr + (8 * i + (tid >> 6)) * TP_PITCH + (tid & 63) * 8) = w; }
    __syncthreads();
    const int kc = tid % P0_NI;
#pragma unroll
    for (int j = 0; j < P0_NI / 2; ++j) { const int n = (tid / P0_NI) + (512 / P0_NI) * j; const LAS unsigned char* sp = scr + (8 * kc) * TP_PITCH + n * 2;
        unsigned short e[8];
#pragma unroll
        for (int q = 0; q < 8; ++q) e[q] = *(const LAS unsigned short*)(sp + q * TP_PITCH);
        v4u o; o.x = e[0] | ((unsigned)e[1] << 16); o.y = e[2] | ((unsigned)e[3] << 16); o.z = e[4] | ((unsigned)e[5] << 16); o.w = e[6] | ((unsigned)e[7] << 16);
        if (dost) *(GAS v4u*)(WT + (size_t)(256 * nb + n) * K + P0_KH * kb + 8 * kc) = o; }
}
__device__ __forceinline__ void p0_tile_store_pk(const u32x2 (&w)[8], int K, int N, bf16* WT, LAS unsigned char* scr, int item, int tid) {
    const int nblk = N / 256, kb = item / nblk, nb = item % nblk;
    __syncthreads();
#pragma unroll
    for (int i = 0; i < 8; ++i) *(LAS u32x2*)(scr + (8 * i + (tid >> 6)) * TP_PITCH + (tid & 63) * 8) = w[i];
    __syncthreads();
    const int kc = tid & 7;
#pragma unroll
    for (int j = 0; j < 4; ++j) { const int n = (tid >> 3) + 64 * j; const LAS unsigned char* sp = scr + (8 * kc) * TP_PITCH + n * 2;
        unsigned short e[8];
#pragma unroll
        for (int q = 0; q < 8; ++q) e[q] = *(const LAS unsigned short*)(sp + q * TP_PITCH);
        v4u o; o.x = e[0] | ((unsigned)e[1] << 16); o.y = e[2] | ((unsigned)e[3] << 16); o.z = e[4] | ((unsigned)e[5] << 16); o.w = e[6] | ((unsigned)e[7] << 16);
        *(GAS v4u*)(WT + (size_t)(256 * nb + n) * K + 64 * kb + 8 * kc) = o; }
}
constexpr int MODS_ITEMS = NL * (NMOD / 256);
template <bool DYN> __device__ __forceinline__ void p0_mods(unsigned* qm, volatile LAS unsigned* mq, LAS unsigned char* lds, const float* c_p, const float* c_s, const float* w_mod, const float* b_mod, const float* g_pre_mix, const float* g_post_mix, const float* g_pre_mlp, const float* g_post_mlp, float* MOD, int G, int bid, int tid) {
    const int lane = tid & 63, wave = __builtin_amdgcn_readfirstlane(tid >> 6);
    LAS float* S = (LAS float*)lds;
    LAS float* PS = (LAS float*)lds;
    for (int item0 = bid; DYN || (item0 < MODS_ITEMS * REP_P0M && (REP_P0M == 1 || bid < MODS_ITEMS)); item0 += (REP_P0M > 1 ? MODS_ITEMS : G)) { int item = item0 % MODS_ITEMS;
        __syncthreads();
        if (DYN) {
            if (tid == 0) mq[0] = __hip_atomic_fetch_add(qm, 1u, __ATOMIC_RELAXED, __HIP_MEMORY_SCOPE_AGENT);
            __syncthreads();
            item = __builtin_amdgcn_readfirstlane((int)mq[0]);
            if (item >= MODS_ITEMS * REP_P0M) break;
            item %= MODS_ITEMS;
        }
        for (int e = tid; e < 12 * 2048; e += 512) { const int row = e >> 11, k = e & 2047; const float c = row < 4 ? c_p[row * 2048 + k] : c_s[(row - 4) * 2048 + k]; S[k * 12 + row] = c / (1.0f + expf(-c)); }
        __syncthreads();
        const int l = item / (NMOD / 256), cg = item % (NMOD / 256), col0 = cg * 256;
        const float* W = w_mod + (size_t)l * DM * NMOD + col0 + 4 * lane;
        f32x4 acc[12];
#pragma unroll
        for (int r = 0; r < 12; ++r) acc[r] = (f32x4){0.f, 0.f, 0.f, 0.f};
        const int k0 = wave * 256;
        for (int kk = 0; kk < 256; kk += 8) {
            f32x4 w[8];
#pragma unroll
            for (int u = 0; u < 8; ++u) w[u] = *(const f32x4*)(W + (size_t)(k0 + kk + u) * NMOD);
#pragma unroll
            for (int u = 0; u < 8; ++u) {
                const LAS f32x4* sp = (const LAS f32x4*)(S + (k0 + kk + u) * 12); const f32x4 s0 = sp[0], s1 = sp[1], s2 = sp[2];
#pragma unroll
                for (int r = 0; r < 4; ++r) { acc[r] += w[u] * s0[r]; acc[4 + r] += w[u] * s1[r]; acc[8 + r] += w[u] * s2[r]; }
            }
        }
        __syncthreads();
#pragma unroll
        for (int r = 0; r < 12; ++r) *(LAS f32x4*)(PS + (wave * 12 + r) * 256 + 4 * lane) = acc[r];
        __syncthreads();
        for (int e = tid; e < 12 * 256; e += 512) { const int r = e >> 8, c = e & 255; float s = b_mod[(size_t)l * NMOD + col0 + c];
#pragma unroll
            for (int w = 0; w < 8; ++w) s += PS[(w * 12 + r) * 256 + c];
            const int col = col0 + c, j = col >> 11, d = col & 2047;
            if (j == 1) s = g_pre_mix[l * DM + d] * (1.0f + s); else if (j == 2) s = s * g_post_mix[l * DM + d]; else if (j == 4) s = g_pre_mlp[l * DM + d] * (1.0f + s); else if (j == 5) s = s * g_post_mlp[l * DM + d];
            MOD[((size_t)l * 12 + r) * NMOD + col] = s; }
    }
    __syncthreads();
}

#define ROW_LD_NT(dst, ptr) do { const f32x4* _p = (const f32x4*)(ptr) + lane; _Pragma("unroll") for (int _j = 0; _j < 8; ++_j) dst[_j] = __builtin_nontemporal_load(_p + 64 * _j); } while (0)
#define ROW_LD(dst, ptr) do { const f32x4* _p = (const f32x4*)(ptr) + 2 * lane; _Pragma("unroll") for (int _g = 0; _g < 4; ++_g) { dst[2 * _g] = _p[128 * _g]; dst[2 * _g + 1] = _p[128 * _g + 1]; } } while (0)
__device__ __forceinline__ float row_sumsq(const f32x4 (&v)[8]) { float s = 0.f;
#pragma unroll
    for (int j = 0; j < 8; ++j) s += (v[j][0] * v[j][0] + v[j][1] * v[j][1]) + (v[j][2] * v[j][2] + v[j][3] * v[j][3]);
    return wave_sum(s); }
#ifndef THIN_SC1
#define THIN_SC1 0
#endif
__device__ __forceinline__ void st16_row(v4u* p, v4u w) {
#if THIN_SC1
    asm volatile("global_store_dwordx4 %0, %1, off sc1\n\ts_nop 1" :: "v"(p), "v"(w) : "memory");
#else
    *p = w;
#endif
}
#define ROW_ST_BF16(ptr, src) do { v4u* _o = (v4u*)(ptr) + lane; _Pragma("unroll") for (int _g = 0; _g < 4; ++_g) { v4u _w; _w.x = pkbf(src[2 * _g][0], src[2 * _g][1]); _w.y = pkbf(src[2 * _g][2], src[2 * _g][3]); _w.z = pkbf(src[2 * _g + 1][0], src[2 * _g + 1][1]); _w.w = pkbf(src[2 * _g + 1][2], src[2 * _g + 1][3]); st16_row(_o + 64 * _g, _w); } } while (0)
#define ROW_LD_BF16(dst, ptr) do { const v4u* _p = (const v4u*)(ptr) + lane; _Pragma("unroll") for (int _g = 0; _g < 4; ++_g) { const v4u _w = _p[64 * _g]; \
    dst[2 * _g] = (f32x4){__uint_as_float(_w.x << 16), __uint_as_float(_w.x & 0xffff0000u), __uint_as_float(_w.y << 16), __uint_as_float(_w.y & 0xffff0000u)}; \
    dst[2 * _g + 1] = (f32x4){__uint_as_float(_w.z << 16), __uint_as_float(_w.z & 0xffff0000u), __uint_as_float(_w.w << 16), __uint_as_float(_w.w & 0xffff0000u)}; } } while (0)
__device__ __forceinline__ void norm_store(const f32x4 (&v)[8], float rstd, const f32x4 (&e)[8], const f32x4 (&f)[8], bf16* hrow, int lane) {
    f32x4 h[8];
#pragma unroll
    for (int j = 0; j < 8; ++j) h[j] = v[j] * rstd * e[j] + f[j];
    ROW_ST_BF16(hrow, h);
}
__device__ __forceinline__ void coop_row(const bf16* trow, const float* xr, const bf16* xr16, const float* cp, const float* ep, const float* fp, float* orow, bf16* orow16, bf16* hrow, LAS float* red, int tid) {
    const int lane = tid & 63, wave = tid >> 6;
    f32x4 x;
    if (xr16 != nullptr) { const u32x2 w = ((const u32x2*)xr16)[tid]; x = (f32x4){__uint_as_float(w.x << 16), __uint_as_float(w.x & 0xffff0000u), __uint_as_float(w.y << 16), __uint_as_float(w.y & 0xffff0000u)}; }
    else x = ((const f32x4*)xr)[tid];
    if (trow != nullptr) {
        const u32x2 w = ((const u32x2*)trow)[tid];
        const f32x4 t = {__uint_as_float(w.x << 16), __uint_as_float(w.x & 0xffff0000u), __uint_as_float(w.y << 16), __uint_as_float(w.y & 0xffff0000u)};
        const f32x4 c = ((const f32x4*)cp)[tid];
        const float ss = wave_sum((t[0] * t[0] + t[1] * t[1]) + (t[2] * t[2] + t[3] * t[3]));
        if (lane == 0) red[wave] = ss;
        __syncthreads();
        float tot = 0.f;
#pragma unroll
        for (int w2 = 0; w2 < 8; ++w2) tot += red[w2];
        const float rt_ = 1.0f / sqrtf(tot * (1.0f / DM) + RMS_EPS);
        x = x + (t * rt_) * c;
        if (orow16 != nullptr) { u32x2 o; o.x = pkbf(x[0], x[1]); o.y = pkbf(x[2], x[3]); ((u32x2*)orow16)[tid] = o; } else ((f32x4*)orow)[tid] = x;
    }
    if (hrow != nullptr) {
        const f32x4 e = ((const f32x4*)ep)[tid], f = ((const f32x4*)fp)[tid];
        const float ss = wave_sum((x[0] * x[0] + x[1] * x[1]) + (x[2] * x[2] + x[3] * x[3]));
        if (lane == 0) red[8 + wave] = ss;
        __syncthreads();
        float tot = 0.f;
#pragma unroll
        for (int w2 = 0; w2 < 8; ++w2) tot += red[8 + w2];
        const float rx = 1.0f / sqrtf(tot * (1.0f / DM) + RMS_EPS);
        const f32x4 h = x * rx * e + f;
        u32x2 o; o.x = pkbf(h[0], h[1]); o.y = pkbf(h[2], h[3]); ((u32x2*)hrow)[tid] = o;
    }
}
constexpr int CD_BASE = 1024, CD_C = 0, CD_E = 8192, CD_F = 16384, CD_T = 24576, CD_X = 28672;
__device__ __forceinline__ void coop_dma(LAS unsigned char* lds, const bf16* trow, const float* xr, const bf16* xr16, const float* cp, const float* ep, const float* fp, int wave, int lane) {
    LAS unsigned char* L = lds + CD_BASE + wave * 1024;
    if (cp != nullptr) __builtin_amdgcn_global_load_lds((const unsigned*)(cp + wave * 256 + lane * 4), (LAS unsigned*)(L + CD_C), 16, 0, 0);
    __builtin_amdgcn_global_load_lds((const unsigned*)(ep + wave * 256 + lane * 4), (LAS unsigned*)(L + CD_E), 16, 0, 0);
    __builtin_amdgcn_global_load_lds((const unsigned*)(fp + wave * 256 + lane * 4), (LAS unsigned*)(L + CD_F), 16, 0, 0);
    if (trow != nullptr && wave < 4) __builtin_amdgcn_global_load_lds((const unsigned*)(trow + wave * 512 + lane * 8), (LAS unsigned*)(L + CD_T), 16, 0, 0);
    if (xr != nullptr) __builtin_amdgcn_global_load_lds((const unsigned*)(xr + wave * 256 + lane * 4), (LAS unsigned*)(L + CD_X), 16, 0, 0);
    else if (wave >= 4) __builtin_amdgcn_global_load_lds((const unsigned*)(xr16 + (wave - 4) * 512 + lane * 8), (LAS unsigned*)(L - 4096 + CD_X), 16, 0, 0);
}
__device__ __forceinline__ int mod_row_of(int row) { return row < MP ? (row >> 11) : 4 + ((row - MP) >> 4); }

constexpr int AK_PITCH = 144, AV_PITCH = 80, AK_BYTES = 32 * AK_PITCH  , AV_BYTES = 64 * AV_PITCH  , ATBL_BYTES = 1088;
struct AttnWave { bool active; bool wr; const bf16* qrow; bf16* orow; int qpos; float m0, l0; };
#define MFMA32(a, b, c) __builtin_amdgcn_mfma_f32_32x32x16_bf16((a), (b), (c), 0, 0, 0)
#define MFMA16(a, b, c) __builtin_amdgcn_mfma_f32_16x16x32_bf16((a), (b), (c), 0, 0, 0)

template <int NTASK>
__device__ __forceinline__ void attn_stage_store(const v4u (&st)[NTASK], LAS unsigned char* kb, LAS unsigned char* vb, int gtid, int nthr) {
#pragma unroll
    for (int i = 0; i < NTASK; ++i) {
        const int task = gtid + nthr * i; const bool isV = task >= 256; const int idx = task & 255, key = idx >> 3, dc = idx & 7;
        if (!isV) { *(LAS v4u*)(kb + key * AK_PITCH + dc * 16) = st[i]; }
        else {
            LAS unsigned short* vp = (LAS unsigned short*)(vb + (dc * 8) * AV_PITCH + key * 2);
#pragma unroll
            for (int e = 0; e < 4; ++e) { const unsigned w = st[i][e]; vp[(2 * e) * (AV_PITCH / 2)] = (unsigned short)(w & 0xffffu); vp[(2 * e + 1) * (AV_PITCH / 2)] = (unsigned short)(w >> 16); }
        }
    }
}
template <bool SHARED, bool BIAS, bool MERGE, class Src, class Rel, bool ROT = false>
__device__ __forceinline__ void attn_run(LAS unsigned char* kbuf, LAS unsigned char* vbuf, const LAS float* tbl, int gtid, int tstart, int tstride, int ntiles, int kbase, int partial_tile,
                                         const Src& src, const Rel& rel, const AttnWave& W, LAS float* mg) {
    constexpr int NTHR = SHARED ? 512 : 64, NTASK = 512 / NTHR, NBUF = SHARED ? 2 : 1;
    const int lane = hw_lane(), r = lane & 31, h = lane >> 5;
    const int fr = (r & 0x13) | ((r & 4) << 1) | ((r & 8) >> 1);
    bf16x8 qf[4];
#pragma unroll
    for (int ks = 0; ks < 4; ++ks) qf[ks] = (bf16x8){0, 0, 0, 0, 0, 0, 0, 0};
    if (W.active) {
#pragma unroll
        for (int ks = 0; ks < 4; ++ks) qf[ks] = *(const bf16x8*)(W.qrow + ks * 16 + h * 8);
    }
    float m = W.m0, l = W.l0;
    f32x16 o0, o1;
#pragma unroll
    for (int i = 0; i < 16; ++i) { o0[i] = 0.f; o1[i] = 0.f; }
    if constexpr (SHARED && ROT) {
        const int idx0 = gtid & 255; const bool isV0 = gtid >= 256;
        v4u rA = src(tstart, isV0, idx0 >> 3, idx0 & 7);
        v4u rB = src(tstart + ((1 < ntiles) ? 1 : (ntiles - 1)) * tstride, isV0, idx0 >> 3, idx0 & 7);
        v4u rC = src(tstart + ((2 < ntiles) ? 2 : (ntiles - 1)) * tstride, isV0, idx0 >> 3, idx0 & 7);
        { const v4u one_[1] = {rA}; attn_stage_store<1>(one_, kbuf, vbuf, gtid, NTHR); }
        __syncthreads();
#pragma unroll 1
        for (int k0 = 0; k0 < ntiles; k0 += 3) {
            { const int k = k0; const int t = tstart + k * tstride;
              { const int kc = (k + 3 < ntiles) ? (k + 3) : (ntiles - 1); const int idx = gtid & 255; rA = src(tstart + kc * tstride, gtid >= 256, idx >> 3, idx & 7); }
              if (k < ntiles) {
                if (W.active && rel(t)) {
                    const LAS unsigned char* kb = kbuf + (NBUF == 2 ? (k & 1) * AK_BYTES : 0);
                    const LAS unsigned char* vb = vbuf + (NBUF == 2 ? (k & 1) * AV_BYTES : 0);
                    f32x16 x;
#pragma unroll
                    for (int i = 0; i < 16; ++i) x[i] = 0.f;
#pragma unroll
                    for (int ks = 0; ks < 4; ++ks) { const bf16x8 kf = *(const LAS bf16x8*)(kb + fr * AK_PITCH + ks * 32 + h * 16); x = MFMA32(kf, qf[ks], x); }
                    float tt[16];
                    const float c = 0.125f * LOG2E;
                    if (BIAS) {
                        const int dbase = W.qpos - (kbase + 32 * t) - 8 * h;
                        const int dmin = __builtin_amdgcn_readfirstlane(W.qpos - (int)(hw_lane() & 31)) - (kbase + 32 * t) - 31;
                        if (dmin >= 128) {
                            const float bfar = tbl[256];
#pragma unroll
                            for (int i = 0; i < 16; ++i) tt[i] = x[i] * c + bfar;
                        } else {
#pragma unroll
                            for (int i = 0; i < 16; ++i) { int d = dbase - ((i & 7) + 16 * (i >> 3)); d = d < -128 ? -128 : (d > 128 ? 128 : d); tt[i] = x[i] * c + tbl[d + 128]; }
                        }
                    } else {
#pragma unroll
                        for (int i = 0; i < 16; ++i) tt[i] = x[i] * c;
                    }
                    if (t == partial_tile) {
#pragma unroll
                        for (int i = 8; i < 16; ++i) tt[i] = -1e30f;
                    }
                    float mt = tt[0];
#pragma unroll
                    for (int i = 1; i < 16; ++i) mt = fmaxf(mt, tt[i]);
                    mt = fmaxf(mt, __shfl_xor(mt, 32));
                    if (__any(mt > m + 6.0f)) {
                        const float mn = fmaxf(m, mt); const float alpha = fexp2(m - mn); m = mn;
                        l *= alpha;
#pragma unroll
                        for (int i = 0; i < 16; ++i) { o0[i] *= alpha; o1[i] *= alpha; }
                    }
                    float ps = 0.f;
#pragma unroll
                    for (int i = 0; i < 16; ++i) { tt[i] = fexp2(tt[i] - m); ps += tt[i]; }
                    l += ps;
#pragma unroll
                    for (int s = 0; s < 2; ++s) {
                        v4u pw; pw.x = pkbf(tt[8 * s], tt[8 * s + 1]); pw.y = pkbf(tt[8 * s + 2], tt[8 * s + 3]); pw.z = pkbf(tt[8 * s + 4], tt[8 * s + 5]); pw.w = pkbf(tt[8 * s + 6], tt[8 * s + 7]);
                        const bf16x8 pf = __builtin_bit_cast(bf16x8, pw);
                        const bf16x8 v0 = *(const LAS bf16x8*)(vb + r * AV_PITCH + s * 32 + h * 16);
                        const bf16x8 v1 = *(const LAS bf16x8*)(vb + (r + 32) * AV_PITCH + s * 32 + h * 16);
                        o0 = MFMA32(v0, pf, o0); o1 = MFMA32(v1, pf, o1);
                    }
                }
              }
              if (k + 1 < ntiles) { const v4u one_[1] = {rB}; attn_stage_store<1>(one_, kbuf + ((k + 1) & 1) * AK_BYTES, vbuf + ((k + 1) & 1) * AV_BYTES, gtid, NTHR); }
              __syncthreads(); }
            { const int k = k0 + 1; const int t = tstart + k * tstride;
              { const int kc = (k + 3 < ntiles) ? (k + 3) : (ntiles - 1); const int idx = gtid & 255; rB = src(tstart + kc * tstride, gtid >= 256, idx >> 3, idx & 7); }
              if (k < ntiles) {
                if (W.active && rel(t)) {
                    const LAS unsigned char* kb = kbuf + (NBUF == 2 ? (k & 1) * AK_BYTES : 0);
                    const LAS unsigned char* vb = vbuf + (NBUF == 2 ? (k & 1) * AV_BYTES : 0);
                    f32x16 x;
#pragma unroll
                    for (int i = 0; i < 16; ++i) x[i] = 0.f;
#pragma unroll
                    for (int ks = 0; ks < 4; ++ks) { const bf16x8 kf = *(const LAS bf16x8*)(kb + fr * AK_PITCH + ks * 32 + h * 16); x = MFMA32(kf, qf[ks], x); }
                    float tt[16];
                    const float c = 0.125f * LOG2E;
                    if (BIAS) {
                        const int dbase = W.qpos - (kbase + 32 * t) - 8 * h;
                        const int dmin = __builtin_amdgcn_readfirstlane(W.qpos - (int)(hw_lane() & 31)) - (kbase + 32 * t) - 31;
                        if (dmin >= 128) {
                            const float bfar = tbl[256];
#pragma unroll
                            for (int i = 0; i < 16; ++i) tt[i] = x[i] * c + bfar;
                        } else {
#pragma unroll
                            for (int i = 0; i < 16; ++i) { int d = dbase - ((i & 7) + 16 * (i >> 3)); d = d < -128 ? -128 : (d > 128 ? 128 : d); tt[i] = x[i] * c + tbl[d + 128]; }
                        }
                    } else {
#pragma unroll
                        for (int i = 0; i < 16; ++i) tt[i] = x[i] * c;
                    }
                    if (t == partial_tile) {
#pragma unroll
                        for (int i = 8; i < 16; ++i) tt[i] = -1e30f;
                    }
                    float mt = tt[0];
#pragma unroll
                    for (int i = 1; i < 16; ++i) mt = fmaxf(mt, tt[i]);
                    mt = fmaxf(mt, __shfl_xor(mt, 32));
                    if (__any(mt > m + 6.0f)) {
                        const float mn = fmaxf(m, mt); const float alpha = fexp2(m - mn); m = mn;
                        l *= alpha;
#pragma unroll
                        for (int i = 0; i < 16; ++i) { o0[i] *= alpha; o1[i] *= alpha; }
                    }
                    float ps = 0.f;
#pragma unroll
                    for (int i = 0; i < 16; ++i) { tt[i] = fexp2(tt[i] - m); ps += tt[i]; }
                    l += ps;
#pragma unroll
                    for (int s = 0; s < 2; ++s) {
                        v4u pw; pw.x = pkbf(tt[8 * s], tt[8 * s + 1]); pw.y = pkbf(tt[8 * s + 2], tt[8 * s + 3]); pw.z = pkbf(tt[8 * s + 4], tt[8 * s + 5]); pw.w = pkbf(tt[8 * s + 6], tt[8 * s + 7]);
                        const bf16x8 pf = __builtin_bit_cast(bf16x8, pw);
                        const bf16x8 v0 = *(const LAS bf16x8*)(vb + r * AV_PITCH + s * 32 + h * 16);
                        const bf16x8 v1 = *(const LAS bf16x8*)(vb + (r + 32) * AV_PITCH + s * 32 + h * 16);
                        o0 = MFMA32(v0, pf, o0); o1 = MFMA32(v1, pf, o1);
                    }
                }
              }
              if (k + 1 < ntiles) { const v4u one_[1] = {rC}; attn_stage_store<1>(one_, kbuf + ((k + 1) & 1) * AK_BYTES, vbuf + ((k + 1) & 1) * AV_BYTES, gtid, NTHR); }
              __syncthreads(); }
            { const int k = k0 + 2; const int t = tstart + k * tstride;
              { const int kc = (k + 3 < ntiles) ? (k + 3) : (ntiles - 1); const int idx = gtid & 255; rC = src(tstart + kc * tstride, gtid >= 256, idx >> 3, idx & 7); }
              if (k < ntiles) {
                if (W.active && rel(t)) {
                    const LAS unsigned char* kb = kbuf + (NBUF == 2 ? (k & 1) * AK_BYTES : 0);
                    const LAS unsigned char* vb = vbuf + (NBUF == 2 ? (k & 1) * AV_BYTES : 0);
                    f32x16 x;
#pragma unroll
                    for (int i = 0; i < 16; ++i) x[i] = 0.f;
#pragma unroll
                    for (int ks = 0; ks < 4; ++ks) { const bf16x8 kf = *(const LAS bf16x8*)(kb + fr * AK_PITCH + ks * 32 + h * 16); x = MFMA32(kf, qf[ks], x); }
                    float tt[16];
                    const float c = 0.125f * LOG2E;
                    if (BIAS) {
                        const int dbase = W.qpos - (kbase + 32 * t) - 8 * h;
                        const int dmin = __builtin_amdgcn_readfirstlane(W.qpos - (int)(hw_lane() & 31)) - (kbase + 32 * t) - 31;
                        if (dmin >= 128) {
                            const float bfar = tbl[256];
#pragma unroll
                            for (int i = 0; i < 16; ++i) tt[i] = x[i] * c + bfar;
                        } else {
#pragma unroll
                            for (int i = 0; i < 16; ++i) { int d = dbase - ((i & 7) + 16 * (i >> 3)); d = d < -128 ? -128 : (d > 128 ? 128 : d); tt[i] = x[i] * c + tbl[d + 128]; }
                        }
                    } else {
#pragma unroll
                        for (int i = 0; i < 16; ++i) tt[i] = x[i] * c;
                    }
                    if (t == partial_tile) {
#pragma unroll
                        for (int i = 8; i < 16; ++i) tt[i] = -1e30f;
                    }
                    float mt = tt[0];
#pragma unroll
                    for (int i = 1; i < 16; ++i) mt = fmaxf(mt, tt[i]);
                    mt = fmaxf(mt, __shfl_xor(mt, 32));
                    if (__any(mt > m + 6.0f)) {
                        const float mn = fmaxf(m, mt); const float alpha = fexp2(m - mn); m = mn;
                        l *= alpha;
#pragma unroll
                        for (int i = 0; i < 16; ++i) { o0[i] *= alpha; o1[i] *= alpha; }
                    }
                    float ps = 0.f;
#pragma unroll
                    for (int i = 0; i < 16; ++i) { tt[i] = fexp2(tt[i] - m); ps += tt[i]; }
                    l += ps;
#pragma unroll
                    for (int s = 0; s < 2; ++s) {
                        v4u pw; pw.x = pkbf(tt[8 * s], tt[8 * s + 1]); pw.y = pkbf(tt[8 * s + 2], tt[8 * s + 3]); pw.z = pkbf(tt[8 * s + 4], tt[8 * s + 5]); pw.w = pkbf(tt[8 * s + 6], tt[8 * s + 7]);
                        const bf16x8 pf = __builtin_bit_cast(bf16x8, pw);
                        const bf16x8 v0 = *(const LAS bf16x8*)(vb + r * AV_PITCH + s * 32 + h * 16);
                        const bf16x8 v1 = *(const LAS bf16x8*)(vb + (r + 32) * AV_PITCH + s * 32 + h * 16);
                        o0 = MFMA32(v0, pf, o0); o1 = MFMA32(v1, pf, o1);
                    }
                }
              }
              if (k + 1 < ntiles) { const v4u one_[1] = {rA}; attn_stage_store<1>(one_, kbuf + ((k + 1) & 1) * AK_BYTES, vbuf + ((k + 1) & 1) * AV_BYTES, gtid, NTHR); }
              __syncthreads(); }
        }
    } else {
    v4u st[NTASK], st2[NTASK], st3[NTASK];
#pragma unroll
    for (int i = 0; i < NTASK; ++i) { const int task = gtid + NTHR * i; const int idx = task & 255; st[i] = src(tstart, task >= 256, idx >> 3, idx & 7);
        if (SHARED) { st2[i] = (1 < ntiles) ? src(tstart + tstride, task >= 256, idx >> 3, idx & 7) : st[i]; st3[i] = (2 < ntiles) ? src(tstart + 2 * tstride, task >= 256, idx >> 3, idx & 7) : st[i]; } }
    attn_stage_store<NTASK>(st, kbuf, vbuf, gtid, NTHR);
    if (SHARED) {
#pragma unroll
        for (int i = 0; i < NTASK; ++i) { st[i] = st2[i]; st2[i] = st3[i]; }
        __syncthreads();
    }
    for (int k = 0; k < ntiles; ++k) {
        const int t = tstart + k * tstride;
        const bool more = (k + 1 < ntiles);
        if (SHARED) {
            if (k + 3 < ntiles) {
#pragma unroll
                for (int i = 0; i < NTASK; ++i) { const int task = gtid + NTHR * i; const int idx = task & 255; st3[i] = src(t + 3 * tstride, task >= 256, idx >> 3, idx & 7); }
            }
        } else if (more) {
#pragma unroll
            for (int i = 0; i < NTASK; ++i) { const int task = gtid + NTHR * i; const int idx = task & 255; st[i] = src(t + tstride, task >= 256, idx >> 3, idx & 7); }
        }
        if (W.active && rel(t)) {
            const LAS unsigned char* kb = kbuf + (NBUF == 2 ? (k & 1) * AK_BYTES : 0);
            const LAS unsigned char* vb = vbuf + (NBUF == 2 ? (k & 1) * AV_BYTES : 0);
            f32x16 x;
#pragma unroll
            for (int i = 0; i < 16; ++i) x[i] = 0.f;
#pragma unroll
            for (int ks = 0; ks < 4; ++ks) { const bf16x8 kf = *(const LAS bf16x8*)(kb + fr * AK_PITCH + ks * 32 + h * 16); x = MFMA32(kf, qf[ks], x); }
            float tt[16];
            const float c = 0.125f * LOG2E;
            if (BIAS) {
                const int dbase = W.qpos - (kbase + 32 * t) - 8 * h;
                const int dmin = __builtin_amdgcn_readfirstlane(W.qpos - (int)(hw_lane() & 31)) - (kbase + 32 * t) - 31;
                if (dmin >= 128) {
                    const float bfar = tbl[256];
#pragma unroll
                    for (int i = 0; i < 16; ++i) tt[i] = x[i] * c + bfar;
                } else {
#pragma unroll
                    for (int i = 0; i < 16; ++i) { int d = dbase - ((i & 7) + 16 * (i >> 3)); d = d < -128 ? -128 : (d > 128 ? 128 : d); tt[i] = x[i] * c + tbl[d + 128]; }
                }
            } else {
#pragma unroll
                for (int i = 0; i < 16; ++i) tt[i] = x[i] * c;
            }
            if (t == partial_tile) {
#pragma unroll
                for (int i = 8; i < 16; ++i) tt[i] = -1e30f;
            }
            float mt = tt[0];
#pragma unroll
            for (int i = 1; i < 16; ++i) mt = fmaxf(mt, tt[i]);
            mt = fmaxf(mt, __shfl_xor(mt, 32));
            if (__any(mt > m + 6.0f)) {
                const float mn = fmaxf(m, mt); const float alpha = fexp2(m - mn); m = mn;
                l *= alpha;
#pragma unroll
                for (int i = 0; i < 16; ++i) { o0[i] *= alpha; o1[i] *= alpha; }
            }
            float ps = 0.f;
#pragma unroll
            for (int i = 0; i < 16; ++i) { tt[i] = fexp2(tt[i] - m); ps += tt[i]; }
            l += ps;
#pragma unroll
            for (int s = 0; s < 2; ++s) {
                v4u pw; pw.x = pkbf(tt[8 * s], tt[8 * s + 1]); pw.y = pkbf(tt[8 * s + 2], tt[8 * s + 3]); pw.z = pkbf(tt[8 * s + 4], tt[8 * s + 5]); pw.w = pkbf(tt[8 * s + 6], tt[8 * s + 7]);
                const bf16x8 pf = __builtin_bit_cast(bf16x8, pw);
                const bf16x8 v0 = *(const LAS bf16x8*)(vb + r * AV_PITCH + s * 32 + h * 16);
                const bf16x8 v1 = *(const LAS bf16x8*)(vb + (r + 32) * AV_PITCH + s * 32 + h * 16);
                o0 = MFMA32(v0, pf, o0); o1 = MFMA32(v1, pf, o1);
            }
        }
        if (more) attn_stage_store<NTASK>(st, kbuf + (NBUF == 2 ? ((k + 1) & 1) * AK_BYTES : 0), vbuf + (NBUF == 2 ? ((k + 1) & 1) * AV_BYTES : 0), gtid, NTHR);
        if (SHARED) {
#pragma unroll
            for (int i = 0; i < NTASK; ++i) { st[i] = st2[i]; st2[i] = st3[i]; }
            __syncthreads();
        }
    }
    }
    if (MERGE) {
        const float lt = l + __shfl_xor(l, 32);
        if (h == 0) { mg[r] = m; mg[32 + r] = lt; }
#pragma unroll
        for (int i = 0; i < 16; ++i) { const int d = (i & 3) + 8 * (i >> 2) + 4 * h; mg[64 + d * 32 + r] = o0[i]; mg[64 + (d + 32) * 32 + r] = o1[i]; }
    } else if (W.active) {
        const float lt = l + __shfl_xor(l, 32); const float inv = 1.0f / lt;
        if (W.wr) {
#pragma unroll
            for (int g = 0; g < 4; ++g) {
                u32x2 w0; w0.x = pkbf(o0[4 * g] * inv, o0[4 * g + 1] * inv); w0.y = pkbf(o0[4 * g + 2] * inv, o0[4 * g + 3] * inv);
                u32x2 w1; w1.x = pkbf(o1[4 * g] * inv, o1[4 * g + 1] * inv); w1.y = pkbf(o1[4 * g + 2] * inv, o1[4 * g + 3] * inv);
                *(u32x2*)(W.orow + 8 * g + 4 * h) = w0; *(u32x2*)(W.orow + 32 + 8 * g + 4 * h) = w1;
            }
        }
    }
}
struct RelAll { __device__ __forceinline__ bool operator()(int) const { return true; } };
struct RelBandP { int lo, hi; __device__ __forceinline__ bool operator()(int t) const { return t >= lo && t <= hi; } };
struct SrcZ { const bf16* zb; int kpos_first, kcol, vcol;
    __device__ __forceinline__ v4u operator()(int t, bool isV, int key, int dc) const { const int col = kcol + (isV ? (vcol - kcol) : 0); return *(const v4u*)(zb + (size_t)(kpos_first + 32 * t + key) * DIN + col + dc * 8); } };
struct SrcCache { const float* ck; const float* cv; int hstride  ; int ncache; const bf16* znew; int kcol, vcol;
    __device__ __forceinline__ v4u operator()(int t, bool isV, int key, int dc) const {
        const long vd = isV ? (long)(cv - ck) : 0l; const int col = kcol + (isV ? (vcol - kcol) : 0);
        if (t < ncache) { const float* p = ck + vd + (size_t)(32 * t + key) * hstride + dc * 8; const f32x4 a = *(const f32x4*)p, b = *(const f32x4*)(p + 4); return pack8(a, b); }
        if (key < 16) return *(const v4u*)(znew + (size_t)key * DIN + col + dc * 8);
        return (v4u){0u, 0u, 0u, 0u}; } };

template <int NTMAX, class Src>
__device__ __forceinline__ void attn_run_all(LAS unsigned char* kbuf, LAS unsigned char* vbuf, int tid, int ntiles, const Src& src, const AttnWave& W) {
    const int lane = hw_lane(), r = lane & 31, h = lane >> 5;
    const int fr = (r & 0x13) | ((r & 4) << 1) | ((r & 8) >> 1);
    bf16x8 qf[4];
#pragma unroll
    for (int ks = 0; ks < 4; ++ks) qf[ks] = *(const bf16x8*)(W.qrow + ks * 16 + h * 8);
    { const int idx = tid & 255; const bool isV = tid >= 256;
      v4u st[NTMAX];
#pragma unroll
      for (int k = 0; k < NTMAX; ++k) if (k < ntiles) st[k] = src(k, isV, idx >> 3, idx & 7);
#pragma unroll
      for (int k = 0; k < NTMAX; ++k) if (k < ntiles) { const v4u one[1] = {st[k]}; attn_stage_store<1>(one, kbuf + k * AK_BYTES, vbuf + k * AV_BYTES, tid, 512); } }
    __syncthreads();
    float m = W.m0, l = W.l0;
    f32x16 o0, o1;
#pragma unroll
    for (int i = 0; i < 16; ++i) { o0[i] = 0.f; o1[i] = 0.f; }
#pragma unroll 1
    for (int k = 0; k < ntiles; ++k) {
        const LAS unsigned char* kb = kbuf + k * AK_BYTES;
        const LAS unsigned char* vb = vbuf + k * AV_BYTES;
        f32x16 x;
#pragma unroll
        for (int i = 0; i < 16; ++i) x[i] = 0.f;
#pragma unroll
        for (int ks = 0; ks < 4; ++ks) { const bf16x8 kf = *(const LAS bf16x8*)(kb + fr * AK_PITCH + ks * 32 + h * 16); x = MFMA32(kf, qf[ks], x); }
        float tt[16];
        const float c = 0.125f * LOG2E;
#pragma unroll
        for (int i = 0; i < 16; ++i) tt[i] = x[i] * c;
        float mt = tt[0];
#pragma unroll
        for (int i = 1; i < 16; ++i) mt = fmaxf(mt, tt[i]);
        mt = fmaxf(mt, __shfl_xor(mt, 32));
        if (__any(mt > m + 6.0f)) {
            const float mn = fmaxf(m, mt); const float alpha = fexp2(m - mn); m = mn;
            l *= alpha;
#pragma unroll
            for (int i = 0; i < 16; ++i) { o0[i] *= alpha; o1[i] *= alpha; }
        }
        float ps = 0.f;
#pragma unroll
        for (int i = 0; i < 16; ++i) { tt[i] = fexp2(tt[i] - m); ps += tt[i]; }
        l += ps;
#pragma unroll
        for (int s = 0; s < 2; ++s) {
            v4u pw; pw.x = pkbf(tt[8 * s], tt[8 * s + 1]); pw.y = pkbf(tt[8 * s + 2], tt[8 * s + 3]); pw.z = pkbf(tt[8 * s + 4], tt[8 * s + 5]); pw.w = pkbf(tt[8 * s + 6], tt[8 * s + 7]);
            const bf16x8 pf = __builtin_bit_cast(bf16x8, pw);
            const bf16x8 v0 = *(const LAS bf16x8*)(vb + r * AV_PITCH + s * 32 + h * 16);
            const bf16x8 v1 = *(const LAS bf16x8*)(vb + (r + 32) * AV_PITCH + s * 32 + h * 16);
            o0 = MFMA32(v0, pf, o0); o1 = MFMA32(v1, pf, o1);
        }
    }
    const float lt = l + __shfl_xor(l, 32); const float inv = 1.0f / lt;
#pragma unroll
    for (int g = 0; g < 4; ++g) {
        u32x2 w0; w0.x = pkbf(o0[4 * g] * inv, o0[4 * g + 1] * inv); w0.y = pkbf(o0[4 * g + 2] * inv, o0[4 * g + 3] * inv);
        u32x2 w1; w1.x = pkbf(o1[4 * g] * inv, o1[4 * g + 1] * inv); w1.y = pkbf(o1[4 * g + 2] * inv, o1[4 * g + 3] * inv);
        *(u32x2*)(W.orow + 8 * g + 4 * h) = w0; *(u32x2*)(W.orow + 32 + 8 * g + 4 * h) = w1;
    }
}

struct LruUnit {
    const bf16* zseq;
    const float* prefix;
    int n;
    int chn;
    float c8, cw0, cw1, cw2, cw3, cb, rb, ib;
    bf16x8 bfr[8], bfi[8];
};
__device__ __forceinline__ void lru_setup(LruUnit& U, int l, int n, int dq, const float* conv_w, const float* conv_b, const float* w_r, const float* b_r, const float* w_i, const float* b_i, const float* lam) {
    const int lane = hw_lane(), ch = lane & 15, kq = lane >> 4;
    U.n = n; U.chn = 64 * n + 16 * dq + ch;
    const float* Wr = w_r + ((size_t)(l * 16 + n) * 64) * 64 + 16 * dq + ch;
    const float* Wi = w_i + ((size_t)(l * 16 + n) * 64) * 64 + 16 * dq + ch;
    const float* cw = conv_w + (size_t)l * 4 * 1024 + 64 * n;
    const float* cbp = conv_b + (size_t)l * 1024 + 64 * n;
    float sr = 0.f, si = 0.f;
#pragma unroll
    for (int chalf = 0; chalf < 2; ++chalf) {
        float wr8[8], wi8[8];
#pragma unroll
        for (int jj = 0; jj < 8; ++jj) { const int c = 32 * chalf + 8 * kq + jj; wr8[jj] = Wr[c * 64]; wi8[jj] = Wi[c * 64]; const float cbv = cbp[c]; sr += cbv * wr8[jj]; si += cbv * wi8[jj]; }
#pragma unroll
        for (int j = 0; j < 4; ++j) {
            float t8[8];
#pragma unroll
            for (int jj = 0; jj < 8; ++jj) t8[jj] = cw[j * 1024 + 32 * chalf + 8 * kq + jj];
            v4u pr, pi;
#pragma unroll
            for (int e = 0; e < 4; ++e) { pr[e] = pkbf(t8[2 * e] * wr8[2 * e], t8[2 * e + 1] * wr8[2 * e + 1]); pi[e] = pkbf(t8[2 * e] * wi8[2 * e], t8[2 * e + 1] * wi8[2 * e + 1]); }
            U.bfr[j * 2 + chalf] = __builtin_bit_cast(bf16x8, pr); U.bfi[j * 2 + chalf] = __builtin_bit_cast(bf16x8, pi);
        }
    }
    sr += __shfl_xor(sr, 16); sr += __shfl_xor(sr, 32); si += __shfl_xor(si, 16); si += __shfl_xor(si, 32);
    U.rb = sr + b_r[(size_t)(l * 16 + n) * 64 + 16 * dq + ch]; U.ib = si + b_i[(size_t)(l * 16 + n) * 64 + 16 * dq + ch];
    const float lm = lam[(size_t)l * 1024 + U.chn];
    U.c8 = -8.0f * log1pf(expf(-lm));
    U.cw0 = conv_w[((size_t)l * 4 + 0) * 1024 + U.chn]; U.cw1 = conv_w[((size_t)l * 4 + 1) * 1024 + U.chn]; U.cw2 = conv_w[((size_t)l * 4 + 2) * 1024 + U.chn]; U.cw3 = conv_w[((size_t)l * 4 + 3) * 1024 + U.chn];
    U.cb = conv_b[(size_t)l * 1024 + U.chn];
}
__device__ __forceinline__ bf16x8 lru_ld8(const LruUnit& U, int trow, int c0) {
    v4u w;
    if (trow >= 0) w = *(const v4u*)(U.zseq + (size_t)trow * DIN + C_XB + 64 * U.n + c0);
    else if (U.prefix != nullptr) { const float* p = U.prefix + (trow + 3) * 1024 + 64 * U.n + c0; w = pack8(*(const f32x4*)p, *(const f32x4*)(p + 4)); }
    else w = (v4u){0u, 0u, 0u, 0u};
    return __builtin_bit_cast(bf16x8, w);
}
__device__ __forceinline__ float lru_xb(const LruUnit& U, int trow) {
    if (trow >= 0) return bf2f(U.zseq[(size_t)trow * DIN + C_XB + U.chn]);
    if (U.prefix != nullptr) return U.prefix[(trow + 3) * 1024 + U.chn];
    return 0.f;
}
__device__ __forceinline__ void lru_tile(const LruUnit& U, int t0, float& Ac, float& Hc, float (&P)[4], float (&hl)[4]) {
    const int lane = hw_lane(), tk = lane & 15, kq = lane >> 4, tq = kq;
    f32x4 ar = {U.rb, U.rb, U.rb, U.rb}, ai = {U.ib, U.ib, U.ib, U.ib};
#pragma unroll
    for (int j = 0; j < 4; ++j)
#pragma unroll
        for (int chalf = 0; chalf < 2; ++chalf) { const bf16x8 a = lru_ld8(U, t0 + tk - 3 + j, 32 * chalf + 8 * kq); ar = MFMA16(a, U.bfr[j * 2 + chalf], ar); ai = MFMA16(a, U.bfi[j * 2 + chalf], ai); }
    float xv[7];
#pragma unroll
    for (int e = 0; e < 7; ++e) xv[e] = lru_xb(U, t0 + 4 * tq - 3 + e);
    float a[4], u[4];
#pragma unroll
    for (int j = 0; j < 4; ++j) {
        const float xc = U.cb + U.cw0 * xv[j] + U.cw1 * xv[j + 1] + U.cw2 * xv[j + 2] + U.cw3 * xv[j + 3];
        const float rg = sigmoidf_fast(ar[j]), ig = sigmoidf_fast(ai[j]);
        const float la = U.c8 * rg;
        a[j] = fexp2(la * LOG2E);
        const float x2 = 2.0f * la;
        const float om = __builtin_fmaf(-a[j], a[j], 1.0f);
        u[j] = sqrtf(fmaxf(om, 0.f)) * (ig * xc);
    }
    P[0] = a[0]; hl[0] = u[0];
#pragma unroll
    for (int j = 1; j < 4; ++j) { P[j] = P[j - 1] * a[j]; hl[j] = a[j] * hl[j - 1] + u[j]; }
    float A = P[3], H = hl[3];
    { const float Ap = __shfl_up(A, 16), Hp = __shfl_up(H, 16); if (tq >= 1) { H = A * Hp + H; A = A * Ap; } }
    { const float Ap = __shfl_up(A, 32), Hp = __shfl_up(H, 32); if (tq >= 2) { H = A * Hp + H; A = A * Ap; } }
    float Aex = __shfl_up(A, 16), Hex = __shfl_up(H, 16); if (tq == 0) { Aex = 1.0f; Hex = 0.f; }
    const float At = __shfl(A, 48 + tk), Ht = __shfl(H, 48 + tk);
    const float Ae2 = Ac * Aex, He2 = Aex * Hc + Hex;
#pragma unroll
    for (int j = 0; j < 4; ++j) { hl[j] = P[j] * He2 + hl[j]; P[j] = Ae2 * P[j]; }
    Hc = At * Hc + Ht; Ac = Ac * At;
}
__device__ __forceinline__ void lru_setup_lds(LruUnit& U, LAS unsigned char* bl, LAS float* bsum, int wave, int l, int n, int dq, const float* conv_w, const float* conv_b, const float* w_r, const float* w_i, const float* lam) {
    const int lane = hw_lane(), ch = lane & 15, kq = lane >> 4;
    U.n = n; U.chn = 64 * n + 16 * dq + ch;
    const float* Wr = w_r + ((size_t)(l * 16 + n) * 64) * 64 + 16 * dq + ch;
    const float* Wi = w_i + ((size_t)(l * 16 + n) * 64) * 64 + 16 * dq + ch;
    const int j = wave >> 1, chalf = wave & 1;
    const float* cw = conv_w + ((size_t)l * 4 + j) * 1024 + 64 * n + 32 * chalf + 8 * kq;
    const float* cbp = conv_b + (size_t)l * 1024 + 64 * n + 32 * chalf + 8 * kq;
    float wr8[8], wi8[8], t8[8], cb8[8];
#pragma unroll
    for (int jj = 0; jj < 8; ++jj) { const int c = 32 * chalf + 8 * kq + jj; wr8[jj] = Wr[c * 64]; wi8[jj] = Wi[c * 64]; t8[jj] = cw[jj]; cb8[jj] = cbp[jj]; }
    v4u pr, pi;
#pragma unroll
    for (int e = 0; e < 4; ++e) { pr[e] = pkbf(t8[2 * e] * wr8[2 * e], t8[2 * e + 1] * wr8[2 * e + 1]); pi[e] = pkbf(t8[2 * e] * wi8[2 * e], t8[2 * e + 1] * wi8[2 * e + 1]); }
    *(LAS v4u*)(bl + wave * 1024 + lane * 16) = pr; *(LAS v4u*)(bl + (8 + wave) * 1024 + lane * 16) = pi;
    if (wave < 2) {
        float sr = 0.f, si = 0.f;
#pragma unroll
        for (int jj = 0; jj < 8; ++jj) { sr += cb8[jj] * wr8[jj]; si += cb8[jj] * wi8[jj]; }
        sr += __shfl_xor(sr, 16); sr += __shfl_xor(sr, 32); si += __shfl_xor(si, 16); si += __shfl_xor(si, 32);
        if (kq == 0) { bsum[(wave * 2 + 0) * 16 + ch] = sr; bsum[(wave * 2 + 1) * 16 + ch] = si; }
    }
    const float lm = lam[(size_t)l * 1024 + U.chn];
    U.c8 = -8.0f * log1pf(expf(-lm));
    U.cw0 = conv_w[((size_t)l * 4 + 0) * 1024 + U.chn]; U.cw1 = conv_w[((size_t)l * 4 + 1) * 1024 + U.chn]; U.cw2 = conv_w[((size_t)l * 4 + 2) * 1024 + U.chn]; U.cw3 = conv_w[((size_t)l * 4 + 3) * 1024 + U.chn];
    U.cb = conv_b[(size_t)l * 1024 + U.chn];
}
constexpr int LX_PITCH = 144, LX_ROWS = 515, LX_CHUNKS = LX_ROWS * 8, LX_EX_OFF = 75776, LX_BL_OFF = 77824, LX_BS_OFF = 94208, LX_GS_OFF = 94720  ;
__device__ __forceinline__ void lru_round_mfma(const LruUnit& U, const LAS unsigned char* slab, const LAS unsigned char* bl, int wtok, f32x4 (&ar)[4], f32x4 (&ai)[4]) {
    const int lane = hw_lane(), tk = lane & 15, kq = lane >> 4;
#pragma unroll
    for (int i = 0; i < 4; ++i) { ar[i] = (f32x4){U.rb, U.rb, U.rb, U.rb}; ai[i] = (f32x4){U.ib, U.ib, U.ib, U.ib}; }
#pragma unroll
    for (int j = 0; j < 4; ++j)
#pragma unroll
        for (int chalf = 0; chalf < 2; ++chalf) {
            const bf16x8 br = *(const LAS bf16x8*)(bl + (j * 2 + chalf) * 1024 + lane * 16), bi = *(const LAS bf16x8*)(bl + (8 + j * 2 + chalf) * 1024 + lane * 16);
#pragma unroll
            for (int i = 0; i < 4; ++i) { const bf16x8 a = *(const LAS bf16x8*)(slab + (wtok + 16 * i + tk + j) * LX_PITCH + (32 * chalf + 8 * kq) * 2); ar[i] = MFMA16(a, br, ar[i]); ai[i] = MFMA16(a, bi, ai[i]); }
        }
}
__device__ __forceinline__ void lru_tile_lds(const LruUnit& U, const LAS unsigned char* slab, const f32x4 ar, const f32x4 ai, int tloc, int dq, float& Ac, float& Hc, float (&P)[4], float (&hl)[4]) {
    const int lane = hw_lane(), tk = lane & 15, kq = lane >> 4, tq = kq;
    float xv[7];
#pragma unroll
    for (int e = 0; e < 7; ++e) xv[e] = bf2f(*(const LAS unsigned short*)(slab + (tloc + 4 * tq + e) * LX_PITCH + (16 * dq + tk) * 2));
    float a[4], u[4];
#pragma unroll
    for (int j = 0; j < 4; ++j) {
        const float xc = U.cb + U.cw0 * xv[j] + U.cw1 * xv[j + 1] + U.cw2 * xv[j + 2] + U.cw3 * xv[j + 3];
        const float rg = sigmoidf_fast(ar[j]), ig = sigmoidf_fast(ai[j]);
        const float la = U.c8 * rg;
        a[j] = fexp2(la * LOG2E);
        const float x2 = 2.0f * la;
        const float om = __builtin_fmaf(-a[j], a[j], 1.0f);
        u[j] = sqrtf(fmaxf(om, 0.f)) * (ig * xc);
    }
    P[0] = a[0]; hl[0] = u[0];
#pragma unroll
    for (int j = 1; j < 4; ++j) { P[j] = P[j - 1] * a[j]; hl[j] = a[j] * hl[j - 1] + u[j]; }
    float A = P[3], H = hl[3];
    { const float Ap = __shfl_up(A, 16), Hp = __shfl_up(H, 16); if (tq >= 1) { H = A * Hp + H; A = A * Ap; } }
    { const float Ap = __shfl_up(A, 32), Hp = __shfl_up(H, 32); if (tq >= 2) { H = A * Hp + H; A = A * Ap; } }
    float Aex = __shfl_up(A, 16), Hex = __shfl_up(H, 16); if (tq == 0) { Aex = 1.0f; Hex = 0.f; }
    const float At = __shfl(A, 48 + tk), Ht = __shfl(H, 48 + tk);
    const float Ae2 = Ac * Aex, He2 = Aex * Hc + Hex;
#pragma unroll
    for (int j = 0; j < 4; ++j) { hl[j] = P[j] * He2 + hl[j]; P[j] = Ae2 * P[j]; }
    Hc = At * Hc + Ht; Ac = Ac * At;
}
__device__ __forceinline__ void lru_round_lds(const LruUnit& U, const LAS unsigned char* slab, const LAS unsigned char* bl, int wtok, int dq, float& At, float& Ht, float (&P)[16], float (&hl)[16]) {
    const int lane = hw_lane(), tk = lane & 15, kq = lane >> 4, tq = kq;
    f32x4 ar[4], ai[4];
#pragma unroll
    for (int i = 0; i < 4; ++i) { ar[i] = (f32x4){U.rb, U.rb, U.rb, U.rb}; ai[i] = (f32x4){U.ib, U.ib, U.ib, U.ib}; }
    const LAS unsigned char* arow = slab + (wtok + 16 * (tk >> 2) + (tk & 3)) * LX_PITCH;
    const int cq0 = 16 * (kq ^ ((tk >> 2) & 3)), cq1 = 16 * (kq ^ (((tk >> 2) + 1) & 3));
#pragma unroll
    for (int j = 0; j < 4; ++j)
#pragma unroll
        for (int chalf = 0; chalf < 2; ++chalf) {
            const bf16x8 br = *(const LAS bf16x8*)(bl + (j * 2 + chalf) * 1024 + lane * 16), bi = *(const LAS bf16x8*)(bl + (8 + j * 2 + chalf) * 1024 + lane * 16);
#pragma unroll
            for (int i = 0; i < 4; ++i) { const int cq = (((tk & 3) + 4 * i + j) >> 4) ? cq1 : cq0;
                const bf16x8 a = *(const LAS bf16x8*)(arow + (4 * i + j) * LX_PITCH + chalf * 64 + cq); ar[i] = MFMA16(a, br, ar[i]); ai[i] = MFMA16(a, bi, ai[i]); }
        }
    float xv[19];
    { const LAS unsigned char* xp = slab + (wtok + 16 * tq) * LX_PITCH + (tk & 7) * 2; const int xc = 2 * dq + (tk >> 3), x0 = 16 * (xc ^ tq), x1 = 16 * (xc ^ ((tq + 1) & 3));
#pragma unroll
      for (int e = 0; e < 19; ++e) xv[e] = bf2f(*(const LAS unsigned short*)(xp + e * LX_PITCH + (e < 16 ? x0 : x1))); }
#pragma unroll
    for (int i = 0; i < 4; ++i)
#pragma unroll
        for (int r = 0; r < 4; ++r) { const int k = 4 * i + r;
            const float xc = U.cb + U.cw0 * xv[k] + U.cw1 * xv[k + 1] + U.cw2 * xv[k + 2] + U.cw3 * xv[k + 3];
            const float rg = sigmoidf_fast(ar[i][r]), ig = sigmoidf_fast(ai[i][r]);
            const float la = U.c8 * rg;
            const float a = fexp2(la * LOG2E);
            const float x2 = 2.0f * la;
            const float om = __builtin_fmaf(-a, a, 1.0f);
            const float u = __builtin_amdgcn_sqrtf(fmaxf(om, 0.f)) * (ig * xc);
            if (k == 0) { P[0] = a; hl[0] = u; } else { P[k] = P[k - 1] * a; hl[k] = a * hl[k - 1] + u; } }
    float A = P[15], H = hl[15];
    { const float Ap = __shfl_up(A, 16), Hp = __shfl_up(H, 16); if (tq >= 1) { H = A * Hp + H; A = A * Ap; } }
    { const float Ap = __shfl_up(A, 32), Hp = __shfl_up(H, 32); if (tq >= 2) { H = A * Hp + H; A = A * Ap; } }
    float Aex = __shfl_up(A, 16), Hex = __shfl_up(H, 16); if (tq == 0) { Aex = 1.0f; Hex = 0.f; }
    At = __shfl(A, 48 + tk); Ht = __shfl(H, 48 + tk);
#pragma unroll
    for (int k = 0; k < 16; ++k) { hl[k] = P[k] * Hex + hl[k]; P[k] = Aex * P[k]; }
}
__device__ __forceinline__ float gelu_tanh(float g) { const float y = 0.7978845608028654f * (g + 0.044715f * g * g * g); return g * sigmoidf_fast(2.0f * y); }


template <int ROWT, int NC, int UNR, class Epi, int ORDER = 0>
__device__ __forceinline__ void skinny_gemm(LAS unsigned char* lds, const bf16* A, int lda, const bf16* Wt, int K, int N, int Mrows, int tid, int bid, int G, const Epi& epi) {
    constexpr int CT = (NC + 15) / 16, PW = CT * 16, ROWS = ROWT * 16; const int RG = Mrows / ROWS;
    const int lane = tid & 63, wave = __builtin_amdgcn_readfirstlane(tid >> 6), r16 = lane & 15, kq = lane >> 4;
    LAS float* P = (LAS float*)lds;
    const int nunits = (N / NC) * RG;
    for (int unit0 = bid; unit0 < nunits * REP_S; unit0 += G) { const int unit = unit0 % nunits;
        const int rg = ORDER ? (unit0 % G) % RG : unit % RG, n0 = (ORDER ? ((unit0 % G) / RG) * 2 + (unit0 / G) : unit / RG) * NC, row0 = rg * ROWS, kw = K / 8, k0 = wave * kw;
        f32x4 acc[ROWT][CT];
#pragma unroll
        for (int rt = 0; rt < ROWT; ++rt)
#pragma unroll
            for (int ct = 0; ct < CT; ++ct) acc[rt][ct] = (f32x4){0.f, 0.f, 0.f, 0.f};
        const bf16* ap = A + (size_t)(row0 + r16) * lda + k0 + 8 * kq;
        const bf16* bp[CT];
#pragma unroll
        for (int ct = 0; ct < CT; ++ct) { int col = ct * 16 + r16; col = col < NC ? col : NC - 1; bp[ct] = Wt + (size_t)(n0 + col) * K + k0 + 8 * kq; }
#pragma unroll UNR
        for (int ks = 0; ks < kw / 32; ++ks) {
            bf16x8 a[ROWT], b[CT];
#pragma unroll
            for (int rt = 0; rt < ROWT; ++rt) a[rt] = *(const bf16x8*)(ap + (size_t)rt * 16 * lda + ks * 32);
#pragma unroll
            for (int ct = 0; ct < CT; ++ct) b[ct] = *(const bf16x8*)(bp[ct] + ks * 32);
#pragma unroll
            for (int rt = 0; rt < ROWT; ++rt)
#pragma unroll
                for (int ct = 0; ct < CT; ++ct) acc[rt][ct] = MFMA16(a[rt], b[ct], acc[rt][ct]);
        }
        __syncthreads();
#pragma unroll
        for (int rt = 0; rt < ROWT; ++rt)
#pragma unroll
            for (int ct = 0; ct < CT; ++ct)
#pragma unroll
                for (int e = 0; e < 4; ++e) P[(size_t)((wave * ROWS + rt * 16 + 4 * kq + e) * PW) + ct * 16 + r16] = acc[rt][ct][e];
        __syncthreads();
        for (int e = tid; e < ROWS * NC; e += 512) { const int row = e / NC, c = e % NC; float sum = 0.f;
#pragma unroll
            for (int w = 0; w < 8; ++w) sum += P[(w * ROWS + row) * PW + c];
            epi(row0 + row, n0 + c, sum); }
    }
    __syncthreads();
}
struct SkEpiBf16 { bf16* C; int ldc; __device__ __forceinline__ void operator()(int row, int col, float v) const { C[(size_t)row * ldc + col] = (bf16)f2bf(v); } };
struct SkEpiF32 { float* C; int ldc; __device__ __forceinline__ void operator()(int row, int col, float v) const { C[(size_t)row * ldc + col] = v; } };
struct SkEpiRelu2 { bf16* C; int ldc; __device__ __forceinline__ void operator()(int row, int col, float v) const { const float r = fmaxf(v, 0.f); C[(size_t)row * ldc + col] = (bf16)f2bf(r * r); } };
struct SkEpiT16 { bf16* Z; float* out; int L;
    __device__ __forceinline__ void operator()(int row, int col, float v) const {
        Z[(size_t)row * DIN + 4096 + col] = (bf16)f2bf(v);
        const int b = row >> 11, t = row & 2047;
        if (t >= 1536) out[pg8::O_BVP + ((size_t)(L * 4 + b) * 512 + (t - 1536)) * 512 + 256 + col] = v;
    } };
struct SkEpiInProj { bf16* Zs; float* out; int L;
    __device__ __forceinline__ void operator()(int row, int col, float v) const {
        Zs[(size_t)row * DIN + col] = (bf16)f2bf(v);
        const int bs = row >> 4, t = row & 15;
        if (col >= C_KA && col < C_XB) { const bool isV = col >= C_VA; const int c = col - (isV ? C_VA : C_KA); out[(isV ? pg8::O_SVS : pg8::O_SKS) + ((size_t)(L * 8 + bs) * 16 + t) * 128 + c] = v; }
        else if (col >= C_XB && col < C_GB) { if (t >= 13) out[pg8::O_LCS + ((size_t)(L * 8 + bs) * 3 + (t - 13)) * 1024 + (col - C_XB)] = v; }
        else if (col >= C_KC) { const bool isV = col >= C_VC; const int c = col - (isV ? C_VC : C_KC); out[(isV ? pg8::O_BVS : pg8::O_BKS) + ((size_t)(L * 8 + bs) * 16 + t) * 512 + c] = v; }
    } };


template <int TR, int TC, int WR, int WC, int KS, int PF, class Epi>
__device__ __forceinline__ void mini_gemm(LAS unsigned char* lds, const bf16* A, int lda, int Mrows, const bf16* Wt, int N, int K, int tid, int bid, int G, const Epi& epi) {
    constexpr int KC = 256, PITCH = 528, NP = (TR + TC) * 32 / 512, MT = TR / WR / 16, NT = TC / WC / 16, KSTEPS = 8 / KS;
    static_assert(WR * WC * KS == 8 && (TR + TC) * 32 % 512 == 0 && MT >= 1 && NT >= 1, "mini_gemm geometry");
    const int lane = tid & 63, wave = __builtin_amdgcn_readfirstlane(tid >> 6), r16 = lane & 15, kq = lane >> 4;
    const int wk = wave / (WR * WC), wrc = wave % (WR * WC), wr = wrc / WC, wc = wrc % WC;
    LAS unsigned char* As = lds; LAS unsigned char* Bs = lds + TR * PITCH;
    const int RG = Mrows / TR, nunits = RG * (N / TC), nch = K / KC;
    for (int unit = bid; unit < nunits; unit += G) {
        const int rg = unit % RG, row0 = rg * TR, n0 = (unit / RG) * TC;
        const bf16* src[NP]; int dst[NP];
#pragma unroll
        for (int i = 0; i < NP; ++i) { const int p = tid + 512 * i, r = p >> 5, c = p & 31;
            src[i] = (r < TR) ? A + (size_t)(row0 + r) * lda + c * 8 : Wt + (size_t)(n0 + r - TR) * K + c * 8; dst[i] = r * PITCH + c * 16; }
        f32x4 acc[MT][NT];
#pragma unroll
        for (int m = 0; m < MT; ++m)
#pragma unroll
            for (int n = 0; n < NT; ++n) acc[m][n] = (f32x4){0.f, 0.f, 0.f, 0.f};
        v4u st[PF][NP];
#pragma unroll
        for (int d = 0; d < PF; ++d)
#pragma unroll
            for (int i = 0; i < NP; ++i) st[d][i] = *(const v4u*)(src[i] + (size_t)(d < nch ? d : 0) * KC);
        for (int ch = 0; ch < nch; ch += PF) {
#pragma unroll
            for (int d = 0; d < PF; ++d) {
                __syncthreads();
#pragma unroll
                for (int i = 0; i < NP; ++i) *(LAS v4u*)(lds + dst[i]) = st[d][i];
                if (ch + d + PF < nch) {
#pragma unroll
                    for (int i = 0; i < NP; ++i) st[d][i] = *(const v4u*)(src[i] + (size_t)(ch + d + PF) * KC);
                }
                __syncthreads();
#pragma unroll
                for (int ks = 0; ks < KSTEPS; ++ks) { const int kb = ((wk * KSTEPS + ks) * 32 + 8 * kq) * 2;
                    bf16x8 a[MT], b[NT];
#pragma unroll
                    for (int m = 0; m < MT; ++m) a[m] = *(const LAS bf16x8*)(As + ((wr * MT + m) * 16 + r16) * PITCH + kb);
#pragma unroll
                    for (int n = 0; n < NT; ++n) b[n] = *(const LAS bf16x8*)(Bs + ((wc * NT + n) * 16 + r16) * PITCH + kb);
#pragma unroll
                    for (int m = 0; m < MT; ++m)
#pragma unroll
                        for (int n = 0; n < NT; ++n) acc[m][n] = MFMA16(a[m], b[n], acc[m][n]);
                }
            }
        }
        __syncthreads();
        if (KS > 1) {
            LAS f32x4* P = (LAS f32x4*)lds;
            if (wk > 0) {
#pragma unroll
                for (int m = 0; m < MT; ++m)
#pragma unroll
                    for (int n = 0; n < NT; ++n) P[(((wk - 1) * (WR * WC) + wrc) * (MT * NT) + m * NT + n) * 64 + lane] = acc[m][n];
            }
            __syncthreads();
            if (wk == 0) {
#pragma unroll
                for (int k2 = 1; k2 < KS; ++k2)
#pragma unroll
                    for (int m = 0; m < MT; ++m)
#pragma unroll
                        for (int n = 0; n < NT; ++n) acc[m][n] += P[(((k2 - 1) * (WR * WC) + wrc) * (MT * NT) + m * NT + n) * 64 + lane];
            }
        }
        if (wk == 0) {
#pragma unroll
            for (int m = 0; m < MT; ++m)
#pragma unroll
                for (int n = 0; n < NT; ++n)
#pragma unroll
                    for (int e = 0; e < 4; ++e) epi(row0 + (wr * MT + m) * 16 + 4 * kq + e, n0 + (wc * NT + n) * 16 + r16, acc[m][n][e]);
        }
    }
    __syncthreads();
}

constexpr int J_IN = (DM / P0_KH) * (DIN / 256), J_OUT = (DM / P0_KH) * (DM / 256), J_UP = (DM / P0_KH) * (DFF / 256), J_DN = (DFF / P0_KH) * (DM / 256), J_L = J_IN + J_OUT + J_UP + J_DN;
#ifndef BARWORK
#define BARWORK 1
#endif
#ifndef BARWORK_EXTRA
#define BARWORK_EXTRA 0
#endif
template <class Work>
__device__ __forceinline__ void xcd_barrier_work(const XcdBarrier& b, bool t0, unsigned* queue, unsigned nitems, volatile LAS unsigned* slot, const Work& work) {
    asm volatile("s_waitcnt vmcnt(0)" ::: "memory");
    __syncthreads();
    bool leader = true; unsigned gen = 0u;
    if (t0) {
        unsigned* bar = b.bar;
        __builtin_amdgcn_s_waitcnt(0);
        unsigned nloc = b.st[0], nx = b.st[1];
        if (nloc == 0u) { xcd_barrier_complete(bar, b.x, nloc, nx); b.st[0] = nloc; b.st[1] = nx; }
        const unsigned old = xb_add(&bar[XB_XSUB(b.x)], 1u);
        gen = old / nloc;
        leader = (old + 1u == (gen + 1u) * nloc);
        if (leader) {
            __builtin_amdgcn_fence(__ATOMIC_RELEASE, "agent");
            asm volatile("s_waitcnt vmcnt(0)" ::: "memory");
            const unsigned og = xb_add(&bar[XB_TOP], 1u);
            const unsigned tg = og / nx;
            if (og + 1u == (tg + 1u) * nx) xb_add(&bar[XB_TOPGEN], 1u);
            else XB_SPIN(xb_ld(&bar[XB_TOPGEN]) == tg, bar);
            __builtin_amdgcn_fence(__ATOMIC_ACQUIRE, "agent");
            xb_add(&bar[XB_XGEN(b.x)], 1u);
            asm volatile("s_waitcnt vmcnt(0)" ::: "memory");
            slot[0] = 0xffffffffu;
        } else {
            slot[0] = (nitems != 0u) ? xb_add(queue, 1u) : 0xffffffffu;
        }
    }
    __syncthreads();
    unsigned ticket = (unsigned)__builtin_amdgcn_readfirstlane((int)slot[0]);
    if (ticket < nitems) {
        work((int)ticket);
#if BARWORK_EXTRA
        for (int extra = 0; extra < BARWORK_EXTRA; ++extra) {
            if (t0) { unsigned more = 0xffffffffu;
                      const unsigned nloc = b.st[0];
                      const unsigned arrived = xb_ld(&b.bar[XB_XSUB(b.x)]) - gen * nloc;
                      if (arrived < nloc) more = xb_add(queue, 1u);
                      slot[0] = more; }
            __syncthreads();
            ticket = (unsigned)__builtin_amdgcn_readfirstlane((int)slot[0]);
            __syncthreads();
            if (ticket >= nitems) break;
            work((int)ticket);
        }
#endif
    }
    if (t0 && !leader) {
        unsigned* bar = b.bar;
        XB_SPIN(xb_ld(&bar[XB_XGEN(b.x)]) == gen, bar);
        __builtin_amdgcn_fence(__ATOMIC_ACQUIRE, "agent");
        asm volatile("s_waitcnt vmcnt(0)" ::: "memory");
    }
    __syncthreads();
}
struct Args { const float* in[29]; float* out; unsigned char* ws; int ph_lo, ph_hi; };
static_assert(sizeof(Args) == 31 * 8 + 8, "Args has no padding");
constexpr int N_PHASES = 2 + 7 * NL;


typedef const __attribute__((address_space(4))) Args* KArgs;
__device__ __forceinline__ KArgs kargs() { KArgs p = (KArgs)__builtin_amdgcn_kernarg_segment_ptr(); asm volatile("" : "+s"(p)); return p; }
#define TIDS() int tid_ = wave0 * 64 + hw_lane(); asm volatile("" : "+v"(tid_)); const int tid = tid_, lane = tid & 63, wave = __builtin_amdgcn_readfirstlane(tid >> 6); (void)tid; (void)lane; (void)wave
#define GWS() int G_ = gridDim.x, bid_ = blockIdx.x; asm volatile("" : "+s"(G_), "+s"(bid_)); const int G = G_, bid = bid_; const int vcu = (G % 8 == 0) ? (bid % 8) * (G / 8) + bid / 8 : bid; const int gw = vcu * NWAVES + wave, NGW = G * NWAVES; (void)gw; (void)NGW

__global__ void __launch_bounds__(NWAVES * 64, 2) mk_fwd(Args args) {
    extern __shared__ __attribute__((aligned(16))) unsigned char lds_raw[];
    LAS unsigned char* lds = (LAS unsigned char*)lds_raw;
    const int wave0 = __builtin_amdgcn_readfirstlane((int)threadIdx.x >> 6);
    { const int tid0 = threadIdx.x; for (int u = tid0; u < (LDS_BYTES - LDSCTL_OFF) / 4; u += NWAVES * 64) ((LAS unsigned*)(lds + LDSCTL_OFF))[u] = 0u; }
    __syncthreads();
    const int lo = args.ph_lo, hi = args.ph_hi;
    const bool use_bar = (hi - lo) > 1;
    XcdBarrier bar; bar.bar = (unsigned*)(args.ws + WS_CTL) + CW_BAR; bar.x = 0; bar.st = nullptr;
    if (use_bar) bar = xcd_barrier_post((unsigned*)(args.ws + WS_CTL) + CW_BAR, (volatile LAS unsigned*)(lds + MISC_OFF) + 8, threadIdx.x == 0);
#define IN(k) (lo <= (k) && (k) < hi)
    const bool defer = BARWORK && use_bar && lo == 0 && hi == N_PHASES;
    auto conv_item = [&](int lnext, int r) {
        KArgs KA = kargs(); unsigned char* ws = KA->ws; const int tid = wave0 * 64 + hw_lane();
        const float* W; int K, N; bf16* WT; int rr = r;
        if (rr < J_IN) { W = KA->in[13] + (size_t)lnext * DM * DIN; K = DM; N = DIN; WT = (bf16*)(ws + WS_WIN) + (size_t)lnext * DIN * DM; }
        else if ((rr -= J_IN) < J_OUT) { W = KA->in[23] + (size_t)lnext * DM * DM; K = DM; N = DM; WT = (bf16*)(ws + WS_WOUT) + (size_t)lnext * DM * DM; }
        else if ((rr -= J_OUT) < J_UP) { W = KA->in[26] + (size_t)lnext * DM * DFF; K = DM; N = DFF; WT = (bf16*)(ws + WS_WUP) + (size_t)lnext * DFF * DM; }
        else { rr -= J_UP; W = KA->in[27] + (size_t)lnext * DFF * DM; K = DFF; N = DM; WT = (bf16*)(ws + WS_WDN) + (size_t)lnext * DM * DFF; }
        f32x4 pre[P0_NI]; p0_tile_load(W, N, rr, tid, pre); p0_tile_store(pre, K, N, WT, lds, rr, tid);
        __syncthreads();
    };
    constexpr int NTOT = NL * J_L - J_IN;
    auto seam = [&](int k) {
        const bool t0 = (wave0 == 0 && hw_lane() == 0);
        if (!defer) { xcd_barrier(bar, t0); return; }
        unsigned* queue = (unsigned*)(kargs()->ws + WS_CTL) + CW_DQ;
        volatile LAS unsigned* slot = (volatile LAS unsigned*)(lds + MISC_OFF) + 10;
        int required = 0;
        { const int p = k + 1; if (p >= 2) { const int l = (p - 2) / 7, j = (p - 2) % 7;
            if (j == 0) required = l * J_L; else if (j == 2) required = l * J_L + J_OUT; else if (j == 4) required = l * J_L + J_OUT + J_UP; else if (j == 5) required = (l + 1) * J_L - J_IN; } }
        if (required > 0) {
            for (;;) {
                __syncthreads();
                if (t0) { unsigned tk = 0xffffffffu; if (xb_ld(queue) < (unsigned)required) tk = xb_add(queue, 1u); slot[0] = tk; }
                __syncthreads();
                const unsigned ticket = (unsigned)__builtin_amdgcn_readfirstlane((int)slot[0]);
                if (ticket >= (unsigned)NTOT) break;
                { const int g = J_IN + (int)ticket; conv_item(g / J_L, g % J_L); }
            }
        }
        xcd_barrier_work(bar, t0, queue, (unsigned)NTOT, slot, [&](int q) { const int g = J_IN + q; conv_item(g / J_L, g % J_L); });
    };
#define SEAM(k) do { if (IN(k) && IN((k) + 1)) { seam(k); } } while (0)

    if (IN(0)) {
        KArgs KA = kargs(); unsigned char* ws = KA->ws; TIDS(); GWS();
#if P0_DYN
        unsigned* qctr = (unsigned*)(ws + WS_CTL) + CW_Q;
        volatile LAS unsigned* mq = (volatile LAS unsigned*)(lds + MISC_OFF) + 12;
        p0_mods<true>(qctr, mq, lds, KA->in[2], KA->in[3], KA->in[10], KA->in[11], KA->in[12], KA->in[24], KA->in[25], KA->in[28], (float*)(ws + WS_MOD), G, bid, tid);
#else
        p0_mods<false>(nullptr, nullptr, lds, KA->in[2], KA->in[3], KA->in[10], KA->in[11], KA->in[12], KA->in[24], KA->in[25], KA->in[28], (float*)(ws + WS_MOD), G, bid, tid);
#endif
        const float* w_in = KA->in[13]; const float* w_out = KA->in[23];
        bf16* WIN = (bf16*)(ws + WS_WIN); bf16* WOUT = (bf16*)(ws + WS_WOUT);
        LAS float* scr = (LAS float*)(lds + wave * 16384);
        constexpr int I_IN = (DM / 64) * (DIN / 32), I_OUT = (DM / 64) * (DM / 32), I_UP = (TAIL_MODE >= 1) ? 0 : (DM / 64) * (DFF / 32), I_DN = (TAIL_MODE >= 2) ? 0 : (DFF / 64) * (DM / 32), I_L = I_IN + I_OUT + I_UP + I_DN;
        const float* w_up = KA->in[26]; const float* w_down = KA->in[27]; bf16* WUP = (bf16*)(ws + WS_WUP); bf16* WDN = (bf16*)(ws + WS_WDN);
        {
        const int nfree = (G > MODS_ITEMS) ? (G - MODS_ITEMS) : 0, nslots = G + nfree;
        const int slot0 = (bid < MODS_ITEMS || nfree == 0) ? bid : MODS_ITEMS + (bid - MODS_ITEMS) * 2, nmine = (bid < MODS_ITEMS || nfree == 0) ? 1 : 2;
        const int NLIST = (BARWORK && (args.ph_hi - args.ph_lo) == N_PHASES) ? J_IN : REP_P0 * NL * J_L;
        auto item_of = [&](int q) -> int { const int it = (q / nmine) * nslots + slot0 + (q % nmine); return it < NLIST ? it : -1; };
#if P0_DYN
#define P0_DECODE(it_, W_, K_, N_, WT_) do { const int l_ = ((it_) % (NL * J_L)) / J_L; int r_ = (it_) % J_L; \
            if (r_ < J_IN) { W_ = w_in + (size_t)l_ * DM * DIN; K_ = DM; N_ = DIN; WT_ = WIN + (size_t)l_ * DIN * DM; } \
            else if ((r_ -= J_IN) < J_OUT) { W_ = w_out + (size_t)l_ * DM * DM; K_ = DM; N_ = DM; WT_ = WOUT + (size_t)l_ * DM * DM; } \
            else if ((r_ -= J_OUT) < J_UP) { W_ = w_up + (size_t)l_ * DM * DFF; K_ = DM; N_ = DFF; WT_ = WUP + (size_t)l_ * DFF * DM; } \
            else { r_ -= J_UP; W_ = w_down + (size_t)l_ * DFF * DM; K_ = DFF; N_ = DM; WT_ = WDN + (size_t)l_ * DM * DFF; } \
            it_ = r_; } while (0)
        (void)item_of;
        constexpr int NIT = REP_P0 * NL * J_L;
        unsigned* qc = qctr + 64;
        unsigned nn = 0u;
        __syncthreads();
        if (tid == 0) { mq[0] = __hip_atomic_fetch_add(qc, 1u, __ATOMIC_RELAXED, __HIP_MEMORY_SCOPE_AGENT); mq[1] = __hip_atomic_fetch_add(qc, 1u, __ATOMIC_RELAXED, __HIP_MEMORY_SCOPE_AGENT);
                        nn = __hip_atomic_fetch_add(qc, 1u, __ATOMIC_RELAXED, __HIP_MEMORY_SCOPE_AGENT); }
        __syncthreads();
        int it = __builtin_amdgcn_readfirstlane((int)mq[0]), itn = __builtin_amdgcn_readfirstlane((int)mq[1]);
        f32x4 pre[8];
        const float* Wc = nullptr; int Kc = 0, Nc = 0; bf16* WTc = nullptr; int rc = it;
        if (it < NIT) { P0_DECODE(rc, Wc, Kc, Nc, WTc); p0_tile_load(Wc, Nc, rc, tid, pre); }
        while (it < NIT) {
            f32x4 cur[8];
#pragma unroll
            for (int i = 0; i < 8; ++i) cur[i] = pre[i];
            const float* Wn = nullptr; int Kn = 0, Nn = 0; bf16* WTn = nullptr; int rn = itn;
            if (itn < NIT) { P0_DECODE(rn, Wn, Kn, Nn, WTn); p0_tile_load(Wn, Nn, rn, tid, pre); }
            {
                LAS unsigned char* scr = lds;
                const int nblk = Nc / 256, kb = rc / nblk, nb = rc % nblk;
                __syncthreads();
#pragma unroll
                for (int i = 0; i < 8; ++i) { u32x2 w; w.x = pkbf(cur[i][0], cur[i][1]); w.y = pkbf(cur[i][2], cur[i][3]); *(LAS u32x2*)(scr + (8 * i + (tid >> 6)) * TP_PITCH + (tid & 63) * 8) = w; }
                if (tid == 0) { mq[0] = nn; nn = __hip_atomic_fetch_add(qc, 1u, __ATOMIC_RELAXED, __HIP_MEMORY_SCOPE_AGENT); }
                __syncthreads();
                const int kc = tid & 7;
#pragma unroll
                for (int j = 0; j < 4; ++j) { const int n = (tid >> 3) + 64 * j; const LAS unsigned char* sp = scr + (8 * kc) * TP_PITCH + n * 2;
                    unsigned short e[8];
#pragma unroll
                    for (int q = 0; q < 8; ++q) e[q] = *(const LAS unsigned short*)(sp + q * TP_PITCH);
                    v4u o; o.x = e[0] | ((unsigned)e[1] << 16); o.y = e[2] | ((unsigned)e[3] << 16); o.z = e[4] | ((unsigned)e[5] << 16); o.w = e[6] | ((unsigned)e[7] << 16);
                    *(GAS v4u*)(WTc + (size_t)(256 * nb + n) * Kc + 64 * kb + 8 * kc) = o; }
            }
            const int itnn = __builtin_amdgcn_readfirstlane((int)mq[0]);
            Wc = Wn; Kc = Kn; Nc = Nn; WTc = WTn; rc = rn; it = itn; itn = itnn;
        }
#elif P0_DEEP
#define P0_DECODE(it_, W_, K_, N_, WT_) do { const int l_ = ((it_) % (NL * J_L)) / J_L; int r_ = (it_) % J_L; \
            if (r_ < J_IN) { W_ = w_in + (size_t)l_ * DM * DIN; K_ = DM; N_ = DIN; WT_ = WIN + (size_t)l_ * DIN * DM; } \
            else if ((r_ -= J_IN) < J_OUT) { W_ = w_out + (size_t)l_ * DM * DM; K_ = DM; N_ = DM; WT_ = WOUT + (size_t)l_ * DM * DM; } \
            else if ((r_ -= J_OUT) < J_UP) { W_ = w_up + (size_t)l_ * DM * DFF; K_ = DM; N_ = DFF; WT_ = WUP + (size_t)l_ * DFF * DM; } \
            else { r_ -= J_UP; W_ = w_down + (size_t)l_ * DFF * DM; K_ = DFF; N_ = DM; WT_ = WDN + (size_t)l_ * DM * DFF; } \
            it_ = r_; } while (0)
        f32x4 pa[8], pb[8];
        int q = 0;
        int ita = item_of(0), itb = item_of(1);
        const float* Wa = nullptr; int Ka = 0, Na = 0; bf16* WTa = nullptr; int ra = ita;
        const float* Wb = nullptr; int Kb = 0, Nb = 0; bf16* WTb = nullptr; int rb = itb;
        if (ita >= 0) { P0_DECODE(ra, Wa, Ka, Na, WTa); p0_tile_load(Wa, Na, ra, tid, pa); }
        if (itb >= 0) { P0_DECODE(rb, Wb, Kb, Nb, WTb); p0_tile_load(Wb, Nb, rb, tid, pb); }
        while (ita >= 0) {
            { u32x2 w[8];
#pragma unroll
              for (int i = 0; i < 8; ++i) { w[i].x = pkbf(pa[i][0], pa[i][1]); w[i].y = pkbf(pa[i][2], pa[i][3]); }
              const int itn = item_of(q + 2); const float* Wn = nullptr; int Kn = 0, Nn = 0; bf16* WTn = nullptr; int rn = itn;
              if (itn >= 0) { P0_DECODE(rn, Wn, Kn, Nn, WTn); p0_tile_load(Wn, Nn, rn, tid, pa); }
              p0_tile_store_pk(w, Ka, Na, WTa, lds, ra, tid);
              Wa = Wn; Ka = Kn; Na = Nn; WTa = WTn; ra = rn; ita = itn; }
            if (itb < 0) break;
            { u32x2 w[8];
#pragma unroll
              for (int i = 0; i < 8; ++i) { w[i].x = pkbf(pb[i][0], pb[i][1]); w[i].y = pkbf(pb[i][2], pb[i][3]); }
              const int itn = item_of(q + 3); const float* Wn = nullptr; int Kn = 0, Nn = 0; bf16* WTn = nullptr; int rn = itn;
              if (itn >= 0) { P0_DECODE(rn, Wn, Kn, Nn, WTn); p0_tile_load(Wn, Nn, rn, tid, pb); }
              p0_tile_store_pk(w, Kb, Nb, WTb, lds, rb, tid);
              Wb = Wn; Kb = Kn; Nb = Nn; WTb = WTn; rb = rn; itb = itn; }
            q += 2;
        }
#else
        f32x4 pre[P0_NI];
        int q = 0, it = item_of(0);
#define P0_DECODE(it_, W_, K_, N_, WT_) do { const int l_ = ((it_) % (NL * J_L)) / J_L; int r_ = (it_) % J_L; \
            if (r_ < J_IN) { W_ = w_in + (size_t)l_ * DM * DIN; K_ = DM; N_ = DIN; WT_ = WIN + (size_t)l_ * DIN * DM; } \
            else if ((r_ -= J_IN) < J_OUT) { W_ = w_out + (size_t)l_ * DM * DM; K_ = DM; N_ = DM; WT_ = WOUT + (size_t)l_ * DM * DM; } \
            else if ((r_ -= J_OUT) < J_UP) { W_ = w_up + (size_t)l_ * DM * DFF; K_ = DM; N_ = DFF; WT_ = WUP + (size_t)l_ * DFF * DM; } \
            else { r_ -= J_UP; W_ = w_down + (size_t)l_ * DFF * DM; K_ = DFF; N_ = DM; WT_ = WDN + (size_t)l_ * DM * DFF; } \
            it_ = r_; } while (0)
        const float* Wc = nullptr; int Kc = 0, Nc = 0; bf16* WTc = nullptr; int rc = it;
        if (it >= 0) { P0_DECODE(rc, Wc, Kc, Nc, WTc); p0_tile_load(Wc, Nc, rc, tid, pre); }
        while (it >= 0) {
            const int itn = item_of(q + 1);
            f32x4 cur[P0_NI];
#pragma unroll
            for (int i = 0; i < P0_NI; ++i) cur[i] = pre[i];
            const float* Wn = nullptr; int Kn = 0, Nn = 0; bf16* WTn = nullptr; int rn = itn;
            if (itn >= 0) { P0_DECODE(rn, Wn, Kn, Nn, WTn); if (!(P0_PROBE == 2 && itn >= NL * J_L)) p0_tile_load(Wn, Nn, rn, tid, pre); }
            p0_tile_store(cur, Kc, Nc, WTc, lds, rc, tid, !(P0_PROBE == 1 && it >= NL * J_L));
            Wc = Wn; Kc = Kn; Nc = Nn; WTc = WTn; rc = rn; it = itn; ++q;
        }
#endif
#undef P0_DECODE
        }
    }
    SEAM(0);
    if (IN(1)) {
        KArgs KA = kargs(); unsigned char* ws = KA->ws; TIDS(); GWS();
        const float* x_p = KA->in[0]; const float* x_s = KA->in[1]; const float* g_pre_mix = KA->in[12];
        const float* MOD = (const float*)(ws + WS_MOD); bf16* Hb = (bf16*)(ws + WS_H); bf16* MIXb = (bf16*)(ws + WS_MIX);
        for (int row = MR + gw; row < MT; row += NGW) {
            u32x2* o = (u32x2*)(Hb + (size_t)row * DM) + lane; u32x2* o2 = (u32x2*)(MIXb + (size_t)row * DM) + lane;
#pragma unroll
            for (int j = 0; j < 8; ++j) { o[64 * j] = (u32x2){0u, 0u}; o2[64 * j] = (u32x2){0u, 0u}; }
        }
        for (int r4 = gw; r4 < MP / 4; r4 += NGW) {
            const float* md = MOD + ((size_t)0 * 12 + mod_row_of(4 * r4)) * NMOD;
            f32x4 ev[8], fv[8]; ROW_LD(ev, md + DM); ROW_LD(fv, md);
#pragma unroll 1
            for (int ri = 0; ri < 4; ++ri) {
                const int row = 4 * r4 + ri;
                f32x4 v[8]; ROW_LD(v, x_p + (size_t)row * DM);
                const float rstd = 1.0f / sqrtf(row_sumsq(v) * (1.0f / DM) + RMS_EPS);
                norm_store(v, rstd, ev, fv, Hb + (size_t)row * DM, lane);
            }
        }
        for (int sr = bid; sr < MS; sr += G) {
            __syncthreads();
            const int row = MP + sr; const float* md = MOD + ((size_t)0 * 12 + mod_row_of(row)) * NMOD;
            coop_row(nullptr, x_s + (size_t)sr * DM, nullptr, nullptr, md + DM, md, nullptr, nullptr, Hb + (size_t)row * DM, (LAS float*)lds, tid);
        }
    }
    SEAM(1);

    for (int l = 0; l < NL; ++l) {
        const int pb = 2 + 7 * l;
        if (IN(pb + 0)) {
            { KArgs KA = kargs(); unsigned char* ws = KA->ws;
              pg8::Gemm g{(const bf16*)(ws + WS_H), (const bf16*)(ws + WS_WIN) + (size_t)l * DIN * DM, MP, 4096, DM}; pg8::StaticOrder S; { int G_ = gridDim.x, bid_ = blockIdx.x; asm volatile("" : "+s"(G_), "+s"(bid_)); S.init(MP, 4096, G_, bid_, REP_A); }
              pg8::EpiInProj E{(bf16*)(ws + WS_Z), KA->out, l};
              pg8::gemm_phase<pg8::EpiInProj, pg8::StaticOrder, true, true>(lds, g, S, E, wave0 * 64 + hw_lane()); }
            { KArgs KA = kargs(); unsigned char* ws = KA->ws; TIDS(); GWS();
              SkEpiT16 SE{(bf16*)(ws + WS_Z), KA->out, l};
              mini_gemm<64, 128, 1, 4, 2, 2, SkEpiT16>(lds, (const bf16*)(ws + WS_H), DM, MP, (const bf16*)(ws + WS_WIN) + (size_t)l * DIN * DM + (size_t)4096 * DM, 256, DM, tid, bid, G, SE); }
            { KArgs KA = kargs(); unsigned char* ws = KA->ws; TIDS(); GWS();
              SkEpiInProj SE{(bf16*)(ws + WS_Z) + (size_t)MP * DIN, KA->out, l};
              mini_gemm<32, 128, 1, 4, 2, 2, SkEpiInProj>(lds, (const bf16*)(ws + WS_H) + (size_t)MP * DM, DM, MS, (const bf16*)(ws + WS_WIN) + (size_t)l * DIN * DM, DIN, DM, tid, bid, G, SE); }
        }
        SEAM(pb + 0);
        if (IN(pb + 1)) {
            {
            KArgs KA = kargs(); unsigned char* ws = KA->ws; TIDS(); GWS();
            const bf16* Zb = (const bf16*)(ws + WS_Z); bf16* MIXb = (bf16*)(ws + WS_MIX); float* out = KA->out;
            for (int un0 = bid; un0 < 256 * REP_B1; un0 += G) { const int un = un0 & 255;
                __syncthreads();
                const int unl = (G == 256) ? (((un >> 5) * 8 + (un & 7)) * 4 + ((un >> 3) & 3)) : un;
                const int b = unl >> 6, n = (unl >> 2) & 15, dq = unl & 3;
                LruUnit U; U.zseq = Zb + (size_t)(b * TP) * DIN; U.prefix = nullptr;
                LAS unsigned char* bl = lds + LX_BL_OFF; LAS float* bsum = (LAS float*)(lds + LX_BS_OFF);
                lru_setup_lds(U, bl, bsum, wave, l, n, dq, KA->in[15], KA->in[16], KA->in[17], KA->in[19], KA->in[21]);
                const int ch = lane & 15, tq = lane >> 4;
                LAS unsigned char* slab = lds;
                LAS float* ex = (LAS float*)(lds + LX_EX_OFF);
                const bf16* zcol = U.zseq + C_XB + 64 * n;
                v4u st[8];
                const int r0 = tid >> 3, c8 = tid & 7;
                const bf16* zsrc = zcol + (size_t)r0 * DIN + 8 * c8;
                LAS unsigned char* sdst = slab + (r0 + 3) * LX_PITCH + (c8 ^ (((r0 + 3) >> 4) & 3)) * 16;
                const bf16* gsrc = Zb + (size_t)(b * TP + (tid >> 1)) * DIN + C_GB + U.chn - (lane & 15) + 8 * (tid & 1);
                LAS unsigned char* gdst = lds + LX_GS_OFF + (tid >> 1) * 32 + (tid & 1) * 16;
                v4u gst[2];
#pragma unroll
                for (int i = 0; i < 8; ++i) st[i] = *(const v4u*)(zsrc + (size_t)(64 * i) * DIN);
                gst[0] = *(const v4u*)gsrc; gst[1] = *(const v4u*)(gsrc + (size_t)256 * DIN);
#pragma unroll
                for (int i = 0; i < 8; ++i) *(LAS v4u*)(sdst + i * 64 * LX_PITCH) = st[i];
                *(LAS v4u*)gdst = gst[0]; *(LAS v4u*)(gdst + 256 * 32) = gst[1];
                if (tid < 24) { unsigned z_; asm volatile("v_mov_b32 %0, 0" : "=v"(z_)); *(LAS v4u*)(slab + (tid >> 3) * LX_PITCH + c8 * 16) = (v4u){z_, z_, z_, z_}; }
                __syncthreads();
                U.rb = KA->in[18][(size_t)(l * 16 + n) * 64 + 16 * dq + ch] + bsum[0 * 16 + ch] + bsum[2 * 16 + ch];
                U.ib = KA->in[20][(size_t)(l * 16 + n) * 64 + 16 * dq + ch] + bsum[1 * 16 + ch] + bsum[3 * 16 + ch];
                float hstart = 0.f;
#pragma unroll 1
                for (int R = 0; R < 4; ++R) {
                    v4u hist;
                    if (R + 1 < 4) {
#pragma unroll
                        for (int i = 0; i < 8; ++i) st[i] = *(const v4u*)(zsrc + (size_t)((R + 1) * 512 + 64 * i) * DIN);
                        gst[0] = *(const v4u*)(gsrc + (size_t)((R + 1) * 512) * DIN); gst[1] = *(const v4u*)(gsrc + (size_t)((R + 1) * 512 + 256) * DIN);
                        if (tid < 24) hist = *(const LAS v4u*)(slab + (512 + (tid >> 3)) * LX_PITCH + c8 * 16);
                    }
                    const int tw = R * 512 + wave * 64;
                    float Ac, Hc; float P[16], hl[16];
                    lru_round_lds(U, slab, bl, wave * 64, dq, Ac, Hc, P, hl);
                    if (tq == 0) { ex[(wave * 16 + ch) * 2] = Ac; ex[(wave * 16 + ch) * 2 + 1] = Hc; }
                    __syncthreads();
                    float hs = hstart, hin = 0.f;
#pragma unroll
                    for (int w2 = 0; w2 < 8; ++w2) { const float A2 = ex[(w2 * 16 + ch) * 2], H2 = ex[(w2 * 16 + ch) * 2 + 1]; if (w2 == wave) hin = hs; hs = A2 * hs + H2; }
                    hstart = hs;
                    if (R + 1 < 4) {
#pragma unroll
                        for (int i = 0; i < 8; ++i) *(LAS v4u*)(sdst + i * 64 * LX_PITCH) = st[i];
                        if (tid < 24) *(LAS v4u*)(slab + (tid >> 3) * LX_PITCH + c8 * 16) = hist;
                        *(LAS v4u*)(gdst + ((R + 1) & 1) * 16384) = gst[0]; *(LAS v4u*)(gdst + ((R + 1) & 1) * 16384 + 256 * 32) = gst[1];
                    }
                    float gbv[16];
                    { const LAS unsigned char* gp = lds + LX_GS_OFF + (R & 1) * 16384 + (wave * 64 + 16 * tq) * 32 + ch * 2;
#pragma unroll
                    for (int k = 0; k < 16; ++k) gbv[k] = bf2f(*(const LAS unsigned short*)(gp + k * 32)); }
#pragma unroll
                    for (int k = 0; k < 16; ++k) {
                        const int t = tw + 16 * tq + k; const size_t row = (size_t)(b * TP + t);
                        const float hv = hl[k] + P[k] * hin;
                        MIXb[row * DM + 512 + U.chn] = (bf16)f2bf(hv * gelu_tanh(gbv[k]));
                        if (t == TP - 1) out[O_LHP + (size_t)(l * BP + b) * 1024 + U.chn] = hv;
                    }
                    __syncthreads();
                }
            }
            }
            {
            KArgs KA = kargs(); unsigned char* ws = KA->ws; TIDS(); GWS();
            const bf16* Zb = (const bf16*)(ws + WS_Z); bf16* MIXb = (bf16*)(ws + WS_MIX); const float* rel_bias = KA->in[22];
            for (int un0 = bid; un0 < 256 * REP_B2; un0 += G) { const int un = un0 & 255;
                __syncthreads();
                const int unb = (G == 256) ? ((((un & 7) + 8 * (un >> 6)) * 8) + ((un >> 3) & 7)) : un;
                const int b = unb >> 6, hd = (unb >> 3) & 7, cg = unb & 7;
                LAS float* tbl = (LAS float*)(lds + 2 * AK_BYTES + 2 * AV_BYTES);
                for (int e = tid; e < 257; e += 512) tbl[e] = rel_bias[((size_t)l * 8 + hd) * 257 + e] * LOG2E;
                const int first = (4 * cg - 8) > 0 ? (4 * cg - 8) : 0, ntiles = 2 * (4 * cg + 3 - first + 1);
                const int cq = 4 * cg + (wave >> 1), r = lane & 31;
                const size_t qrowi = (size_t)(b * TP + cq * 64 + 32 * (wave & 1) + r);
                AttnWave W; W.active = true; W.wr = true; W.qrow = Zb + qrowi * DIN + C_QC + hd * 64; W.orow = MIXb + qrowi * DM + 1536 + hd * 64;
                W.qpos = cq * 64 + 32 * (wave & 1) + r; W.m0 = -1e30f; W.l0 = 0.f;
                SrcZ src{Zb + (size_t)(b * TP) * DIN, 64 * first, C_KC + hd * 64, C_VC + hd * 64};
                const int klo = (cq - 8) > first ? (cq - 8) : first;
                RelBandP rel{2 * (klo - first), 2 * (cq - first) + 1};
                attn_run<true, true, false, SrcZ, RelBandP, (ATT_ROT != 0)>(lds, lds + 2 * AK_BYTES, tbl, tid, 0, 1, ntiles, 64 * first, -1, src, rel, W, nullptr);
            }
            }
            {
            KArgs KA = kargs(); unsigned char* ws = KA->ws; TIDS(); GWS();
            const bf16* Zb = (const bf16*)(ws + WS_Z); bf16* MIXb = (bf16*)(ws + WS_MIX); const float* swa_sink = KA->in[14];
            for (int un0 = bid; un0 < 256 * REP_B3; un0 += G) { const int un = un0 & 255;
                __syncthreads();
                const int b = un >> 6, c = (un >> 1) & 31, kvh = un & 1;
                const int first = (c - 2) > 0 ? (c - 2) : 0; int ntiles = 2 * (c - first + 1);
#ifdef B3_PROBE_TILES
                if (un0 + G < 256 * REP_B3) ntiles = ntiles < B3_PROBE_TILES ? ntiles : B3_PROBE_TILES;
#endif
                const int gq = wave >> 1, r = lane & 31;
                const size_t qrowi = (size_t)(b * TP + c * 64 + 32 * (wave & 1) + r);
                AttnWave W; W.active = true; W.wr = true; W.qrow = Zb + qrowi * DIN + C_QA + kvh * 256 + gq * 64; W.orow = MIXb + qrowi * DM + kvh * 256 + gq * 64;
                W.qpos = 0; W.m0 = swa_sink[l * 8 + kvh * 4 + gq] * LOG2E; W.l0 = (lane < 32) ? 1.0f : 0.f;
                SrcZ src{Zb + (size_t)(b * TP) * DIN, 64 * first, C_KA + kvh * 64, C_VA + kvh * 64};
#if SWA_ALL
                attn_run_all<6, SrcZ>(lds, lds + 6 * AK_BYTES, tid, ntiles, src, W);
#else
                attn_run<true, false, false, SrcZ, RelAll>(lds, lds + 2 * AK_BYTES, nullptr, tid, 0, 1, ntiles, 0, -1, src, RelAll{}, W, nullptr);
#endif
            }
            }
            {
            KArgs KA = kargs(); unsigned char* ws = KA->ws; TIDS(); GWS();
            const bf16* Zb = (const bf16*)(ws + WS_Z); bf16* MIXb = (bf16*)(ws + WS_MIX); float* out = KA->out;
            for (int un = bid; un < 256; un += G) {
                if (wave < 2) {
                    const int uidx = un * 2 + wave, bs = uidx >> 6, n = (uidx >> 2) & 15, dq = uidx & 3;
                    LruUnit U; U.zseq = Zb + (size_t)(MP + bs * TS) * DIN; U.prefix = KA->in[9] + ((size_t)(l * BS + bs) * 3) * 1024;
                    lru_setup(U, l, n, dq, KA->in[15], KA->in[16], KA->in[17], KA->in[18], KA->in[19], KA->in[20], KA->in[21]);
                    float Ac = 1.0f, Hc = 0.f, P[4], hl[4];
                    lru_tile(U, 0, Ac, Hc, P, hl);
                    const float hin = KA->in[8][(size_t)(l * BS + bs) * 1024 + U.chn];
                    const int tq = lane >> 4;
#pragma unroll
                    for (int j = 0; j < 4; ++j) {
                        const int t = 4 * tq + j; const size_t row = (size_t)(MP + bs * TS + t);
                        const float hv = hl[j] + P[j] * hin;
                        const float gb = bf2f(Zb[row * DIN + C_GB + U.chn]);
                        MIXb[row * DM + 512 + U.chn] = (bf16)f2bf(hv * gelu_tanh(gb));
                        if (t == TS - 1) out[O_LHS + (size_t)(l * BS + bs) * 1024 + U.chn] = hv;
                    }
                }
            }
            }
            {
            KArgs KA = kargs(); unsigned char* ws = KA->ws; TIDS(); GWS();
            const bf16* Zb = (const bf16*)(ws + WS_Z); bf16* MIXb = (bf16*)(ws + WS_MIX); const float* swa_sink = KA->in[14];
            for (int un = (G == 256) ? ((((bid >> 3) & 7) == 0) ? ((bid & 7) + 8 * (bid >> 6)) : 16) : bid; un < 16; un += G) {
                __syncthreads();
                const int bs = un >> 1, kvh = un & 1, r = lane & 31;
                const int gq = 2 * (wave & 1) + (r >> 4), t = r & 15;
                const size_t qrowi = (size_t)(MP + bs * TS + t);
                AttnWave W; W.active = wave < 2; W.wr = true; W.qrow = Zb + qrowi * DIN + C_QA + kvh * 256 + gq * 64; W.orow = MIXb + qrowi * DM + kvh * 256 + gq * 64;
                W.qpos = 0; W.m0 = swa_sink[l * 8 + kvh * 4 + gq] * LOG2E; W.l0 = (lane < 32) ? 1.0f : 0.f;
                SrcCache src{KA->in[4] + ((size_t)(l * BS + bs) * 128 * 2 + kvh) * 64, KA->in[5] + ((size_t)(l * BS + bs) * 128 * 2 + kvh) * 64, 2 * 64, 4,
                             Zb + (size_t)(MP + bs * TS) * DIN, C_KA + kvh * 64, C_VA + kvh * 64};
                attn_run<true, false, false, SrcCache, RelAll>(lds, lds + 2 * AK_BYTES, nullptr, tid, 0, 1, 5, 0, 4, src, RelAll{}, W, nullptr);
            }
            }
            {
            KArgs KA = kargs(); unsigned char* ws = KA->ws; TIDS(); GWS();
            const bf16* Zb = (const bf16*)(ws + WS_Z); bf16* MIXb = (bf16*)(ws + WS_MIX); const float* rel_bias = KA->in[22];
            constexpr int WREG = AK_BYTES + AV_BYTES + ATBL_BYTES;
            for (int un = (G == 256) ? ((((bid >> 3) & 7) < 2) ? ((bid & 7) + 8 * (bid >> 6)) * 2 + ((bid >> 3) & 7) : 64) : bid; un < 64; un += G) {
                __syncthreads();
                const int bs = un >> 3, hd = un & 7, r = lane & 31, t = r & 15;
                LAS float* tbl = (LAS float*)(lds + 8 * WREG);
                for (int e = tid; e < 257; e += 512) tbl[e] = rel_bias[((size_t)l * 8 + hd) * 257 + e] * LOG2E;
                __syncthreads();
                LAS unsigned char* wb = lds + wave * WREG;
                const size_t qrowi = (size_t)(MP + bs * TS + t);
                AttnWave W; W.active = true; W.wr = false; W.qrow = Zb + qrowi * DIN + C_QC + hd * 64; W.orow = nullptr;
                W.qpos = t; W.m0 = -1e30f; W.l0 = 0.f;
                SrcCache src{KA->in[6] + ((size_t)(l * BS + bs) * 512 * 8 + hd) * 64, KA->in[7] + ((size_t)(l * BS + bs) * 512 * 8 + hd) * 64, 8 * 64, 16,
                             Zb + (size_t)(MP + bs * TS) * DIN, C_KC + hd * 64, C_VC + hd * 64};
                attn_run<false, true, true, SrcCache, RelAll>(wb, wb + AK_BYTES, tbl, lane, wave, 8, wave == 0 ? 3 : 2, -512, 16, src, RelAll{}, W, (LAS float*)wb);
                __syncthreads();
                { const int q = tid & 15, d = tid >> 4;
                  float mw[8], M = -3e38f;
#pragma unroll
                  for (int w = 0; w < 8; ++w) { mw[w] = ((const LAS float*)(lds + w * WREG))[q]; M = fmaxf(M, mw[w]); }
                  float L = 0.f, a0 = 0.f, a1 = 0.f;
#pragma unroll
                  for (int w = 0; w < 8; ++w) { const LAS float* pw = (const LAS float*)(lds + w * WREG); const float f = fexp2(mw[w] - M); L += pw[32 + q] * f; a0 += pw[64 + d * 32 + q] * f; a1 += pw[64 + (d + 32) * 32 + q] * f; }
                  const float inv = 1.0f / L; bf16* orow = MIXb + (size_t)(MP + bs * TS + q) * DM + 1536 + hd * 64;
                  orow[d] = (bf16)f2bf(a0 * inv); orow[d + 32] = (bf16)f2bf(a1 * inv); }
            }
            }
            __syncthreads();
        }
        SEAM(pb + 1);
        if (IN(pb + 2)) {
            { KArgs KA = kargs(); unsigned char* ws = KA->ws; TIDS(); GWS();
              SkEpiBf16 SE{(bf16*)(ws + WS_T) + (size_t)MP * DM, DM};
              mini_gemm<32, 32, 1, 1, 8, 4, SkEpiBf16>(lds, (const bf16*)(ws + WS_MIX) + (size_t)MP * DM, DM, MS, (const bf16*)(ws + WS_WOUT) + (size_t)l * DM * DM, DM, DM, tid, bid, G, SE); }
            KArgs KA = kargs(); unsigned char* ws = KA->ws;
            pg8::Gemm g{(const bf16*)(ws + WS_MIX), (const bf16*)(ws + WS_WOUT) + (size_t)l * DM * DM, MP, DM, DM}; pg8::StaticOrder S; int G_ = gridDim.x, bid_ = blockIdx.x; asm volatile("" : "+s"(G_), "+s"(bid_)); S.init(MP, DM, G_, bid_, REP_C);
            if (FUSE_THIN && G_ == 256) {
                const float* md = (const float*)(ws + WS_MOD) + (size_t)l * 12 * NMOD;
                pg8::PanelRms st{(unsigned long long*)(ws + WS_XCH + (size_t)(2 * l) * MiB), (unsigned*)(ws + WS_CTL) + CW_SEAM + (2 * l) * 32 * 64, (unsigned*)(ws + WS_CTL), 0x700u};
                pg8::EpiFuse E{(l == 0) ? KA->in[0] : (const float*)KA->out, KA->out, (bf16*)(ws + WS_H), md + 2 * DM, md + 4 * DM, md + 3 * DM, NMOD, st};
                pg8::gemm_phase<pg8::EpiFuse, pg8::StaticOrder, false, true>(lds, g, S, E, wave0 * 64 + hw_lane());
            } else {
                pg8::EpiBf16 E{(bf16*)(ws + WS_T), DM};
                pg8::gemm_phase<pg8::EpiBf16, pg8::StaticOrder, true, true>(lds, g, S, E, wave0 * 64 + hw_lane());
            }
        }
        SEAM(pb + 2);
        if (IN(pb + 3)) {
            KArgs KA = kargs(); unsigned char* ws = KA->ws; TIDS(); GWS();
            const float* x_p = KA->in[0]; const float* x_s = KA->in[1]; const float* g_post_mix = KA->in[24]; const float* g_pre_mlp = KA->in[25]; float* out = KA->out;
            const float* MOD = (const float*)(ws + WS_MOD); bf16* Hb = (bf16*)(ws + WS_H); const bf16* Tb = (const bf16*)(ws + WS_T); bf16* XR = (bf16*)(ws + WS_XR);
            const bool fusedp = FUSE_THIN && G == 256;
#if COOP_SPLIT
            const bool has_s = bid < MS;
            if (has_s) { const int row = MP + bid; const float* md = MOD + ((size_t)l * 12 + mod_row_of(row)) * NMOD;
                coop_dma(lds, Tb + (size_t)row * DM, (l == 0) ? x_s + (size_t)bid * DM : (const float*)nullptr, (l == 0) ? (const bf16*)nullptr : XR + (size_t)row * DM, md + 2 * DM, md + 4 * DM, md + 3 * DM, wave, lane); }
#endif
            for (int r4 = fusedp ? MP : gw; r4 < MP / 4; r4 += NGW) {
                const float* md = MOD + ((size_t)l * 12 + mod_row_of(4 * r4)) * NMOD;
                f32x4 cv[8], ev[8], fv[8];
                ROW_LD(cv, md + 2 * DM); ROW_LD(ev, md + 4 * DM); ROW_LD(fv, md + 3 * DM);
#pragma unroll 1
                for (int ri = 0; ri < 4; ++ri) {
                    const int row = 4 * r4 + ri;
                    f32x4 tv[8], xv[8];
                    ROW_LD_BF16(tv, Tb + (size_t)row * DM);
                    if (l == 0) { ROW_LD(xv, x_p + (size_t)row * DM); } else { ROW_LD_BF16(xv, XR + (size_t)row * DM); }
                    const float rt_ = 1.0f / sqrtf(row_sumsq(tv) * (1.0f / DM) + RMS_EPS);
#pragma unroll
                    for (int j = 0; j < 8; ++j) xv[j] = xv[j] + (tv[j] * rt_) * cv[j];
                    ROW_ST_BF16(XR + (size_t)row * DM, xv);
                    const float rx = 1.0f / sqrtf(row_sumsq(xv) * (1.0f / DM) + RMS_EPS);
                    norm_store(xv, rx, ev, fv, Hb + (size_t)row * DM, lane);
                }
            }
#if COOP_SPLIT
            if (has_s) { const int row = MP + bid; asm volatile("s_waitcnt vmcnt(0)" ::: "memory"); __syncthreads(); const unsigned char* Lg = lds_raw + CD_BASE;
                coop_row((const bf16*)(Lg + CD_T), (const float*)(Lg + CD_X), (l == 0) ? (const bf16*)nullptr : (const bf16*)(Lg + CD_X), (const float*)(Lg + CD_C), (const float*)(Lg + CD_E), (const float*)(Lg + CD_F), nullptr, XR + (size_t)row * DM, Hb + (size_t)row * DM, (LAS float*)lds, tid); }
            for (int sr = bid + G; sr < MS; sr += G) {
#else
            for (int sr = bid; sr < MS; sr += G) {
#endif
                __syncthreads();
                const int row = MP + sr; const float* md = MOD + ((size_t)l * 12 + mod_row_of(row)) * NMOD;
                coop_row(Tb + (size_t)row * DM, x_s + (size_t)sr * DM, (l == 0) ? (const bf16*)nullptr : XR + (size_t)row * DM, md + 2 * DM, md + 4 * DM, md + 3 * DM, nullptr, XR + (size_t)row * DM, Hb + (size_t)row * DM, (LAS float*)lds, tid);
            }
        }
        SEAM(pb + 3);
        if (IN(pb + 4)) {
            { KArgs KA = kargs(); unsigned char* ws = KA->ws; TIDS(); GWS();
              SkEpiRelu2 SE{(bf16*)(ws + WS_F1) + (size_t)MP * DFF, DFF};
              mini_gemm<64, 64, 1, 2, 4, 2, SkEpiRelu2>(lds, (const bf16*)(ws + WS_H) + (size_t)MP * DM, DM, MS, (const bf16*)(ws + WS_WUP) + (size_t)l * DFF * DM, DFF, DM, tid, bid, G, SE); }
            KArgs KA = kargs(); unsigned char* ws = KA->ws;
            pg8::Gemm g{(const bf16*)(ws + WS_H), (const bf16*)(ws + WS_WUP) + (size_t)l * DFF * DM, MP, DFF, DM}; pg8::StaticOrder S; { int G_ = gridDim.x, bid_ = blockIdx.x; asm volatile("" : "+s"(G_), "+s"(bid_)); S.init(MP, DFF, G_, bid_, REP_E); }
            pg8::EpiRelu2 E{(bf16*)(ws + WS_F1), DFF};
            pg8::gemm_phase<pg8::EpiRelu2, pg8::StaticOrder, true, true>(lds, g, S, E, wave0 * 64 + hw_lane());
        }
        SEAM(pb + 4);
        if (IN(pb + 5)) {
            { KArgs KA = kargs(); unsigned char* ws = KA->ws; TIDS(); GWS();
              SkEpiBf16 SE{(bf16*)(ws + WS_T) + (size_t)MP * DM, DM};
              mini_gemm<32, 32, 1, 1, 8, 4, SkEpiBf16>(lds, (const bf16*)(ws + WS_F1) + (size_t)MP * DFF, DFF, MS, (const bf16*)(ws + WS_WDN) + (size_t)l * DM * DFF, DM, DFF, tid, bid, G, SE); }
            KArgs KA = kargs(); unsigned char* ws = KA->ws;
            pg8::Gemm g{(const bf16*)(ws + WS_F1), (const bf16*)(ws + WS_WDN) + (size_t)l * DM * DFF, MP, DM, DFF}; pg8::StaticOrder S; int G_ = gridDim.x, bid_ = blockIdx.x; asm volatile("" : "+s"(G_), "+s"(bid_)); S.init(MP, DM, G_, bid_, REP_F);
            if (FUSE_THIN && G_ == 256) {
                const float* md = (const float*)(ws + WS_MOD) + (size_t)l * 12 * NMOD; const float* md2 = (const float*)(ws + WS_MOD) + (size_t)(l + 1 < NL ? l + 1 : l) * 12 * NMOD;
                pg8::PanelRms st{(unsigned long long*)(ws + WS_XCH + (size_t)(2 * l + 1) * MiB), (unsigned*)(ws + WS_CTL) + CW_SEAM + (2 * l + 1) * 32 * 64, (unsigned*)(ws + WS_CTL), 0x780u};
                pg8::EpiFuse E{(const float*)KA->out, KA->out, (l + 1 < NL) ? (bf16*)(ws + WS_H) : (bf16*)nullptr, md + 5 * DM, md2 + DM, md2, NMOD, st};
                pg8::gemm_phase<pg8::EpiFuse, pg8::StaticOrder, false, true>(lds, g, S, E, wave0 * 64 + hw_lane());
            } else {
                pg8::EpiBf16 E{(bf16*)(ws + WS_T), DM};
                pg8::gemm_phase<pg8::EpiBf16, pg8::StaticOrder, true, true>(lds, g, S, E, wave0 * 64 + hw_lane());
            }
        }
        SEAM(pb + 5);
        if (IN(pb + 6)) {
            KArgs KA = kargs(); unsigned char* ws = KA->ws; TIDS(); GWS();
            const float* g_post_mlp = KA->in[28]; const float* g_pre_mix = KA->in[12]; float* out = KA->out;
            const float* MOD = (const float*)(ws + WS_MOD); bf16* Hb = (bf16*)(ws + WS_H); const bf16* Tb = (const bf16*)(ws + WS_T); bf16* XR = (bf16*)(ws + WS_XR);
            const bool fusedp = FUSE_THIN && G == 256;
#if COOP_SPLIT
            const bool has_s = bid < MS;
            if (has_s) { const int row = MP + bid; const float* md = MOD + ((size_t)l * 12 + mod_row_of(row)) * NMOD; const float* md2 = MOD + ((size_t)(l + 1 < NL ? l + 1 : l) * 12 + mod_row_of(row)) * NMOD;
                coop_dma(lds, Tb + (size_t)row * DM, nullptr, XR + (size_t)row * DM, md + 5 * DM, md2 + DM, md2, wave, lane); }
#endif
            for (int r4 = fusedp ? MP : gw; r4 < MP / 4; r4 += NGW) {
                const float* md = MOD + ((size_t)l * 12 + mod_row_of(4 * r4)) * NMOD;
                const float* md2 = MOD + ((size_t)(l + 1 < NL ? l + 1 : l) * 12 + mod_row_of(4 * r4)) * NMOD;
                f32x4 cv[8], ev[8], fv[8];
                ROW_LD(cv, md + 5 * DM); ROW_LD(ev, md2 + DM); ROW_LD(fv, md2);
#pragma unroll 1
                for (int ri = 0; ri < 4; ++ri) {
                    const int row = 4 * r4 + ri;
                    f32x4 tv[8], xv[8];
                    ROW_LD_BF16(tv, Tb + (size_t)row * DM); ROW_LD_BF16(xv, XR + (size_t)row * DM);
                    const float rt_ = 1.0f / sqrtf(row_sumsq(tv) * (1.0f / DM) + RMS_EPS);
#pragma unroll
                    for (int j = 0; j < 8; ++j) xv[j] = xv[j] + (tv[j] * rt_) * cv[j];
                    if (l + 1 < NL) {
                        ROW_ST_BF16(XR + (size_t)row * DM, xv);
                        const float rx = 1.0f / sqrtf(row_sumsq(xv) * (1.0f / DM) + RMS_EPS);
                        norm_store(xv, rx, ev, fv, Hb + (size_t)row * DM, lane);
                    } else {
                        f32x4* o4 = (f32x4*)(out + (size_t)row * DM) + 2 * lane;
#pragma unroll
                        for (int g = 0; g < 4; ++g) { o4[128 * g] = xv[2 * g]; o4[128 * g + 1] = xv[2 * g + 1]; }
                    }
                }
            }
#if COOP_SPLIT
            if (has_s) { const int row = MP + bid; asm volatile("s_waitcnt vmcnt(0)" ::: "memory"); __syncthreads(); const unsigned char* Lg = lds_raw + CD_BASE;
                coop_row((const bf16*)(Lg + CD_T), nullptr, (const bf16*)(Lg + CD_X), (const float*)(Lg + CD_C), (const float*)(Lg + CD_E), (const float*)(Lg + CD_F), out + (size_t)row * DM, (l + 1 < NL) ? XR + (size_t)row * DM : (bf16*)nullptr, (l + 1 < NL) ? Hb + (size_t)row * DM : (bf16*)nullptr, (LAS float*)lds, tid); }
            for (int sr = bid + G; sr < MS; sr += G) {
#else
            for (int sr = bid; sr < MS; sr += G) {
#endif
                __syncthreads();
                const int row = MP + sr; const float* md = MOD + ((size_t)l * 12 + mod_row_of(row)) * NMOD;
                const float* md2 = MOD + ((size_t)(l + 1 < NL ? l + 1 : l) * 12 + mod_row_of(row)) * NMOD;
                coop_row(Tb + (size_t)row * DM, nullptr, XR + (size_t)row * DM, md + 5 * DM, md2 + DM, md2, out + (size_t)row * DM, (l + 1 < NL) ? XR + (size_t)row * DM : (bf16*)nullptr, (l + 1 < NL) ? Hb + (size_t)row * DM : (bf16*)nullptr, (LAS float*)lds, tid);
            }
        }
        SEAM(pb + 6);
    }
#undef IN
#undef SEAM
}

#ifndef MK_SINGLE
#define MK_SINGLE 0
#endif
extern "C" void kernel_launch(void* const* d_in, const int* in_sizes, int n_in, void* d_out, int out_size, void* d_ws, size_t ws_size, hipStream_t stream) {
    static int grid = 0;
    if (grid == 0) {
        if (n_in != 29 || in_sizes[0] != MP * DM || (size_t)out_size != O_END || ws_size < WS_END) {
            fprintf(stderr, "kernel_launch: unexpected shapes: n_in %d in0 %d out %d (want %zu) ws %zu (want %zu); nothing launched\n", n_in, n_in > 0 ? in_sizes[0] : -1, out_size, (size_t)O_END, ws_size, (size_t)WS_END);
            grid = -1; return; }
        int dev = 0, cus = 0, per_cu = 0;
        if (hipGetDevice(&dev) != hipSuccess || hipDeviceGetAttribute(&cus, hipDeviceAttributeMultiprocessorCount, dev) != hipSuccess) { fprintf(stderr, "kernel_launch: device query failed\n"); grid = -1; return; }
        if (hipFuncSetAttribute((const void*)mk_fwd, hipFuncAttributeMaxDynamicSharedMemorySize, LDS_BYTES) != hipSuccess) { fprintf(stderr, "kernel_launch: hipFuncSetAttribute failed\n"); grid = -1; return; }
        if (hipOccupancyMaxActiveBlocksPerMultiprocessor(&per_cu, (const void*)mk_fwd, NWAVES * 64, LDS_BYTES) != hipSuccess || per_cu < 1)
            fprintf(stderr, "kernel_launch: note: occupancy query reports %d workgroups per CU\n", per_cu);
        (void)hipGetLastError();
        grid = cus;
    }
    if (grid < 0) return;
    if (hipMemsetAsync((char*)d_ws + WS_CTL, 0, CTL_ZERO_BYTES, stream) != hipSuccess) { fprintf(stderr, "kernel_launch: memset failed\n"); return; }
    Args a{};
    for (int i = 0; i < 29; ++i) a.in[i] = (const float*)d_in[i];
    a.out = (float*)d_out; a.ws = (unsigned char*)d_ws;
#if MK_SINGLE
    a.ph_lo = 0; a.ph_hi = N_PHASES;
    hipLaunchKernelGGL(mk_fwd, dim3(grid), dim3(NWAVES * 64), LDS_BYTES, stream, a);
#else
    for (int p = 0; p < N_PHASES; ++p) {
        a.ph_lo = p; a.ph_hi = p + 1;
        hipLaunchKernelGGL(mk_fwd, dim3(grid), dim3(NWAVES * 64), LDS_BYTES, stream, a);
    }
#endif
    const hipError_t le = hipPeekAtLastError();
    if (le != hipSuccess) fprintf(stderr, "kernel_launch: launch failed: %s\n", hipGetErrorName(le));
}
```

```cpp
#include <hip/hip_runtime.h>
#include <cstdio>
#include <cstdint>
#include <cmath>
#define MK_SINGLE 1
#define ATT_ROT 1
namespace pg8 {
#define PG8_LAS __attribute__((address_space(3)))
typedef unsigned short bf16_t;
typedef short bf16x8 __attribute__((ext_vector_type(8)));
typedef float f32x4 __attribute__((ext_vector_type(4)));
typedef unsigned u32x4 __attribute__((ext_vector_type(4)));
constexpr int BM = 256, BK = 64, HALF = 128, HTB = HALF * BK * 2  , STAGE_BYTES = 8 * HTB, NXCD = 8, WGM = 8;

__host__ __device__ __forceinline__ int lds_byte(int r, int c) { const int st = (r >> 4) * 2 + (c >> 5), rr = r & 15, cc = c & 31, ob = rr * 64 + cc * 2; return st * 1024 + (ob ^ (((ob >> 9) & 1) << 5)); }
__host__ __device__ __forceinline__ void stage_rc(int b, int& R, int& C) { const int st = b / 1024, sb = b % 1024, swz = sb ^ (((sb >> 9) & 1) << 5); R = (st >> 1) * 16 + swz / 64; C = (st & 1) * 32 + (swz % 64) / 2; }
__host__ __device__ __forceinline__ int perm32(int rho) { const int n = rho >> 4, i = rho & 15; return 8 * (i >> 2) + 4 * n + (i & 3); }

struct Unit { int pm, pn; };
struct Gemm { const bf16_t* A; const bf16_t* Bt; int M, N, K; };

struct StaticOrder {
    int nM, nN, nwg, G, c, rep;
    __host__ __device__ void init(int M, int N, int G_, int c_, int rep_ = 1) { nM = M / BM; nN = N / BM; nwg = nM * nN; G = G_; c = c_; rep = rep_; }
    __host__ __device__ bool next(int i, Unit& u) const {
        long L = (long)i * G + c; if (L >= (long)nwg * rep) return false;
        L %= nwg;
        int wgid = (int)L; { const int q = nwg / NXCD, r = nwg % NXCD, xcd = wgid % NXCD, off = wgid / NXCD; wgid = (xcd < r ? xcd * (q + 1) : r * (q + 1) + (xcd - r) * q) + off; }
        const int nig = WGM * nN, gid = wgid / nig, fm = gid * WGM, gsz = (nM - fm) < WGM ? (nM - fm) : WGM;
        u.pm = fm + ((wgid % nig) % gsz); u.pn = (wgid % nig) / gsz; return true;
    }
    __device__ __forceinline__ void a_ready(const Unit&) const {}
    __device__ __forceinline__ void done(const Unit&) const {}
};

__device__ __forceinline__ unsigned cvt_pk_bf16(float lo, float hi) { unsigned r; asm volatile("v_cvt_pk_bf16_f32 %0, %1, %2" : "=v"(r) : "v"(lo), "v"(hi)); return r; }
typedef float f32x2 __attribute__((ext_vector_type(2)));

constexpr int X_DM = 2048, X_MP = 8192, X_MS = 128, X_DIN = 4352, X_DFF = 8192, X_NL = 4;
constexpr size_t O_YP = 0, O_YS = O_YP + (size_t)X_MP * X_DM, O_SKP = O_YS + (size_t)X_MS * X_DM, O_SVP = O_SKP + (size_t)X_NL * 4 * 128 * 128,
                 O_BKP = O_SVP + (size_t)X_NL * 4 * 128 * 128, O_BVP = O_BKP + (size_t)X_NL * 4 * 512 * 512, O_LHP = O_BVP + (size_t)X_NL * 4 * 512 * 512,
                 O_LCP = O_LHP + (size_t)X_NL * 4 * 1024, O_SKS = O_LCP + (size_t)X_NL * 4 * 3 * 1024, O_SVS = O_SKS + (size_t)X_NL * 8 * 16 * 128,
                 O_BKS = O_SVS + (size_t)X_NL * 8 * 16 * 128, O_BVS = O_BKS + (size_t)X_NL * 8 * 16 * 512, O_LHS = O_BVS + (size_t)X_NL * 8 * 16 * 512,
                 O_LCS = O_LHS + (size_t)X_NL * 8 * 1024, O_END = O_LCS + (size_t)X_NL * 8 * 3 * 1024;

#ifndef EPI_SC1
#define EPI_SC1 0
#endif
__device__ __forceinline__ void st16_wt(void* p, u32x4 w) {
#if EPI_SC1
    asm volatile("global_store_dwordx4 %0, %1, off sc1\n\ts_nop 1" :: "v"(p), "v"(w) : "memory");
#else
    *(u32x4*)p = w;
#endif
}
struct EpiF32 {
    static constexpr bool PERM = false, ADJ = false, AFTER_DRAIN = false;
    float* C; int ldc;
    __device__ __forceinline__ void operator()(const f32x4 (&acc)[2][2][4][2], const Unit& u, int wr, int wc, int fr, int fq) const {
        const int row0 = u.pm * BM + wr * 64 + fr, col0 = u.pn * BM + wc * 32 + 4 * fq;
#pragma unroll
        for (int ai = 0; ai < 2; ++ai)
#pragma unroll
            for (int m = 0; m < 4; ++m) { float* rowp = C + (size_t)(row0 + ai * HALF + m * 16) * ldc + col0;
#pragma unroll
                for (int bj = 0; bj < 2; ++bj)
#pragma unroll
                    for (int n = 0; n < 2; ++n) *(f32x4*)(rowp + bj * HALF + n * 16) = acc[ai][bj][m][n]; }
    }
};
#ifndef EPI_RELU_ASM
#define EPI_RELU_ASM 1
#endif
__device__ __forceinline__ f32x2 relu2_pk(float x, float y) {
    f32x2 m, r;
    asm("v_max_f32 %0, 0, %1" : "=v"(m.x) : "v"(x));
    asm("v_max_f32 %0, 0, %1" : "=v"(m.y) : "v"(y));
    asm("v_pk_mul_f32 %0, %1, %1" : "=v"(r) : "v"(m));
    return r;
}
struct EpiRelu2 {
    static constexpr bool PERM = true, ADJ = true, AFTER_DRAIN = false;
    bf16_t* O; int ldc;
    __device__ __forceinline__ void operator()(const f32x4 (&acc)[2][2][4][2], const Unit& u, int wr, int wc, int fr, int fq) const {
        const int row0 = u.pm * BM + wr * 64 + fr, col0 = u.pn * BM + wc * 64 + 8 * fq;
#pragma unroll
        for (int ai = 0; ai < 2; ++ai)
#pragma unroll
            for (int m = 0; m < 4; ++m) { bf16_t* rowp = O + (size_t)(row0 + ai * HALF + m * 16) * ldc + col0;
#pragma unroll
                for (int bj = 0; bj < 2; ++bj) { f32x4 v0 = acc[ai][bj][m][0], v1 = acc[ai][bj][m][1];
#if EPI_RELU_ASM
                    u32x4 w;
                    { const f32x2 a = relu2_pk(v0[0], v0[1]), b = relu2_pk(v0[2], v0[3]), c = relu2_pk(v1[0], v1[1]), d = relu2_pk(v1[2], v1[3]);
                      w.x = cvt_pk_bf16(a[0], a[1]); w.y = cvt_pk_bf16(b[0], b[1]); w.z = cvt_pk_bf16(c[0], c[1]); w.w = cvt_pk_bf16(d[0], d[1]); }
#else
#pragma unroll
                    for (int e = 0; e < 4; ++e) { v0[e] = v0[e] > 0.f ? v0[e] : 0.f; v1[e] = v1[e] > 0.f ? v1[e] : 0.f; }
                    v0 = v0 * v0; v1 = v1 * v1;
                    u32x4 w; w.x = cvt_pk_bf16(v0[0], v0[1]); w.y = cvt_pk_bf16(v0[2], v0[3]); w.z = cvt_pk_bf16(v1[0], v1[1]); w.w = cvt_pk_bf16(v1[2], v1[3]);
#endif
                    st16_wt(rowp + bj * 32, w); } }
    }
};
struct EpiBf16 {
    static constexpr bool PERM = true, ADJ = true, AFTER_DRAIN = false;
    bf16_t* O; int ldc;
    __device__ __forceinline__ void operator()(const f32x4 (&acc)[2][2][4][2], const Unit& u, int wr, int wc, int fr, int fq) const {
        const int row0 = u.pm * BM + wr * 64 + fr, col0 = u.pn * BM + wc * 64 + 8 * fq;
#pragma unroll
        for (int ai = 0; ai < 2; ++ai)
#pragma unroll
            for (int m = 0; m < 4; ++m) { bf16_t* rowp = O + (size_t)(row0 + ai * HALF + m * 16) * ldc + col0;
#pragma unroll
                for (int bj = 0; bj < 2; ++bj) { const f32x4 v0 = acc[ai][bj][m][0], v1 = acc[ai][bj][m][1];
                    u32x4 w; w.x = cvt_pk_bf16(v0[0], v0[1]); w.y = cvt_pk_bf16(v0[2], v0[3]); w.z = cvt_pk_bf16(v1[0], v1[1]); w.w = cvt_pk_bf16(v1[2], v1[3]);
                    st16_wt(rowp + bj * 32, w); } }
    }
};
struct EpiInProj {
    static constexpr bool PERM = true, ADJ = true, AFTER_DRAIN = false;
    bf16_t* Z; float* out; int layer;
    __device__ __forceinline__ void operator()(const f32x4 (&acc)[2][2][4][2], const Unit& u, int wr, int wc, int fr, int fq) const {
        const int row0 = u.pm * BM + wr * 64 + fr, col0 = u.pn * BM + wc * 64 + 8 * fq;
#pragma unroll
        for (int ai = 0; ai < 2; ++ai)
#pragma unroll
            for (int m = 0; m < 4; ++m) { bf16_t* rowp = Z + (size_t)(row0 + ai * HALF + m * 16) * X_DIN + col0;
#pragma unroll
                for (int bj = 0; bj < 2; ++bj) { const f32x4 v0 = acc[ai][bj][m][0], v1 = acc[ai][bj][m][1];
                    u32x4 w; w.x = cvt_pk_bf16(v0[0], v0[1]); w.y = cvt_pk_bf16(v0[2], v0[3]); w.z = cvt_pk_bf16(v1[0], v1[1]); w.w = cvt_pk_bf16(v1[2], v1[3]);
                    st16_wt(rowp + bj * 32, w); } }
        const int pn = u.pn, pm = u.pm;
        const bool rows_state = (pm == 32) || ((pm & 7) >= 6);
        const bool cols_state = (pn >= 2 && pn <= 6) || (pn >= 13);
        if (rows_state && cols_state) {
            const int L = layer;
#pragma unroll
            for (int ai = 0; ai < 2; ++ai)
#pragma unroll
                for (int m = 0; m < 4; ++m) {
                    const int row = row0 + ai * HALF + m * 16;
                    const bool samp = row >= X_MP;
                    int b, t;
                    if (!samp) { b = row >> 11; t = row & 2047; } else { const int rs = row - X_MP; b = rs >> 4; t = rs & 15; }
                    const bool rowok = row < X_MP + X_MS;
#pragma unroll
                    for (int bj = 0; bj < 2; ++bj) {
                        const int col = col0 + bj * 32;
                        float* dst = nullptr;
                        if (pn == 2) {
                            const bool isV = col >= 640; const int c = col - (isV ? 640 : 512);
                            if (!samp) { if (t >= 1920) dst = out + (isV ? O_SVP : O_SKP) + ((size_t)(L * 4 + b) * 128 + (t - 1920)) * 128 + c; }
                            else dst = out + (isV ? O_SVS : O_SKS) + ((size_t)(L * 8 + b) * 16 + t) * 128 + c;
                        } else if (pn <= 6) {
                            const int ch = col - 768;
                            if (!samp) { if (t >= 2045) dst = out + O_LCP + ((size_t)(L * 4 + b) * 3 + (t - 2045)) * 1024 + ch; }
                            else if (t >= 13) dst = out + O_LCS + ((size_t)(L * 8 + b) * 3 + (t - 13)) * 1024 + ch;
                        } else {
                            const bool isV = pn >= 15; const int c = col - (isV ? 3840 : 3328);
                            if (!samp) { if (t >= 1536) dst = out + (isV ? O_BVP : O_BKP) + ((size_t)(L * 4 + b) * 512 + (t - 1536)) * 512 + c; }
                            else dst = out + (isV ? O_BVS : O_BKS) + ((size_t)(L * 8 + b) * 16 + t) * 512 + c;
                        }
                        if (dst != nullptr && rowok) { *(f32x4*)dst = acc[ai][bj][m][0]; *(f32x4*)(dst + 4) = acc[ai][bj][m][1]; }
                    }
                }
        }
    }
};

struct PanelRms {
    unsigned long long* xbuf;
    unsigned* cnt;
    unsigned* tmo;
    unsigned code;
    __device__ __forceinline__ void run(const f32x4 (&st)[2][4], const Unit& u, int wr, int wc, int fr, int fq, PG8_LAS unsigned char* lds, int wid, int lane) const {
        typedef float f32x2v __attribute__((ext_vector_type(2)));
        PG8_LAS f32x4* P = (PG8_LAS f32x4*)lds;
        PG8_LAS f32x2v* S = (PG8_LAS f32x2v*)(lds + 16384);
#pragma unroll
        for (int ai = 0; ai < 2; ++ai)
#pragma unroll
            for (int m = 0; m < 4; ++m) if (fq == 0) P[(ai * HALF + wr * 64 + m * 16 + fr) * 4 + wc] = st[ai][m];
        asm volatile("s_waitcnt lgkmcnt(0)" ::: "memory"); __builtin_amdgcn_s_barrier(); asm volatile("" ::: "memory");
        const int row = wid * 32 + (lane & 31);
        if (lane < 32) {
            const f32x4 a = P[row * 4 + 0], b = P[row * 4 + 1], c = P[row * 4 + 2], d = P[row * 4 + 3];
            const f32x4 s = (a + b) + (c + d);
            unsigned long long* slot = xbuf + ((size_t)(u.pm * BM + row) * 8 + u.pn) * 2;
            __hip_atomic_store(slot, ((unsigned long long)__float_as_uint(s[1]) << 32) | __float_as_uint(s[0]), __ATOMIC_RELAXED, __HIP_MEMORY_SCOPE_AGENT);
            __hip_atomic_store(slot + 1, ((unsigned long long)__float_as_uint(s[3]) << 32) | __float_as_uint(s[2]), __ATOMIC_RELAXED, __HIP_MEMORY_SCOPE_AGENT);
        }
        asm volatile("s_waitcnt vmcnt(0)" ::: "memory");
        if (lane == 0) __hip_atomic_fetch_add(cnt + 64 * u.pm, 1u, __ATOMIC_RELAXED, __HIP_MEMORY_SCOPE_AGENT);
        if (wid == 0) {
            const unsigned long long t0 = __builtin_amdgcn_s_memrealtime(); const unsigned want = 64u;
            for (;;) {
                if ((unsigned)__builtin_amdgcn_readfirstlane(__hip_atomic_load(cnt + 64 * u.pm, __ATOMIC_RELAXED, __HIP_MEMORY_SCOPE_AGENT)) >= want) break;
                if (__builtin_amdgcn_s_memrealtime() - t0 > 2000000ull) {
                    if (lane == 0) { unsigned expect = 0u; __hip_atomic_compare_exchange_strong(tmo + 1, &expect, code | (unsigned)(u.pm & 0xff), __ATOMIC_RELAXED, __ATOMIC_RELAXED, __HIP_MEMORY_SCOPE_AGENT);
                                     __hip_atomic_store(tmo, 1u, __ATOMIC_RELAXED, __HIP_MEMORY_SCOPE_AGENT); }
                    break; }
                __builtin_amdgcn_s_sleep(2);
            }
            __builtin_amdgcn_fence(__ATOMIC_ACQUIRE, "agent");
        }
        asm volatile("s_waitcnt vmcnt(0) lgkmcnt(0)" ::: "memory"); __builtin_amdgcn_s_barrier(); asm volatile("" ::: "memory");
        if (lane < 32) {
            const unsigned long long* slot = xbuf + (size_t)(u.pm * BM + row) * 8 * 2; float s1 = 0.f, s2 = 0.f, s3 = 0.f, s4 = 0.f;
#pragma unroll
            for (int t = 0; t < 8; ++t) { const unsigned long long w0 = __hip_atomic_load(slot + 2 * t, __ATOMIC_RELAXED, __HIP_MEMORY_SCOPE_AGENT), w1 = __hip_atomic_load(slot + 2 * t + 1, __ATOMIC_RELAXED, __HIP_MEMORY_SCOPE_AGENT);
                s1 += __uint_as_float((unsigned)w0); s2 += __uint_as_float((unsigned)(w0 >> 32)); s3 += __uint_as_float((unsigned)w1); s4 += __uint_as_float((unsigned)(w1 >> 32)); }
            const float rt = 1.0f / sqrtf(s1 * (1.0f / X_DM) + 1e-6f);
            const float q = s2 + 2.0f * rt * s3 + rt * rt * s4;
            S[row] = (f32x2v){rt, 1.0f / sqrtf(fmaxf(q, 0.f) * (1.0f / X_DM) + 1e-6f)};
        }
        asm volatile("s_waitcnt lgkmcnt(0)" ::: "memory"); __builtin_amdgcn_s_barrier(); asm volatile("" ::: "memory");
    }
};
struct EpiFuse {
    static constexpr bool PERM = false, ADJ = false, AFTER_DRAIN = true;
    const float* xin; float* xout; bf16_t* H;
    const float* vc; const float* ve; const float* vf;
    int bstride;
    PanelRms st;
    __device__ __forceinline__ void fused(f32x4 (&acc)[2][2][4][2], const Unit& u, int wr, int wc, int fr, int fq, PG8_LAS unsigned char* lds, int wid, int lane) const {
        typedef float f32x2v __attribute__((ext_vector_type(2))); typedef unsigned u32x2v __attribute__((ext_vector_type(2)));
        PG8_LAS unsigned char* xl = lds + 20480;
        PG8_LAS unsigned* tp = (PG8_LAS unsigned*)xl + (wid * 64 + lane);
        PG8_LAS unsigned* tq = tp + 32 * 512; asm volatile("" : "+v"(tq));
#define TPW(w) (((w) < 32) ? tp[(w) * 512] : tq[((w) - 32) * 512])
        const PG8_LAS f32x2v* S = (const PG8_LAS f32x2v*)(lds + 16384);
        const int col0 = u.pn * BM + wc * 32 + 4 * fq;
        const size_t boff = (size_t)(u.pm >> 3) * bstride + col0;
        float s1[2][4];
#pragma unroll
        for (int ai = 0; ai < 2; ++ai)
#pragma unroll
            for (int m = 0; m < 4; ++m) { float q = 0.f;
#pragma unroll
                for (int bj = 0; bj < 2; ++bj)
#pragma unroll
                    for (int n = 0; n < 2; ++n) { const f32x4 t = acc[ai][bj][m][n]; q += (t[0] * t[0] + t[1] * t[1]) + (t[2] * t[2] + t[3] * t[3]);
                        const int w = ((ai * 4 + m) * 4 + bj * 2 + n) * 2; TPW(w) = cvt_pk_bf16(t[0], t[1]); TPW(w + 1) = cvt_pk_bf16(t[2], t[3]); }
                s1[ai][m] = q; asm volatile("" ::: "memory"); __builtin_amdgcn_sched_barrier(0); }
        asm volatile("s_waitcnt lgkmcnt(0)" ::: "memory"); __builtin_amdgcn_sched_barrier(0);
        f32x4 cv[2][2];
#pragma unroll
        for (int bj = 0; bj < 2; ++bj)
#pragma unroll
            for (int n = 0; n < 2; ++n) cv[bj][n] = *(const f32x4*)(vc + boff + bj * HALF + n * 16);
        f32x4 stt[2][4];
#pragma unroll
        for (int ai = 0; ai < 2; ++ai) {
            f32x4 xv[4][2][2];
#pragma unroll
            for (int m = 0; m < 4; ++m) { const size_t off = (size_t)(u.pm * BM + ai * HALF + wr * 64 + m * 16 + fr) * X_DM + col0;
#pragma unroll
                for (int bj = 0; bj < 2; ++bj)
#pragma unroll
                    for (int n = 0; n < 2; ++n) xv[m][bj][n] = *(const f32x4*)(xin + off + bj * HALF + n * 16); }
#pragma unroll
            for (int m = 0; m < 4; ++m) { float a1 = s1[ai][m], s2 = 0.f, s3 = 0.f, s4 = 0.f;
#pragma unroll
                for (int bj = 0; bj < 2; ++bj)
#pragma unroll
                    for (int n = 0; n < 2; ++n) { const int w = ((ai * 4 + m) * 4 + bj * 2 + n) * 2; const unsigned p0 = TPW(w), p1 = TPW(w + 1);
                        const f32x4 t = {__uint_as_float(p0 << 16), __uint_as_float(p0 & 0xffff0000u), __uint_as_float(p1 << 16), __uint_as_float(p1 & 0xffff0000u)};
                        const f32x4 x = xv[m][bj][n]; const f32x4 ct = cv[bj][n] * t;
                        s2 += (x[0] * x[0] + x[1] * x[1]) + (x[2] * x[2] + x[3] * x[3]);
                        s3 += (x[0] * ct[0] + x[1] * ct[1]) + (x[2] * ct[2] + x[3] * ct[3]); s4 += (ct[0] * ct[0] + ct[1] * ct[1]) + (ct[2] * ct[2] + ct[3] * ct[3]); }
                a1 += __shfl_xor(a1, 16); a1 += __shfl_xor(a1, 32); s2 += __shfl_xor(s2, 16); s2 += __shfl_xor(s2, 32);
                s3 += __shfl_xor(s3, 16); s3 += __shfl_xor(s3, 32); s4 += __shfl_xor(s4, 16); s4 += __shfl_xor(s4, 32);
                stt[ai][m] = (f32x4){a1, s2, s3, s4}; }
            asm volatile("" ::: "memory");
        }
        st.run(stt, u, wr, wc, fr, fq, lds, wid, lane);
        f32x4 ev[2][2], fv[2][2];
#pragma unroll
        for (int bj = 0; bj < 2; ++bj)
#pragma unroll
            for (int n = 0; n < 2; ++n) { ev[bj][n] = H ? *(const f32x4*)(ve + boff + bj * HALF + n * 16) : (f32x4){0.f, 0.f, 0.f, 0.f}; fv[bj][n] = H ? *(const f32x4*)(vf + boff + bj * HALF + n * 16) : (f32x4){0.f, 0.f, 0.f, 0.f}; }
#pragma unroll
        for (int ai = 0; ai < 2; ++ai) {
            f32x4 xv[4][2][2];
#pragma unroll
            for (int m = 0; m < 4; ++m) { const size_t off = (size_t)(u.pm * BM + ai * HALF + wr * 64 + m * 16 + fr) * X_DM + col0;
#pragma unroll
                for (int bj = 0; bj < 2; ++bj)
#pragma unroll
                    for (int n = 0; n < 2; ++n) xv[m][bj][n] = *(const f32x4*)(xin + off + bj * HALF + n * 16); }
#pragma unroll
            for (int m = 0; m < 4; ++m) { const int r = ai * HALF + wr * 64 + m * 16 + fr; const f32x2v sr = S[r]; const size_t off = (size_t)(u.pm * BM + r) * X_DM + col0;
#pragma unroll
                for (int bj = 0; bj < 2; ++bj)
#pragma unroll
                    for (int n = 0; n < 2; ++n) { const int w = ((ai * 4 + m) * 4 + bj * 2 + n) * 2; const unsigned p0 = TPW(w), p1 = TPW(w + 1);
                        const f32x4 t = {__uint_as_float(p0 << 16), __uint_as_float(p0 & 0xffff0000u), __uint_as_float(p1 << 16), __uint_as_float(p1 & 0xffff0000u)};
                        const f32x4 x1 = xv[m][bj][n] + (t * sr.x) * cv[bj][n];
                        *(f32x4*)(xout + off + bj * HALF + n * 16) = x1;
                        if (H) { const f32x4 h = x1 * sr.y * ev[bj][n] + fv[bj][n]; u32x2v w2; w2.x = cvt_pk_bf16(h[0], h[1]); w2.y = cvt_pk_bf16(h[2], h[3]); *(u32x2v*)(H + off + bj * HALF + n * 16) = w2; } } }
            asm volatile("" ::: "memory");
        }
    }
};
#undef TPW
template <class Epi, class Sched, bool ALIGN_EPI = false, bool SP2 = false>
__device__ __forceinline__ void gemm_phase(PG8_LAS unsigned char* lds, const Gemm g, const Sched& S, const Epi& E, int tid_in) {
    int tid_ = tid_in; asm volatile("" : "+v"(tid_));
    const int tid = tid_, wid = __builtin_amdgcn_readfirstlane(tid >> 6), lane = tid & 63, wr = wid >> 2, wc = wid & 3, fr = lane & 15, fq = lane >> 4;
    int K_ = g.K; asm volatile("" : "+s"(K_));
    const int K = K_, nt = K / BK;
    unsigned voffA[2], voffB[2];
#pragma unroll
    for (int i = 0; i < 2; ++i) { int R, C; stage_rc(tid * 16 + i * 8192, R, C); const int Rb = Epi::ADJ ? (64 * (R >> 5) + perm32(R & 31)) : (Epi::PERM ? ((R & ~31) + perm32(R & 31)) : R);
        voffA[i] = (unsigned)(R * K + C) * 2u; voffB[i] = (unsigned)(Rb * K + C) * 2u; }
    const size_t kstep = (size_t)(BK * 2);
    const size_t hstep = (size_t)HALF * K * 2;
    const size_t bhstep = Epi::ADJ ? (size_t)32 * K * 2 : hstep;
    const size_t tstep = 2 * hstep;
    const unsigned ldsw = (unsigned)wid * 1024u;
    const int aoff = lds_byte(wr * 64 + fr, fq * 8), boff = lds_byte(wc * 32 + fr, fq * 8);
#define PG8_SA(b, h) (((b) * 2 + (h)) * HTB)
#define PG8_SB(b, h) ((4 + (b) * 2 + (h)) * HTB)
#define PG8_STAGE(bufoff, gbase, voff) do { _Pragma("unroll") for (int _i = 0; _i < 2; ++_i) \
        __builtin_amdgcn_global_load_lds((const unsigned*)((const char*)(gbase) + (voff)[_i]), (PG8_LAS unsigned*)(lds + (bufoff) + ldsw + _i * 8192), 16, 0, 0); } while (0)
#define PG8_LDA(dst, b, h) do { _Pragma("unroll") for (int m = 0; m < 4; ++m) _Pragma("unroll") for (int k = 0; k < 2; ++k) dst[m][k] = *(const PG8_LAS bf16x8*)(lds + PG8_SA(b, h) + aoff + m * 2048 + k * 1024); } while (0)
#define PG8_LDB(dst, b, h) do { _Pragma("unroll") for (int n = 0; n < 2; ++n) _Pragma("unroll") for (int k = 0; k < 2; ++k) dst[n][k] = *(const PG8_LAS bf16x8*)(lds + PG8_SB(b, h) + boff + n * 2048 + k * 1024); } while (0)
#define PG8_MMA(ai, bj, At, Bt) do { __builtin_amdgcn_s_setprio(1); _Pragma("unroll") for (int m = 0; m < 4; ++m) _Pragma("unroll") for (int n = 0; n < 2; ++n) _Pragma("unroll") for (int k = 0; k < 2; ++k) \
        acc[ai][bj][m][n] = __builtin_amdgcn_mfma_f32_16x16x32_bf16(Bt[n][k], At[m][k], acc[ai][bj][m][n], 0, 0, 0); __builtin_amdgcn_s_setprio(0); } while (0)
#define PG8_WAIT_V(n) asm volatile("s_waitcnt vmcnt(" #n ")" ::: "memory")
#define PG8_WAIT_L(n) asm volatile("s_waitcnt lgkmcnt(" #n ")" ::: "memory")
#define PG8_BAR __builtin_amdgcn_s_barrier()
#define PG8_SCHED __builtin_amdgcn_sched_barrier(0)
    Unit cur, nxt; int ui = 0;
    if (!S.next(0, cur)) return;
    f32x4 acc[2][2][4][2];
#pragma unroll
    for (int a = 0; a < 2; ++a)
#pragma unroll
        for (int b = 0; b < 2; ++b)
#pragma unroll
            for (int m = 0; m < 4; ++m)
#pragma unroll
                for (int n = 0; n < 2; ++n) acc[a][b][m][n] = (f32x4){0.f, 0.f, 0.f, 0.f};
    bf16x8 At[4][2], B0[2][2], B1[2][2];
    const char* cA = (const char*)g.A + (size_t)cur.pm * tstep; const char* cB = (const char*)g.Bt + (size_t)cur.pn * tstep;
    S.a_ready(cur);
    if constexpr (SP2) {
        PG8_STAGE(PG8_SB(0, 0), cB, voffB); PG8_STAGE(PG8_SB(0, 1), cB + bhstep, voffB); PG8_STAGE(PG8_SA(0, 0), cA, voffA); PG8_STAGE(PG8_SA(0, 1), cA + hstep, voffA);
        if (wr == 1) PG8_BAR;
        PG8_WAIT_V(2); PG8_BAR;
        PG8_STAGE(PG8_SB(1, 0), cB + kstep, voffB); PG8_STAGE(PG8_SA(1, 0), cA + kstep, voffA); PG8_STAGE(PG8_SB(1, 1), cB + bhstep + kstep, voffB);
        PG8_WAIT_V(6); PG8_BAR;
    } else {
        PG8_STAGE(PG8_SB(0, 0), cB, voffB); PG8_STAGE(PG8_SA(0, 0), cA, voffA); PG8_STAGE(PG8_SB(0, 1), cB + bhstep, voffB); PG8_STAGE(PG8_SA(0, 1), cA + hstep, voffA);
        if (wr == 1) PG8_BAR;
        PG8_WAIT_V(4); PG8_BAR;
        PG8_STAGE(PG8_SB(1, 0), cB + kstep, voffB); PG8_STAGE(PG8_SA(1, 0), cA + kstep, voffA); PG8_STAGE(PG8_SB(1, 1), cB + bhstep + kstep, voffB);
        PG8_WAIT_V(6); PG8_BAR;
    }
    for (;;) {
        const bool has_next = S.next(ui + 1, nxt);
        const char* nA = has_next ? (const char*)g.A + (size_t)nxt.pm * tstep : cA; const char* nB = has_next ? (const char*)g.Bt + (size_t)nxt.pn * tstep : cB;
        for (int t = 0; t < nt; t += 2) {
            const bool last = (t == nt - 2);
            const char* a1 = cA + (size_t)(t + 1) * kstep;
            const char* a2 = last ? nA : cA + (size_t)(t + 2) * kstep; const char* b2 = last ? nB : cB + (size_t)(t + 2) * kstep;
            const char* a3 = a2 + kstep; const char* b3 = b2 + kstep;
            if (last && has_next) S.a_ready(nxt);
            if constexpr (SP2) {
            PG8_LDB(B0, 0, 0); PG8_LDB(B1, 0, 1); PG8_SCHED; PG8_LDA(At, 0, 0); PG8_STAGE(PG8_SA(1, 1), a1 + hstep, voffA);
            PG8_WAIT_V(8); PG8_WAIT_L(0); PG8_BAR; PG8_MMA(0, 0, At, B0); PG8_MMA(0, 1, At, B1); PG8_BAR; PG8_SCHED;
            PG8_LDA(At, 0, 1); PG8_STAGE(PG8_SB(0, 0), b2, voffB); PG8_STAGE(PG8_SB(0, 1), b2 + bhstep, voffB); PG8_STAGE(PG8_SA(0, 0), a2, voffA);
            PG8_WAIT_V(8); PG8_WAIT_L(0); PG8_BAR; PG8_MMA(1, 0, At, B0); PG8_MMA(1, 1, At, B1); PG8_BAR; PG8_SCHED;
            PG8_LDB(B0, 1, 0); PG8_LDB(B1, 1, 1); PG8_SCHED; PG8_LDA(At, 1, 0); PG8_STAGE(PG8_SA(0, 1), a2 + hstep, voffA);
            PG8_WAIT_V(8); PG8_WAIT_L(0); PG8_BAR; PG8_MMA(0, 0, At, B0); PG8_MMA(0, 1, At, B1); PG8_BAR; PG8_SCHED;
            PG8_LDA(At, 1, 1); PG8_STAGE(PG8_SB(1, 0), b3, voffB); PG8_STAGE(PG8_SB(1, 1), b3 + bhstep, voffB); PG8_STAGE(PG8_SA(1, 0), a3, voffA);
            PG8_WAIT_V(8); PG8_WAIT_L(0); PG8_BAR; PG8_MMA(1, 0, At, B0); PG8_MMA(1, 1, At, B1); PG8_BAR; PG8_SCHED;
            } else {
            PG8_LDB(B0, 0, 0); PG8_SCHED; PG8_LDA(At, 0, 0); PG8_STAGE(PG8_SA(1, 1), a1 + hstep, voffA);
            PG8_WAIT_L(8); PG8_BAR; PG8_WAIT_L(0); PG8_MMA(0, 0, At, B0); PG8_BAR; PG8_SCHED;
            PG8_LDB(B1, 0, 1); PG8_STAGE(PG8_SB(0, 0), b2, voffB);
            PG8_BAR; PG8_WAIT_L(0); PG8_MMA(0, 1, At, B1); PG8_BAR;
            PG8_LDA(At, 0, 1); PG8_STAGE(PG8_SA(0, 0), a2, voffA);
            PG8_BAR; PG8_WAIT_L(0); PG8_MMA(1, 0, At, B0); PG8_BAR; PG8_SCHED;
            PG8_STAGE(PG8_SB(0, 1), b2 + bhstep, voffB);
            PG8_WAIT_V(6); PG8_BAR; PG8_MMA(1, 1, At, B1); PG8_BAR;
            PG8_LDB(B0, 1, 0); PG8_SCHED; PG8_LDA(At, 1, 0); PG8_STAGE(PG8_SA(0, 1), a2 + hstep, voffA);
            PG8_WAIT_L(8); PG8_BAR; PG8_WAIT_L(0); PG8_MMA(0, 0, At, B0); PG8_BAR; PG8_SCHED;
            PG8_LDB(B1, 1, 1); PG8_STAGE(PG8_SB(1, 0), b3, voffB);
            PG8_BAR; PG8_WAIT_L(0); PG8_MMA(0, 1, At, B1); PG8_BAR;
            PG8_LDA(At, 1, 1); PG8_STAGE(PG8_SA(1, 0), a3, voffA);
            PG8_BAR; PG8_WAIT_L(0); PG8_MMA(1, 0, At, B0); PG8_BAR; PG8_SCHED;
            PG8_STAGE(PG8_SB(1, 1), b3 + bhstep, voffB);
            PG8_WAIT_V(6); PG8_BAR; PG8_MMA(1, 1, At, B1); PG8_BAR;
            }
        }
        if constexpr (ALIGN_EPI) { if (wr == 0) PG8_BAR; }
        if constexpr (!Epi::AFTER_DRAIN) { E(acc, cur, wr, wc, fr, fq); S.done(cur); }
        if (!has_next) break;
#pragma unroll
        for (int a = 0; a < 2; ++a)
#pragma unroll
            for (int b = 0; b < 2; ++b)
#pragma unroll
                for (int m = 0; m < 4; ++m)
#pragma unroll
                    for (int n = 0; n < 2; ++n) acc[a][b][m][n] = (f32x4){0.f, 0.f, 0.f, 0.f};
        cur = nxt; cA = nA; cB = nB; ++ui;
        if constexpr (ALIGN_EPI) { if (wr == 1) PG8_BAR; }
    }
    PG8_WAIT_V(0);
    if constexpr (!ALIGN_EPI) { if (wr == 0) PG8_BAR; }
    PG8_BAR;
    if constexpr (Epi::AFTER_DRAIN) { E.fused(acc, cur, wr, wc, fr, fq, lds, wid, lane); S.done(cur); }
#undef PG8_SA
#undef PG8_SB
#undef PG8_STAGE
#undef PG8_LDA
#undef PG8_LDB
#undef PG8_MMA
#undef PG8_WAIT_V
#undef PG8_WAIT_L
#undef PG8_BAR
#undef PG8_SCHED
}
}
#define GAS __attribute__((address_space(1)))
#define LAS __attribute__((address_space(3)))
typedef unsigned short bf16;
typedef unsigned v4u __attribute__((ext_vector_type(4)));
typedef float f32x4 __attribute__((ext_vector_type(4)));
typedef short bf16x8 __attribute__((ext_vector_type(8)));
typedef GAS unsigned gu32;
typedef GAS unsigned long long gu64;
#define RLX_AGENT __ATOMIC_RELAXED, __HIP_MEMORY_SCOPE_AGENT
#define LDS_WAIT() asm volatile("s_waitcnt lgkmcnt(0)" ::: "memory")
#define VM_WAIT() asm volatile("s_waitcnt vmcnt(0)" ::: "memory")
__device__ __forceinline__ unsigned long long rt() { return __builtin_amdgcn_s_memrealtime(); }
__device__ __forceinline__ unsigned f2bf(float f) { unsigned u = __builtin_bit_cast(unsigned, f); return (u + 0x7fffu + ((u >> 16) & 1u)) >> 16; }
__device__ __forceinline__ unsigned pk2(float lo, float hi) { return f2bf(lo) | (f2bf(hi) << 16); }
#define XB_TMO      128
#define XB_XCNT(j)  (256  + 64 * (j))
#define XB_XSUB(j)  (1280 + 64 * (j))
#define XB_XGEN(j)  (2304 + 64 * (j))
#define XB_TOP      3328
#define XB_TOPGEN   3392
#define XCD_BAR_WORDS 3456
#define XB_SPIN_CAP (1u << 18)

__device__ __forceinline__ unsigned xb_ld(unsigned* p)              { return __hip_atomic_load(p, __ATOMIC_RELAXED, __HIP_MEMORY_SCOPE_AGENT); }
__device__ __forceinline__ unsigned xb_add(unsigned* p, unsigned v) { return __hip_atomic_fetch_add(p, v, __ATOMIC_RELAXED, __HIP_MEMORY_SCOPE_AGENT); }
__device__ __forceinline__ unsigned xb_xcc_id() { return (unsigned)__builtin_amdgcn_s_getreg((3 << 11) | 20) & 0xFu; }
#define XB_SPIN(cond, bar) do { unsigned _sp = 0; while (cond) { __builtin_amdgcn_s_sleep(1); \
    if ((++_sp & 255u) == 0u) { if (xb_ld(&(bar)[XB_TMO])) break; if (_sp > XB_SPIN_CAP) { atomicAdd(&(bar)[XB_TMO], 1u); break; } } } } while (0)

struct XcdBarrier {
    unsigned* bar; unsigned x;
    volatile LAS unsigned* st;
};

__device__ __forceinline__ XcdBarrier xcd_barrier_post(unsigned* bar, volatile LAS unsigned* st, bool t0  ) {
    XcdBarrier b; b.bar = bar; b.x = xb_xcc_id(); b.st = st;
    if (t0) (void)xb_add(&bar[XB_XCNT(b.x)], 1u);
    return b;
}
__device__ __forceinline__ void xcd_barrier_complete(unsigned* bar, unsigned x, unsigned& nloc, unsigned& nx) {
    const unsigned G = gridDim.x * gridDim.y * gridDim.z;
    unsigned sum, cnt, mine, sp = 0u;
    for (;;) {
        sum = 0u; cnt = 0u; mine = 0u;
#pragma unroll
        for (unsigned j = 0; j < 16; ++j) { const unsigned c = xb_ld(&bar[XB_XCNT(j)]); sum += c; cnt += (c > 0u) ? 1u : 0u; mine = (j == x) ? c : mine; }
        if (sum == G) break;
        __builtin_amdgcn_s_sleep(1);
        if ((++sp & 255u) == 0u) { if (xb_ld(&bar[XB_TMO])) break; if (sp > XB_SPIN_CAP) { atomicAdd(&bar[XB_TMO], 1u); break; } }
    }
    nloc = mine > 0u ? mine : 1u; nx = cnt > 0u ? cnt : 1u;
}

__device__ __forceinline__ void xcd_barrier(const XcdBarrier& b, bool t0  ) {
    asm volatile("s_waitcnt vmcnt(0)" ::: "memory");
    __syncthreads();
    if (t0) {
        unsigned* bar = b.bar;
        __builtin_amdgcn_s_waitcnt(0);
        unsigned nloc = b.st[0], nx = b.st[1];
        if (nloc == 0u) { xcd_barrier_complete(bar, b.x, nloc, nx); b.st[0] = nloc; b.st[1] = nx; }
        const unsigned old = xb_add(&bar[XB_XSUB(b.x)], 1u);
        const unsigned gen = old / nloc;
        if (old + 1u == (gen + 1u) * nloc) {
            __builtin_amdgcn_fence(__ATOMIC_RELEASE, "agent");
            asm volatile("s_waitcnt vmcnt(0)" ::: "memory");
            const unsigned og = xb_add(&bar[XB_TOP], 1u);
            const unsigned tg = og / nx;
            if (og + 1u == (tg + 1u) * nx) xb_add(&bar[XB_TOPGEN], 1u);
            else XB_SPIN(xb_ld(&bar[XB_TOPGEN]) == tg, bar);
            __builtin_amdgcn_fence(__ATOMIC_ACQUIRE, "agent");
            xb_add(&bar[XB_XGEN(b.x)], 1u);
            asm volatile("s_waitcnt vmcnt(0)" ::: "memory");
        } else {
            XB_SPIN(xb_ld(&bar[XB_XGEN(b.x)]) == gen, bar);
            __builtin_amdgcn_fence(__ATOMIC_ACQUIRE, "agent");
            asm volatile("s_waitcnt vmcnt(0)" ::: "memory");
        }
    }
    __syncthreads();
}

#ifndef FUSE_THIN
#define FUSE_THIN 0
#endif
#ifndef TAIL_MODE
#define TAIL_MODE 0
#endif
#ifndef REP_BAR
#define REP_BAR 1
#endif
#ifndef SWA_ALL
#define SWA_ALL 1
#endif
#ifndef ATT_ROT
#define ATT_ROT 1
#endif
#ifndef P0_KH
#define P0_KH 64
#endif
#ifndef P0_NT_LD
#define P0_NT_LD 0
#endif
#ifndef P0_NT_ST
#define P0_NT_ST 0
#endif
#ifndef P0_DYN
#define P0_DYN 0
#endif
#ifndef COOP_SPLIT
#define COOP_SPLIT 1
#endif
#ifndef P0_DEEP
#define P0_DEEP 0
#endif
#ifndef P0_PROBE
#define P0_PROBE 0
#endif
#ifndef REP_P0M
#define REP_P0M 1
#endif
#ifndef REP_P0
#define REP_P0 1
#endif
#ifndef REP_A
#define REP_A 1
#endif
#ifndef REP_S
#define REP_S 1
#endif
#ifndef REP_B4
#define REP_B4 1
#endif
#ifndef REP_B1
#define REP_B1 1
#endif
#ifndef REP_B2
#define REP_B2 1
#endif
#ifndef REP_B3
#define REP_B3 1
#endif
#ifndef REP_C
#define REP_C 1
#endif
#ifndef REP_E
#define REP_E 1
#endif
#ifndef REP_F
#define REP_F 1
#endif
constexpr int DM = 2048, BP = 4, TP = 2048, MP = BP * TP, BS = 8, TS = 16, MS = BS * TS, MR = MP + MS, MT = 8448;
constexpr int DIN = 4352, DFF = 8192, NL = 4, NMOD = 6 * DM;
constexpr int C_QA = 0, C_KA = 512, C_VA = 640, C_XB = 768, C_GB = 1792, C_QC = 2816, C_KC = 3328, C_VC = 3840;
constexpr float RMS_EPS = 1e-6f, LOG2E = 1.4426950408889634f;
using pg8::O_YP; using pg8::O_YS; using pg8::O_LHP; using pg8::O_LHS; using pg8::O_END;
constexpr int NWAVES = 8;
constexpr size_t MiB = 1u << 20;
constexpr size_t WS_CTL = 0, CTL_ZERO_BYTES = 1 * MiB;
constexpr size_t WS_MOD = 1 * MiB;
constexpr size_t WS_WIN = 4 * MiB;
constexpr size_t WS_WOUT = 72 * MiB;
constexpr size_t WS_WUP = 104 * MiB;
constexpr size_t WS_WDN = 232 * MiB;
constexpr size_t WS_H = 360 * MiB;
constexpr size_t WS_Z = 393 * MiB;
constexpr size_t WS_MIX = 464 * MiB;
constexpr size_t WS_T = 497 * MiB;
constexpr size_t WS_F1 = 563 * MiB;
constexpr size_t WS_XCH = 695 * MiB;
constexpr size_t WS_XR = 703 * MiB;
constexpr size_t WS_END = 736 * MiB;
static_assert(WS_MOD + (size_t)NL * 12 * NMOD * 4 <= WS_WIN && WS_WIN + (size_t)NL * DIN * DM * 2 <= WS_WOUT && WS_WOUT + (size_t)NL * DM * DM * 2 <= WS_WUP &&
              WS_WUP + (size_t)NL * DFF * DM * 2 <= WS_WDN && WS_WDN + (size_t)NL * DFF * DM * 2 <= WS_H && WS_H + (size_t)MT * DM * 2 <= WS_Z &&
              WS_Z + (size_t)MT * DIN * 2 <= WS_MIX && WS_MIX + (size_t)MT * DM * 2 <= WS_T && WS_T + (size_t)MT * DM * 4 <= WS_F1 && WS_F1 + (size_t)MT * DFF * 2 <= WS_END, "d_ws map");
constexpr int CW_SEAM = 16384;
constexpr int CW_Q = 8192;
constexpr int CW_DQ = 9216;
constexpr int CW_BAR = 4096;
constexpr int RING_BYTES = 131072, SCR_BYTES = 163840 - 1024  , LDSCTL_OFF = SCR_BYTES, MISC_OFF = LDSCTL_OFF + 320, LDS_BYTES = 163840;

typedef float f32x16 __attribute__((ext_vector_type(16)));
typedef unsigned u32x2 __attribute__((ext_vector_type(2)));
__device__ __forceinline__ float bf2f(unsigned short b) { return __uint_as_float((unsigned)b << 16); }
__device__ __forceinline__ unsigned pkbf(float lo, float hi) { typedef float f2_t __attribute__((ext_vector_type(2))); typedef __bf16 b2_t __attribute__((ext_vector_type(2)));
    f2_t v = {lo, hi}; b2_t b = __builtin_convertvector(v, b2_t); return __builtin_bit_cast(unsigned, b); }
__device__ __forceinline__ v4u pack8(const f32x4 a, const f32x4 b) { v4u w; w.x = pkbf(a[0], a[1]); w.y = pkbf(a[2], a[3]); w.z = pkbf(b[0], b[1]); w.w = pkbf(b[2], b[3]); return w; }
__device__ __forceinline__ float dpp_add(float v, float w) { return v + w; }
template <int CTRL> __device__ __forceinline__ float dpp_mov(float v) { return __builtin_bit_cast(float, __builtin_amdgcn_update_dpp(0, __builtin_bit_cast(int, v), CTRL, 0xf, 0xf, true)); }
__device__ __forceinline__ float wave_sum(float v) {
    v += dpp_mov<0xB1>(v);
    v += dpp_mov<0x4E>(v);
    v += dpp_mov<0x141>(v);
    v += dpp_mov<0x140>(v);
    const int b = __builtin_bit_cast(int, v);
    const float r0 = __builtin_bit_cast(float, __builtin_amdgcn_readlane(b, 0)), r1 = __builtin_bit_cast(float, __builtin_amdgcn_readlane(b, 16));
    const float r2 = __builtin_bit_cast(float, __builtin_amdgcn_readlane(b, 32)), r3 = __builtin_bit_cast(float, __builtin_amdgcn_readlane(b, 48));
    return (r0 + r1) + (r2 + r3);
}
__device__ __forceinline__ int hw_lane() { int l; asm volatile("v_mbcnt_lo_u32_b32 %0, -1, 0\n\tv_mbcnt_hi_u32_b32 %0, -1, %0" : "=v"(l)); return l; }
__device__ __forceinline__ float fexp2(float x) { return __builtin_amdgcn_exp2f(x); }
__device__ __forceinline__ float frcp(float x) { return __builtin_amdgcn_rcpf(x); }
__device__ __forceinline__ float sigmoidf_fast(float x) { return frcp(1.0f + fexp2(-x * LOG2E)); }

__device__ __forceinline__ void p0_transpose_item(const float* W, int K, int N, bf16* WT, LAS float* scr, int item, int lane) {
    const int nblk = N / 32, kb = item / nblk, nb = item % nblk, k0 = 64 * kb, n0 = 32 * nb;
    const int lr = lane >> 3, lc = lane & 7;
    const float* src = W + (size_t)(k0 + lr) * N + n0 + 4 * lc;
    f32x4 v[8];
#pragma unroll
    for (int i = 0; i < 8; ++i) v[i] = *(const f32x4*)(src + (size_t)(8 * i) * N);
#pragma unroll
    for (int i = 0; i < 8; ++i) *(LAS f32x4*)(scr + (8 * i + lr) * 36 + 4 * lc) = v[i];
    LDS_WAIT(); asm volatile("" ::: "memory");
    const int c = lane & 7;
#pragma unroll
    for (int j = 0; j < 4; ++j) { const int n = (lane >> 3) + 8 * j; const LAS float* s = scr + (8 * c) * 36 + n;
        v4u o; o.x = pkbf(s[0 * 36], s[1 * 36]); o.y = pkbf(s[2 * 36], s[3 * 36]); o.z = pkbf(s[4 * 36], s[5 * 36]); o.w = pkbf(s[6 * 36], s[7 * 36]);
        *(GAS v4u*)(WT + (size_t)(n0 + n) * K + k0 + 8 * c) = o; }
    LDS_WAIT(); asm volatile("" ::: "memory");
}
constexpr int TP_PITCH = 520;
constexpr int P0_NI = P0_KH / 8;
__device__ __forceinline__ void p0_tile_load(const float* W, int N, int item, int tid, f32x4 (&pre)[P0_NI]) {
    const int nblk = N / 256, kb = item / nblk, nb = item % nblk;
    const float* src = W + (size_t)(P0_KH * kb + (tid >> 6)) * N + 256 * nb + 4 * (tid & 63);
#pragma unroll
    for (int i = 0; i < P0_NI; ++i) pre[i] = *(const f32x4*)(src + (size_t)(8 * i) * N);
}
__device__ __forceinline__ void p0_tile_store(const f32x4 (&pre)[P0_NI], int K, int N, bf16* WT, LAS unsigned char* scr, int item, int tid, bool dost = true) {
    const int nblk = N / 256, kb = item / nblk, nb = item % nblk;
    __syncthreads();
#pragma unroll
    for (int i = 0; i < P0_NI; ++i) { u32x2 w; w.x = pkbf(pre[i][0], pre[i][1]); w.y = pkbf(pre[i][2], pre[i][3]); *(LAS u32x2*)(scr + (8 * i + (tid >> 6)) * TP_PITCH + (tid & 63) * 8) = w; }
    __syncthreads();
    const int kc = tid % P0_NI;
#pragma unroll
    for (int j = 0; j < P0_NI / 2; ++j) { const int n = (tid / P0_NI) + (512 / P0_NI) * j; const LAS unsigned char* sp = scr + (8 * kc) * TP_PITCH + n * 2;
        unsigned short e[8];
#pragma unroll
        for (int q = 0; q < 8; ++q) e[q] = *(const LAS unsigned short*)(sp + q * TP_PITCH);
        v4u o; o.x = e[0] | ((unsigned)e[1] << 16); o.y = e[2] | ((unsigned)e[3] << 16); o.z = e[4] | ((unsigned)e[5] << 16); o.w = e[6] | ((unsigned)e[7] << 16);
        if (dost) *(GAS v4u*)(WT + (size_t)(256 * nb + n) * K + P0_KH * kb + 8 * kc) = o; }
}
__device__ __forceinline__ void p0_tile_store_pk(const u32x2 (&w)[8], int K, int N, bf16* WT, LAS unsigned char* scr, int item, int tid) {
    const int nblk = N / 256, kb = item / nblk, nb = item % nblk;
    __syncthreads();
#pragma unroll
    for (int i = 0; i < 8; ++i) *(LAS u32x2*)(scr + (8 * i + (tid >> 6)) * TP_PITCH + (tid & 63) * 8) = w[i];
    __syncthreads();
    const int kc = tid & 7;
#pragma unroll
    for (int j = 0; j < 4; ++j) { const int n = (tid >> 3) + 64 * j; const LAS unsigned char* sp = scr + (8 * kc) * TP_PITCH + n * 2;
        unsigned short e[8];
#pragma unroll
        for (int q = 0; q < 8; ++q) e[q] = *(const LAS unsigned short*)(sp + q * TP_PITCH);
        v4u o; o.x = e[0] | ((unsigned)e[1] << 16); o.y = e[2] | ((unsigned)e[3] << 16); o.z = e[4] | ((unsigned)e[5] << 16); o.w = e[6] | ((unsigned)e[7] << 16);
        *(GAS v4u*)(WT + (size_t)(256 * nb + n) * K + 64 * kb + 8 * kc) = o; }
}
constexpr int MODS_ITEMS = NL * (NMOD / 256);
template <bool DYN> __device__ __forceinline__ void p0_mods(unsigned* qm, volatile LAS unsigned* mq, LAS unsigned char* lds, const float* c_p, const float* c_s, const float* w_mod, const float* b_mod, const float* g_pre_mix, const float* g_post_mix, const float* g_pre_mlp, const float* g_post_mlp, float* MOD, int G, int bid, int tid) {
    const int lane = tid & 63, wave = __builtin_amdgcn_readfirstlane(tid >> 6);
    LAS float* S = (LAS float*)lds;
    LAS float* PS = (LAS float*)lds;
    for (int item0 = bid; DYN || (item0 < MODS_ITEMS * REP_P0M && (REP_P0M == 1 || bid < MODS_ITEMS)); item0 += (REP_P0M > 1 ? MODS_ITEMS : G)) { int item = item0 % MODS_ITEMS;
        __syncthreads();
        if (DYN) {
            if (tid == 0) mq[0] = __hip_atomic_fetch_add(qm, 1u, __ATOMIC_RELAXED, __HIP_MEMORY_SCOPE_AGENT);
            __syncthreads();
            item = __builtin_amdgcn_readfirstlane((int)mq[0]);
            if (item >= MODS_ITEMS * REP_P0M) break;
            item %= MODS_ITEMS;
        }
        for (int e = tid; e < 12 * 2048; e += 512) { const int row = e >> 11, k = e & 2047; const float c = row < 4 ? c_p[row * 2048 + k] : c_s[(row - 4) * 2048 + k]; S[k * 12 + row] = c / (1.0f + expf(-c)); }
        __syncthreads();
        const int l = item / (NMOD / 256), cg = item % (NMOD / 256), col0 = cg * 256;
        const float* W = w_mod + (size_t)l * DM * NMOD + col0 + 4 * lane;
        f32x4 acc[12];
#pragma unroll
        for (int r = 0; r < 12; ++r) acc[r] = (f32x4){0.f, 0.f, 0.f, 0.f};
        const int k0 = wave * 256;
        for (int kk = 0; kk < 256; kk += 8) {
            f32x4 w[8];
#pragma unroll
            for (int u = 0; u < 8; ++u) w[u] = *(const f32x4*)(W + (size_t)(k0 + kk + u) * NMOD);
#pragma unroll
            for (int u = 0; u < 8; ++u) {
                const LAS f32x4* sp = (const LAS f32x4*)(S + (k0 + kk + u) * 12); const f32x4 s0 = sp[0], s1 = sp[1], s2 = sp[2];
#pragma unroll
                for (int r = 0; r < 4; ++r) { acc[r] += w[u] * s0[r]; acc[4 + r] += w[u] * s1[r]; acc[8 + r] += w[u] * s2[r]; }
            }
        }
        __syncthreads();
#pragma unroll
        for (int r = 0; r < 12; ++r) *(LAS f32x4*)(PS + (wave * 12 + r) * 256 + 4 * lane) = acc[r];
        __syncthreads();
        for (int e = tid; e < 12 * 256; e += 512) { const int r = e >> 8, c = e & 255; float s = b_mod[(size_t)l * NMOD + col0 + c];
#pragma unroll
            for (int w = 0; w < 8; ++w) s += PS[(w * 12 + r) * 256 + c];
            const int col = col0 + c, j = col >> 11, d = col & 2047;
            if (j == 1) s = g_pre_mix[l * DM + d] * (1.0f + s); else if (j == 2) s = s * g_post_mix[l * DM + d]; else if (j == 4) s = g_pre_mlp[l * DM + d] * (1.0f + s); else if (j == 5) s = s * g_post_mlp[l * DM + d];
            MOD[((size_t)l * 12 + r) * NMOD + col] = s; }
    }
    __syncthreads();
}

#define ROW_LD_NT(dst, ptr) do { const f32x4* _p = (const f32x4*)(ptr) + lane; _Pragma("unroll") for (int _j = 0; _j < 8; ++_j) dst[_j] = __builtin_nontemporal_load(_p + 64 * _j); } while (0)
#define ROW_LD(dst, ptr) do { const f32x4* _p = (const f32x4*)(ptr) + 2 * lane; _Pragma("unroll") for (int _g = 0; _g < 4; ++_g) { dst[2 * _g] = _p[128 * _g]; dst[2 * _g + 1] = _p[128 * _g + 1]; } } while (0)
__device__ __forceinline__ float row_sumsq(const f32x4 (&v)[8]) { float s = 0.f;
#pragma unroll
    for (int j = 0; j < 8; ++j) s += (v[j][0] * v[j][0] + v[j][1] * v[j][1]) + (v[j][2] * v[j][2] + v[j][3] * v[j][3]);
    return wave_sum(s); }
#ifndef THIN_SC1
#define THIN_SC1 0
#endif
__device__ __forceinline__ void st16_row(v4u* p, v4u w) {
#if THIN_SC1
    asm volatile("global_store_dwordx4 %0, %1, off sc1\n\ts_nop 1" :: "v"(p), "v"(w) : "memory");
#else
    *p = w;
#endif
}
#define ROW_ST_BF16(ptr, src) do { v4u* _o = (v4u*)(ptr) + lane; _Pragma("unroll") for (int _g = 0; _g < 4; ++_g) { v4u _w; _w.x = pkbf(src[2 * _g][0], src[2 * _g][1]); _w.y = pkbf(src[2 * _g][2], src[2 * _g][3]); _w.z = pkbf(src[2 * _g + 1][0], src[2 * _g + 1][1]); _w.w = pkbf(src[2 * _g + 1][2], src[2 * _g + 1][3]); st16_row(_o + 64 * _g, _w); } } while (0)
#define ROW_LD_BF16(dst, ptr) do { const v4u* _p = (const v4u*)(ptr) + lane; _Pragma("unroll") for (int _g = 0; _g < 4; ++_g) { const v4u _w = _p[64 * _g]; \
    dst[2 * _g] = (f32x4){__uint_as_float(_w.x << 16), __uint_as_float(_w.x & 0xffff0000u), __uint_as_float(_w.y << 16), __uint_as_float(_w.y & 0xffff0000u)}; \
    dst[2 * _g + 1] = (f32x4){__uint_as_float(_w.z << 16), __uint_as_float(_w.z & 0xffff0000u), __uint_as_float(_w.w << 16), __uint_as_float(_w.w & 0xffff0000u)}; } } while (0)
__device__ __forceinline__ void norm_store(const f32x4 (&v)[8], float rstd, const f32x4 (&e)[8], const f32x4 (&f)[8], bf16* hrow, int lane) {
    f32x4 h[8];
#pragma unroll
    for (int j = 0; j < 8; ++j) h[j] = v[j] * rstd * e[j] + f[j];
    ROW_ST_BF16(hrow, h);
}
__device__ __forceinline__ void coop_row(const bf16* trow, const float* xr, const bf16* xr16, const float* cp, const float* ep, const float* fp, float* orow, bf16* orow16, bf16* hrow, LAS float* red, int tid) {
    const int lane = tid & 63, wave = tid >> 6;
    f32x4 x;
    if (xr16 != nullptr) { const u32x2 w = ((const u32x2*)xr16)[tid]; x = (f32x4){__uint_as_float(w.x << 16), __uint_as_float(w.x & 0xffff0000u), __uint_as_float(w.y << 16), __uint_as_float(w.y & 0xffff0000u)}; }
    else x = ((const f32x4*)xr)[tid];
    if (trow != nullptr) {
        const u32x2 w = ((const u32x2*)trow)[tid];
        const f32x4 t = {__uint_as_float(w.x << 16), __uint_as_float(w.x & 0xffff0000u), __uint_as_float(w.y << 16), __uint_as_float(w.y & 0xffff0000u)};
        const f32x4 c = ((const f32x4*)cp)[tid];
        const float ss = wave_sum((t[0] * t[0] + t[1] * t[1]) + (t[2] * t[2] + t[3] * t[3]));
        if (lane == 0) red[wave] = ss;
        __syncthreads();
        float tot = 0.f;
#pragma unroll
        for (int w2 = 0; w2 < 8; ++w2) tot += red[w2];
        const float rt_ = 1.0f / sqrtf(tot * (1.0f / DM) + RMS_EPS);
        x = x + (t * rt_) * c;
        if (orow16 != nullptr) { u32x2 o; o.x = pkbf(x[0], x[1]); o.y = pkbf(x[2], x[3]); ((u32x2*)orow16)[tid] = o; } else ((f32x4*)orow)[tid] = x;
    }
    if (hrow != nullptr) {
        const f32x4 e = ((const f32x4*)ep)[tid], f = ((const f32x4*)fp)[tid];
        const float ss = wave_sum((x[0] * x[0] + x[1] * x[1]) + (x[2] * x[2] + x[3] * x[3]));
        if (lane == 0) red[8 + wave] = ss;
        __syncthreads();
        float tot = 0.f;
#pragma unroll
        for (int w2 = 0; w2 < 8; ++w2) tot += red[8 + w2];
        const float rx = 1.0f / sqrtf(tot * (1.0f / DM) + RMS_EPS);
        const f32x4 h = x * rx * e + f;
        u32x2 o; o.x = pkbf(h[0], h[1]); o.y = pkbf(h[2], h[3]); ((u32x2*)hrow)[tid] = o;
    }
}
constexpr int CD_BASE = 1024, CD_C = 0, CD_E = 8192, CD_F = 16384, CD_T = 24576, CD_X = 28672;
__device__ __forceinline__ void coop_dma(LAS unsigned char* lds, const bf16* trow, const float* xr, const bf16* xr16, const float* cp, const float* ep, const float* fp, int wave, int lane) {
    LAS unsigned char* L = lds + CD_BASE + wave * 1024;
    if (cp != nullptr) __builtin_amdgcn_global_load_lds((const unsigned*)(cp + wave * 256 + lane * 4), (LAS unsigned*)(L + CD_C), 16, 0, 0);
    __builtin_amdgcn_global_load_lds((const unsigned*)(ep + wave * 256 + lane * 4), (LAS unsigned*)(L + CD_E), 16, 0, 0);
    __builtin_amdgcn_global_load_lds((const unsigned*)(fp + wave * 256 + lane * 4), (LAS unsigned*)(L + CD_F), 16, 0, 0);
    if (trow != nullptr && wave < 4) __builtin_amdgcn_global_load_lds((const unsigned*)(trow + wave * 512 + lane * 8), (LAS unsigned*)(L + CD_T), 16, 0, 0);
    if (xr != nullptr) __builtin_amdgcn_global_load_lds((const unsigned*)(xr + wave * 256 + lane * 4), (LAS unsigned*)(L + CD_X), 16, 0, 0);
    else if (wave >= 4) __builtin_amdgcn_global_load_lds((const unsigned*)(xr16 + (wave - 4) * 512 + lane * 8), (LAS unsigned*)(L - 4096 + CD_X), 16, 0, 0);
}
__device__ __forceinline__ int mod_row_of(int row) { return row < MP ? (row >> 11) : 4 + ((row - MP) >> 4); }

constexpr int AK_PITCH = 144, AV_PITCH = 80, AK_BYTES = 32 * AK_PITCH  , AV_BYTES = 64 * AV_PITCH  , ATBL_BYTES = 1088;
struct AttnWave { bool active; bool wr; const bf16* qrow; bf16* orow; int qpos; float m0, l0; };
#define MFMA32(a, b, c) __builtin_amdgcn_mfma_f32_32x32x16_bf16((a), (b), (c), 0, 0, 0)
#define MFMA16(a, b, c) __builtin_amdgcn_mfma_f32_16x16x32_bf16((a), (b), (c), 0, 0, 0)

template <int NTASK>
__device__ __forceinline__ void attn_stage_store(const v4u (&st)[NTASK], LAS unsigned char* kb, LAS unsigned char* vb, int gtid, int nthr) {
#pragma unroll
    for (int i = 0; i < NTASK; ++i) {
        const int task = gtid + nthr * i; const bool isV = task >= 256; const int idx = task & 255, key = idx >> 3, dc = idx & 7;
        if (!isV) { *(LAS v4u*)(kb + key * AK_PITCH + dc * 16) = st[i]; }
        else {
            LAS unsigned short* vp = (LAS unsigned short*)(vb + (dc * 8) * AV_PITCH + key * 2);
#pragma unroll
            for (int e = 0; e < 4; ++e) { const unsigned w = st[i][e]; vp[(2 * e) * (AV_PITCH / 2)] = (unsigned short)(w & 0xffffu); vp[(2 * e + 1) * (AV_PITCH / 2)] = (unsigned short)(w >> 16); }
        }
    }
}
template <bool SHARED, bool BIAS, bool MERGE, class Src, class Rel, bool ROT = false>
__device__ __forceinline__ void attn_run(LAS unsigned char* kbuf, LAS unsigned char* vbuf, const LAS float* tbl, int gtid, int tstart, int tstride, int ntiles, int kbase, int partial_tile,
                                         const Src& src, const Rel& rel, const AttnWave& W, LAS float* mg) {
    constexpr int NTHR = SHARED ? 512 : 64, NTASK = 512 / NTHR, NBUF = SHARED ? 2 : 1;
    const int lane = hw_lane(), r = lane & 31, h = lane >> 5;
    const int fr = (r & 0x13) | ((r & 4) << 1) | ((r & 8) >> 1);
    bf16x8 qf[4];
#pragma unroll
    for (int ks = 0; ks < 4; ++ks) qf[ks] = (bf16x8){0, 0, 0, 0, 0, 0, 0, 0};
    if (W.active) {
#pragma unroll
        for (int ks = 0; ks < 4; ++ks) qf[ks] = *(const bf16x8*)(W.qrow + ks * 16 + h * 8);
    }
    float m = W.m0, l = W.l0;
    f32x16 o0, o1;
#pragma unroll
    for (int i = 0; i < 16; ++i) { o0[i] = 0.f; o1[i] = 0.f; }
    if constexpr (SHARED && ROT) {
        const int idx0 = gtid & 255; const bool isV0 = gtid >= 256;
        v4u rA = src(tstart, isV0, idx0 >> 3, idx0 & 7);
        v4u rB = src(tstart + ((1 < ntiles) ? 1 : (ntiles - 1)) * tstride, isV0, idx0 >> 3, idx0 & 7);
        v4u rC = src(tstart + ((2 < ntiles) ? 2 : (ntiles - 1)) * tstride, isV0, idx0 >> 3, idx0 & 7);
        { const v4u one_[1] = {rA}; attn_stage_store<1>(one_, kbuf, vbuf, gtid, NTHR); }
        __syncthreads();
#pragma unroll 1
        for (int k0 = 0; k0 < ntiles; k0 += 3) {
            { const int k = k0; const int t = tstart + k * tstride;
              { const int kc = (k + 3 < ntiles) ? (k + 3) : (ntiles - 1); const int idx = gtid & 255; rA = src(tstart + kc * tstride, gtid >= 256, idx >> 3, idx & 7); }
              if (k < ntiles) {
                if (W.active && rel(t)) {
                    const LAS unsigned char* kb = kbuf + (NBUF == 2 ? (k & 1) * AK_BYTES : 0);
                    const LAS unsigned char* vb = vbuf + (NBUF == 2 ? (k & 1) * AV_BYTES : 0);
                    f32x16 x;
#pragma unroll
                    for (int i = 0; i < 16; ++i) x[i] = 0.f;
#pragma unroll
                    for (int ks = 0; ks < 4; ++ks) { const bf16x8 kf = *(const LAS bf16x8*)(kb + fr * AK_PITCH + ks * 32 + h * 16); x = MFMA32(kf, qf[ks], x); }
                    float tt[16];
                    const float c = 0.125f * LOG2E;
                    if (BIAS) {
                        const int dbase = W.qpos - (kbase + 32 * t) - 8 * h;
                        const int dmin = __builtin_amdgcn_readfirstlane(W.qpos - (int)(hw_lane() & 31)) - (kbase + 32 * t) - 31;
                        if (dmin >= 128) {
                            const float bfar = tbl[256];
#pragma unroll
                            for (int i = 0; i < 16; ++i) tt[i] = x[i] * c + bfar;
                        } else {
#pragma unroll
                            for (int i = 0; i < 16; ++i) { int d = dbase - ((i & 7) + 16 * (i >> 3)); d = d < -128 ? -128 : (d > 128 ? 128 : d); tt[i] = x[i] * c + tbl[d + 128]; }
                        }
                    } else {
#pragma unroll
                        for (int i = 0; i < 16; ++i) tt[i] = x[i] * c;
                    }
                    if (t == partial_tile) {
#pragma unroll
                        for (int i = 8; i < 16; ++i) tt[i] = -1e30f;
                    }
                    float mt = tt[0];
#pragma unroll
                    for (int i = 1; i < 16; ++i) mt = fmaxf(mt, tt[i]);
                    mt = fmaxf(mt, __shfl_xor(mt, 32));
                    if (__any(mt > m + 6.0f)) {
                        const float mn = fmaxf(m, mt); const float alpha = fexp2(m - mn); m = mn;
                        l *= alpha;
#pragma unroll
                        for (int i = 0; i < 16; ++i) { o0[i] *= alpha; o1[i] *= alpha; }
                    }
                    float ps = 0.f;
#pragma unroll
                    for (int i = 0; i < 16; ++i) { tt[i] = fexp2(tt[i] - m); ps += tt[i]; }
                    l += ps;
#pragma unroll
                    for (int s = 0; s < 2; ++s) {
                        v4u pw; pw.x = pkbf(tt[8 * s], tt[8 * s + 1]); pw.y = pkbf(tt[8 * s + 2], tt[8 * s + 3]); pw.z = pkbf(tt[8 * s + 4], tt[8 * s + 5]); pw.w = pkbf(tt[8 * s + 6], tt[8 * s + 7]);
                        const bf16x8 pf = __builtin_bit_cast(bf16x8, pw);
                        const bf16x8 v0 = *(const LAS bf16x8*)(vb + r * AV_PITCH + s * 32 + h * 16);
                        const bf16x8 v1 = *(const LAS bf16x8*)(vb + (r + 32) * AV_PITCH + s * 32 + h * 16);
                        o0 = MFMA32(v0, pf, o0); o1 = MFMA32(v1, pf, o1);
                    }
                }
              }
              if (k + 1 < ntiles) { const v4u one_[1] = {rB}; attn_stage_store<1>(one_, kbuf + ((k + 1) & 1) * AK_BYTES, vbuf + ((k + 1) & 1) * AV_BYTES, gtid, NTHR); }
              __syncthreads(); }
            { const int k = k0 + 1; const int t = tstart + k * tstride;
              { const int kc = (k + 3 < ntiles) ? (k + 3) : (ntiles - 1); const int idx = gtid & 255; rB = src(tstart + kc * tstride, gtid >= 256, idx >> 3, idx & 7); }
              if (k < ntiles) {
                if (W.active && rel(t)) {
                    const LAS unsigned char* kb = kbuf + (NBUF == 2 ? (k & 1) * AK_BYTES : 0);
                    const LAS unsigned char* vb = vbuf + (NBUF == 2 ? (k & 1) * AV_BYTES : 0);
                    f32x16 x;
#pragma unroll
                    for (int i = 0; i < 16; ++i) x[i] = 0.f;
#pragma unroll
                    for (int ks = 0; ks < 4; ++ks) { const bf16x8 kf = *(const LAS bf16x8*)(kb + fr * AK_PITCH + ks * 32 + h * 16); x = MFMA32(kf, qf[ks], x); }
                    float tt[16];
                    const float c = 0.125f * LOG2E;
                    if (BIAS) {
                        const int dbase = W.qpos - (kbase + 32 * t) - 8 * h;
                        const int dmin = __builtin_amdgcn_readfirstlane(W.qpos - (int)(hw_lane() & 31)) - (kbase + 32 * t) - 31;
                        if (dmin >= 128) {
                            const float bfar = tbl[256];
#pragma unroll
                            for (int i = 0; i < 16; ++i) tt[i] = x[i] * c + bfar;
                        } else {
#pragma unroll
                            for (int i = 0; i < 16; ++i) { int d = dbase - ((i & 7) + 16 * (i >> 3)); d = d < -128 ? -128 : (d > 128 ? 128 : d); tt[i] = x[i] * c + tbl[d + 128]; }
                        }
                    } else {
#pragma unroll
                        for (int i = 0; i < 16; ++i) tt[i] = x[i] * c;
                    }
                    if (t == partial_tile) {
#pragma unroll
                        for (int i = 8; i < 16; ++i) tt[i] = -1e30f;
                    }
                    float mt = tt[0];
#pragma unroll
                    for (int i = 1; i < 16; ++i) mt = fmaxf(mt, tt[i]);
                    mt = fmaxf(mt, __shfl_xor(mt, 32));
                    if (__any(mt > m + 6.0f)) {
                        const float mn = fmaxf(m, mt); const float alpha = fexp2(m - mn); m = mn;
                        l *= alpha;
#pragma unroll
                        for (int i = 0; i < 16; ++i) { o0[i] *= alpha; o1[i] *= alpha; }
                    }
                    float ps = 0.f;
#pragma unroll
                    for (int i = 0; i < 16; ++i) { tt[i] = fexp2(tt[i] - m); ps += tt[i]; }
                    l += ps;
#pragma unroll
                    for (int s = 0; s < 2; ++s) {
                        v4u pw; pw.x = pkbf(tt[8 * s], tt[8 * s + 1]); pw.y = pkbf(tt[8 * s + 2], tt[8 * s + 3]); pw.z = pkbf(tt[8 * s + 4], tt[8 * s + 5]); pw.w = pkbf(tt[8 * s + 6], tt[8 * s + 7]);
                        const bf16x8 pf = __builtin_bit_cast(bf16x8, pw);
                        const bf16x8 v0 = *(const LAS bf16x8*)(vb + r * AV_PITCH + s * 32 + h * 16);
                        const bf16x8 v1 = *(const LAS bf16x8*)(vb + (r + 32) * AV_PITCH + s * 32 + h * 16);
                        o0 = MFMA32(v0, pf, o0); o1 = MFMA32(v1, pf, o1);
                    }
                }
              }
              if (k + 1 < ntiles) { const v4u one_[1] = {rC}; attn_stage_store<1>(one_, kbuf + ((k + 1) & 1) * AK_BYTES, vbuf + ((k + 1) & 1) * AV_BYTES, gtid, NTHR); }
              __syncthreads(); }
            { const int k = k0 + 2; const int t = tstart + k * tstride;
              { const int kc = (k + 3 < ntiles) ? (k + 3) : (ntiles - 1); const int idx = gtid & 255; rC = src(tstart + kc * tstride, gtid >= 256, idx >> 3, idx & 7); }
              if (k < ntiles) {
                if (W.active && rel(t)) {
                    const LAS unsigned char* kb = kbuf + (NBUF == 2 ? (k & 1) * AK_BYTES : 0);
                    const LAS unsigned char* vb = vbuf + (NBUF == 2 ? (k & 1) * AV_BYTES : 0);
                    f32x16 x;
#pragma unroll
                    for (int i = 0; i < 16; ++i) x[i] = 0.f;
#pragma unroll
                    for (int ks = 0; ks < 4; ++ks) { const bf16x8 kf = *(const LAS bf16x8*)(kb + fr * AK_PITCH + ks * 32 + h * 16); x = MFMA32(kf, qf[ks], x); }
                    float tt[16];
                    const float c = 0.125f * LOG2E;
                    if (BIAS) {
                        const int dbase = W.qpos - (kbase + 32 * t) - 8 * h;
                        const int dmin = __builtin_amdgcn_readfirstlane(W.qpos - (int)(hw_lane() & 31)) - (kbase + 32 * t) - 31;
                        if (dmin >= 128) {
                            const float bfar = tbl[256];
#pragma unroll
                            for (int i = 0; i < 16; ++i) tt[i] = x[i] * c + bfar;
                        } else {
#pragma unroll
                            for (int i = 0; i < 16; ++i) { int d = dbase - ((i & 7) + 16 * (i >> 3)); d = d < -128 ? -128 : (d > 128 ? 128 : d); tt[i] = x[i] * c + tbl[d + 128]; }
                        }
                    } else {
#pragma unroll
                        for (int i = 0; i < 16; ++i) tt[i] = x[i] * c;
                    }
                    if (t == partial_tile) {
#pragma unroll
                        for (int i = 8; i < 16; ++i) tt[i] = -1e30f;
                    }
                    float mt = tt[0];
#pragma unroll
                    for (int i = 1; i < 16; ++i) mt = fmaxf(mt, tt[i]);
                    mt = fmaxf(mt, __shfl_xor(mt, 32));
                    if (__any(mt > m + 6.0f)) {
                        const float mn = fmaxf(m, mt); const float alpha = fexp2(m - mn); m = mn;
                        l *= alpha;
#pragma unroll
                        for (int i = 0; i < 16; ++i) { o0[i] *= alpha; o1[i] *= alpha; }
                    }
                    float ps = 0.f;
#pragma unroll
                    for (int i = 0; i < 16; ++i) { tt[i] = fexp2(tt[i] - m); ps += tt[i]; }
                    l += ps;
#pragma unroll
                    for (int s = 0; s < 2; ++s) {
                        v4u pw; pw.x = pkbf(tt[8 * s], tt[8 * s + 1]); pw.y = pkbf(tt[8 * s + 2], tt[8 * s + 3]); pw.z = pkbf(tt[8 * s + 4], tt[8 * s + 5]); pw.w = pkbf(tt[8 * s + 6], tt[8 * s + 7]);
                        const bf16x8 pf = __builtin_bit_cast(bf16x8, pw);
                        const bf16x8 v0 = *(const LAS bf16x8*)(vb + r * AV_PITCH + s * 32 + h * 16);
                        const bf16x8 v1 = *(const LAS bf16x8*)(vb + (r + 32) * AV_PITCH + s * 32 + h * 16);
                        o0 = MFMA32(v0, pf, o0); o1 = MFMA32(v1, pf, o1);
                    }
                }
              }
              if (k + 1 < ntiles) { const v4u one_[1] = {rA}; attn_stage_store<1>(one_, kbuf + ((k + 1) & 1) * AK_BYTES, vbuf + ((k + 1) & 1) * AV_BYTES, gtid, NTHR); }
              __syncthreads(); }
        }
    } else {
    v4u st[NTASK], st2[NTASK], st3[NTASK];
#pragma unroll
    for (int i = 0; i < NTASK; ++i) { const int task = gtid + NTHR * i; const int idx = task & 255; st[i] = src(tstart, task >= 256, idx >> 3, idx & 7);
        if (SHARED) { st2[i] = (1 < ntiles) ? src(tstart + tstride, task >= 256, idx >> 3, idx & 7) : st[i]; st3[i] = (2 < ntiles) ? src(tstart + 2 * tstride, task >= 256, idx >> 3, idx & 7) : st[i]; } }
    attn_stage_store<NTASK>(st, kbuf, vbuf, gtid, NTHR);
    if (SHARED) {
#pragma unroll
        for (int i = 0; i < NTASK; ++i) { st[i] = st2[i]; st2[i] = st3[i]; }
        __syncthreads();
    }
    for (int k = 0; k < ntiles; ++k) {
        const int t = tstart + k * tstride;
        const bool more = (k + 1 < ntiles);
        if (SHARED) {
            if (k + 3 < ntiles) {
#pragma unroll
                for (int i = 0; i < NTASK; ++i) { const int task = gtid + NTHR * i; const int idx = task & 255; st3[i] = src(t + 3 * tstride, task >= 256, idx >> 3, idx & 7); }
            }
        } else if (more) {
#pragma unroll
            for (int i = 0; i < NTASK; ++i) { const int task = gtid + NTHR * i; const int idx = task & 255; st[i] = src(t + tstride, task >= 256, idx >> 3, idx & 7); }
        }
        if (W.active && rel(t)) {
            const LAS unsigned char* kb = kbuf + (NBUF == 2 ? (k & 1) * AK_BYTES : 0);
            const LAS unsigned char* vb = vbuf + (NBUF == 2 ? (k & 1) * AV_BYTES : 0);
            f32x16 x;
#pragma unroll
            for (int i = 0; i < 16; ++i) x[i] = 0.f;
#pragma unroll
            for (int ks = 0; ks < 4; ++ks) { const bf16x8 kf = *(const LAS bf16x8*)(kb + fr * AK_PITCH + ks * 32 + h * 16); x = MFMA32(kf, qf[ks], x); }
            float tt[16];
            const float c = 0.125f * LOG2E;
            if (BIAS) {
                const int dbase = W.qpos - (kbase + 32 * t) - 8 * h;
                const int dmin = __builtin_amdgcn_readfirstlane(W.qpos - (int)(hw_lane() & 31)) - (kbase + 32 * t) - 31;
                if (dmin >= 128) {
                    const float bfar = tbl[256];
#pragma unroll
                    for (int i = 0; i < 16; ++i) tt[i] = x[i] * c + bfar;
                } else {
#pragma unroll
                    for (int i = 0; i < 16; ++i) { int d = dbase - ((i & 7) + 16 * (i >> 3)); d = d < -128 ? -128 : (d > 128 ? 128 : d); tt[i] = x[i] * c + tbl[d + 128]; }
                }
            } else {
#pragma unroll
                for (int i = 0; i < 16; ++i) tt[i] = x[i] * c;
            }
            if (t == partial_tile) {
#pragma unroll
                for (int i = 8; i < 16; ++i) tt[i] = -1e30f;
            }
            float mt = tt[0];
#pragma unroll
            for (int i = 1; i < 16; ++i) mt = fmaxf(mt, tt[i]);
            mt = fmaxf(mt, __shfl_xor(mt, 32));
            if (__any(mt > m + 6.0f)) {
                const float mn = fmaxf(m, mt); const float alpha = fexp2(m - mn); m = mn;
                l *= alpha;
#pragma unroll
                for (int i = 0; i < 16; ++i) { o0[i] *= alpha; o1[i] *= alpha; }
            }
            float ps = 0.f;
#pragma unroll
            for (int i = 0; i < 16; ++i) { tt[i] = fexp2(tt[i] - m); ps += tt[i]; }
            l += ps;
#pragma unroll
            for (int s = 0; s < 2; ++s) {
                v4u pw; pw.x = pkbf(tt[8 * s], tt[8 * s + 1]); pw.y = pkbf(tt[8 * s + 2], tt[8 * s + 3]); pw.z = pkbf(tt[8 * s + 4], tt[8 * s + 5]); pw.w = pkbf(tt[8 * s + 6], tt[8 * s + 7]);
                const bf16x8 pf = __builtin_bit_cast(bf16x8, pw);
                const bf16x8 v0 = *(const LAS bf16x8*)(vb + r * AV_PITCH + s * 32 + h * 16);
                const bf16x8 v1 = *(const LAS bf16x8*)(vb + (r + 32) * AV_PITCH + s * 32 + h * 16);
                o0 = MFMA32(v0, pf, o0); o1 = MFMA32(v1, pf, o1);
            }
        }
        if (more) attn_stage_store<NTASK>(st, kbuf + (NBUF == 2 ? ((k + 1) & 1) * AK_BYTES : 0), vbuf + (NBUF == 2 ? ((k + 1) & 1) * AV_BYTES : 0), gtid, NTHR);
        if (SHARED) {
#pragma unroll
            for (int i = 0; i < NTASK; ++i) { st[i] = st2[i]; st2[i] = st3[i]; }
            __syncthreads();
        }
    }
    }
    if (MERGE) {
        const float lt = l + __shfl_xor(l, 32);
        if (h == 0) { mg[r] = m; mg[32 + r] = lt; }
#pragma unroll
        for (int i = 0; i < 16; ++i) { const int d = (i & 3) + 8 * (i >> 2) + 4 * h; mg[64 + d * 32 + r] = o0[i]; mg[64 + (d + 32) * 32 + r] = o1[i]; }
    } else if (W.active) {
        const float lt = l + __shfl_xor(l, 32); const float inv = 1.0f / lt;
        if (W.wr) {
#pragma unroll
            for (int g = 0; g < 4; ++g) {
                u32x2 w0; w0.x = pkbf(o0[4 * g] * inv, o0[4 * g + 1] * inv); w0.y = pkbf(o0[4 * g + 2] * inv, o0[4 * g + 3] * inv);
                u32x2 w1; w1.x = pkbf(o1[4 * g] * inv, o1[4 * g + 1] * inv); w1.y = pkbf(o1[4 * g + 2] * inv, o1[4 * g + 3] * inv);
                *(u32x2*)(W.orow + 8 * g + 4 * h) = w0; *(u32x2*)(W.orow + 32 + 8 * g + 4 * h) = w1;
            }
        }
    }
}
struct RelAll { __device__ __forceinline__ bool operator()(int) const { return true; } };
struct RelBandP { int lo, hi; __device__ __forceinline__ bool operator()(int t) const { return t >= lo && t <= hi; } };
struct SrcZ { const bf16* zb; int kpos_first, kcol, vcol;
    __device__ __forceinline__ v4u operator()(int t, bool isV, int key, int dc) const { const int col = kcol + (isV ? (vcol - kcol) : 0); return *(const v4u*)(zb + (size_t)(kpos_first + 32 * t + key) * DIN + col + dc * 8); } };
struct SrcCache { const float* ck; const float* cv; int hstride  ; int ncache; const bf16* znew; int kcol, vcol;
    __device__ __forceinline__ v4u operator()(int t, bool isV, int key, int dc) const {
        const long vd = isV ? (long)(cv - ck) : 0l; const int col = kcol + (isV ? (vcol - kcol) : 0);
        if (t < ncache) { const float* p = ck + vd + (size_t)(32 * t + key) * hstride + dc * 8; const f32x4 a = *(const f32x4*)p, b = *(const f32x4*)(p + 4); return pack8(a, b); }
        if (key < 16) return *(const v4u*)(znew + (size_t)key * DIN + col + dc * 8);
        return (v4u){0u, 0u, 0u, 0u}; } };

template <int NTMAX, class Src>
__device__ __forceinline__ void attn_run_all(LAS unsigned char* kbuf, LAS unsigned char* vbuf, int tid, int ntiles, const Src& src, const AttnWave& W) {
    const int lane = hw_lane(), r = lane & 31, h = lane >> 5;
    const int fr = (r & 0x13) | ((r & 4) << 1) | ((r & 8) >> 1);
    bf16x8 qf[4];
#pragma unroll
    for (int ks = 0; ks < 4; ++ks) qf[ks] = *(const bf16x8*)(W.qrow + ks * 16 + h * 8);
    { const int idx = tid & 255; const bool isV = tid >= 256;
      v4u st[NTMAX];
#pragma unroll
      for (int k = 0; k < NTMAX; ++k) if (k < ntiles) st[k] = src(k, isV, idx >> 3, idx & 7);
#pragma unroll
      for (int k = 0; k < NTMAX; ++k) if (k < ntiles) { const v4u one[1] = {st[k]}; attn_stage_store<1>(one, kbuf + k * AK_BYTES, vbuf + k * AV_BYTES, tid, 512); } }
    __syncthreads();
    float m = W.m0, l = W.l0;
    f32x16 o0, o1;
#pragma unroll
    for (int i = 0; i < 16; ++i) { o0[i] = 0.f; o1[i] = 0.f; }
#pragma unroll 1
    for (int k = 0; k < ntiles; ++k) {
        const LAS unsigned char* kb = kbuf + k * AK_BYTES;
        const LAS unsigned char* vb = vbuf + k * AV_BYTES;
        f32x16 x;
#pragma unroll
        for (int i = 0; i < 16; ++i) x[i] = 0.f;
#pragma unroll
        for (int ks = 0; ks < 4; ++ks) { const bf16x8 kf = *(const LAS bf16x8*)(kb + fr * AK_PITCH + ks * 32 + h * 16); x = MFMA32(kf, qf[ks], x); }
        float tt[16];
        const float c = 0.125f * LOG2E;
#pragma unroll
        for (int i = 0; i < 16; ++i) tt[i] = x[i] * c;
        float mt = tt[0];
#pragma unroll
        for (int i = 1; i < 16; ++i) mt = fmaxf(mt, tt[i]);
        mt = fmaxf(mt, __shfl_xor(mt, 32));
        if (__any(mt > m + 6.0f)) {
            const float mn = fmaxf(m, mt); const float alpha = fexp2(m - mn); m = mn;
            l *= alpha;
#pragma unroll
            for (int i = 0; i < 16; ++i) { o0[i] *= alpha; o1[i] *= alpha; }
        }
        float ps = 0.f;
#pragma unroll
        for (int i = 0; i < 16; ++i) { tt[i] = fexp2(tt[i] - m); ps += tt[i]; }
        l += ps;
#pragma unroll
        for (int s = 0; s < 2; ++s) {
            v4u pw; pw.x = pkbf(tt[8 * s], tt[8 * s + 1]); pw.y = pkbf(tt[8 * s + 2], tt[8 * s + 3]); pw.z = pkbf(tt[8 * s + 4], tt[8 * s + 5]); pw.w = pkbf(tt[8 * s + 6], tt[8 * s + 7]);
            const bf16x8 pf = __builtin_bit_cast(bf16x8, pw);
            const bf16x8 v0 = *(const LAS bf16x8*)(vb + r * AV_PITCH + s * 32 + h * 16);
            const bf16x8 v1 = *(const LAS bf16x8*)(vb + (r + 32) * AV_PITCH + s * 32 + h * 16);
            o0 = MFMA32(v0, pf, o0); o1 = MFMA32(v1, pf, o1);
        }
    }
    const float lt = l + __shfl_xor(l, 32); const float inv = 1.0f / lt;
#pragma unroll
    for (int g = 0; g < 4; ++g) {
        u32x2 w0; w0.x = pkbf(o0[4 * g] * inv, o0[4 * g + 1] * inv); w0.y = pkbf(o0[4 * g + 2] * inv, o0[4 * g + 3] * inv);
        u32x2 w1; w1.x = pkbf(o1[4 * g] * inv, o1[4 * g + 1] * inv); w1.y = pkbf(o1[4 * g + 2] * inv, o1[4 * g + 3] * inv);
        *(u32x2*)(W.orow + 8 * g + 4 * h) = w0; *(u32x2*)(W.orow + 32 + 8 * g + 4 * h) = w1;
    }
}

struct LruUnit {
    const bf16* zseq;
    const float* prefix;
    int n;
    int chn;
    float c8, cw0, cw1, cw2, cw3, cb, rb, ib;
    bf16x8 bfr[8], bfi[8];
};
__device__ __forceinline__ void lru_setup(LruUnit& U, int l, int n, int dq, const float* conv_w, const float* conv_b, const float* w_r, const float* b_r, const float* w_i, const float* b_i, const float* lam) {
    const int lane = hw_lane(), ch = lane & 15, kq = lane >> 4;
    U.n = n; U.chn = 64 * n + 16 * dq + ch;
    const float* Wr = w_r + ((size_t)(l * 16 + n) * 64) * 64 + 16 * dq + ch;
    const float* Wi = w_i + ((size_t)(l * 16 + n) * 64) * 64 + 16 * dq + ch;
    const float* cw = conv_w + (size_t)l * 4 * 1024 + 64 * n;
    const float* cbp = conv_b + (size_t)l * 1024 + 64 * n;
    float sr = 0.f, si = 0.f;
#pragma unroll
    for (int chalf = 0; chalf < 2; ++chalf) {
        float wr8[8], wi8[8];
#pragma unroll
        for (int jj = 0; jj < 8; ++jj) { const int c = 32 * chalf + 8 * kq + jj; wr8[jj] = Wr[c * 64]; wi8[jj] = Wi[c * 64]; const float cbv = cbp[c]; sr += cbv * wr8[jj]; si += cbv * wi8[jj]; }
#pragma unroll
        for (int j = 0; j < 4; ++j) {
            float t8[8];
#pragma unroll
            for (int jj = 0; jj < 8; ++jj) t8[jj] = cw[j * 1024 + 32 * chalf + 8 * kq + jj];
            v4u pr, pi;
#pragma unroll
            for (int e = 0; e < 4; ++e) { pr[e] = pkbf(t8[2 * e] * wr8[2 * e], t8[2 * e + 1] * wr8[2 * e + 1]); pi[e] = pkbf(t8[2 * e] * wi8[2 * e], t8[2 * e + 1] * wi8[2 * e + 1]); }
            U.bfr[j * 2 + chalf] = __builtin_bit_cast(bf16x8, pr); U.bfi[j * 2 + chalf] = __builtin_bit_cast(bf16x8, pi);
        }
    }
    sr += __shfl_xor(sr, 16); sr += __shfl_xor(sr, 32); si += __shfl_xor(si, 16); si += __shfl_xor(si, 32);
    U.rb = sr + b_r[(size_t)(l * 16 + n) * 64 + 16 * dq + ch]; U.ib = si + b_i[(size_t)(l * 16 + n) * 64 + 16 * dq + ch];
    const float lm = lam[(size_t)l * 1024 + U.chn];
    U.c8 = -8.0f * log1pf(expf(-lm));
    U.cw0 = conv_w[((size_t)l * 4 + 0) * 1024 + U.chn]; U.cw1 = conv_w[((size_t)l * 4 + 1) * 1024 + U.chn]; U.cw2 = conv_w[((size_t)l * 4 + 2) * 1024 + U.chn]; U.cw3 = conv_w[((size_t)l * 4 + 3) * 1024 + U.chn];
    U.cb = conv_b[(size_t)l * 1024 + U.chn];
}
__device__ __forceinline__ bf16x8 lru_ld8(const LruUnit& U, int trow, int c0) {
    v4u w;
    if (trow >= 0) w = *(const v4u*)(U.zseq + (size_t)trow * DIN + C_XB + 64 * U.n + c0);
    else if (U.prefix != nullptr) { const float* p = U.prefix + (trow + 3) * 1024 + 64 * U.n + c0; w = pack8(*(const f32x4*)p, *(const f32x4*)(p + 4)); }
    else w = (v4u){0u, 0u, 0u, 0u};
    return __builtin_bit_cast(bf16x8, w);
}
__device__ __forceinline__ float lru_xb(const LruUnit& U, int trow) {
    if (trow >= 0) return bf2f(U.zseq[(size_t)trow * DIN + C_XB + U.chn]);
    if (U.prefix != nullptr) return U.prefix[(trow + 3) * 1024 + U.chn];
    return 0.f;
}
__device__ __forceinline__ void lru_tile(const LruUnit& U, int t0, float& Ac, float& Hc, float (&P)[4], float (&hl)[4]) {
    const int lane = hw_lane(), tk = lane & 15, kq = lane >> 4, tq = kq;
    f32x4 ar = {U.rb, U.rb, U.rb, U.rb}, ai = {U.ib, U.ib, U.ib, U.ib};
#pragma unroll
    for (int j = 0; j < 4; ++j)
#pragma unroll
        for (int chalf = 0; chalf < 2; ++chalf) { const bf16x8 a = lru_ld8(U, t0 + tk - 3 + j, 32 * chalf + 8 * kq); ar = MFMA16(a, U.bfr[j * 2 + chalf], ar); ai = MFMA16(a, U.bfi[j * 2 + chalf], ai); }
    float xv[7];
#pragma unroll
    for (int e = 0; e < 7; ++e) xv[e] = lru_xb(U, t0 + 4 * tq - 3 + e);
    float a[4], u[4];
#pragma unroll
    for (int j = 0; j < 4; ++j) {
        const float xc = U.cb + U.cw0 * xv[j] + U.cw1 * xv[j + 1] + U.cw2 * xv[j + 2] + U.cw3 * xv[j + 3];
        const float rg = sigmoidf_fast(ar[j]), ig = sigmoidf_fast(ai[j]);
        const float la = U.c8 * rg;
        a[j] = fexp2(la * LOG2E);
        const float x2 = 2.0f * la;
        const float om = __builtin_fmaf(-a[j], a[j], 1.0f);
        u[j] = sqrtf(fmaxf(om, 0.f)) * (ig * xc);
    }
    P[0] = a[0]; hl[0] = u[0];
#pragma unroll
    for (int j = 1; j < 4; ++j) { P[j] = P[j - 1] * a[j]; hl[j] = a[j] * hl[j - 1] + u[j]; }
    float A = P[3], H = hl[3];
    { const float Ap = __shfl_up(A, 16), Hp = __shfl_up(H, 16); if (tq >= 1) { H = A * Hp + H; A = A * Ap; } }
    { const float Ap = __shfl_up(A, 32), Hp = __shfl_up(H, 32); if (tq >= 2) { H = A * Hp + H; A = A * Ap; } }
    float Aex = __shfl_up(A, 16), Hex = __shfl_up(H, 16); if (tq == 0) { Aex = 1.0f; Hex = 0.f; }
    const float At = __shfl(A, 48 + tk), Ht = __shfl(H, 48 + tk);
    const float Ae2 = Ac * Aex, He2 = Aex * Hc + Hex;
#pragma unroll
    for (int j = 0; j < 4; ++j) { hl[j] = P[j] * He2 + hl[j]; P[j] = Ae2 * P[j]; }
    Hc = At * Hc + Ht; Ac = Ac * At;
}
__device__ __forceinline__ void lru_setup_lds(LruUnit& U, LAS unsigned char* bl, LAS float* bsum, int wave, int l, int n, int dq, const float* conv_w, const float* conv_b, const float* w_r, const float* w_i, const float* lam) {
    const int lane = hw_lane(), ch = lane & 15, kq = lane >> 4;
    U.n = n; U.chn = 64 * n + 16 * dq + ch;
    const float* Wr = w_r + ((size_t)(l * 16 + n) * 64) * 64 + 16 * dq + ch;
    const float* Wi = w_i + ((size_t)(l * 16 + n) * 64) * 64 + 16 * dq + ch;
    const int j = wave >> 1, chalf = wave & 1;
    const float* cw = conv_w + ((size_t)l * 4 + j) * 1024 + 64 * n + 32 * chalf + 8 * kq;
    const float* cbp = conv_b + (size_t)l * 1024 + 64 * n + 32 * chalf + 8 * kq;
    float wr8[8], wi8[8], t8[8], cb8[8];
#pragma unroll
    for (int jj = 0; jj < 8; ++jj) { const int c = 32 * chalf + 8 * kq + jj; wr8[jj] = Wr[c * 64]; wi8[jj] = Wi[c * 64]; t8[jj] = cw[jj]; cb8[jj] = cbp[jj]; }
    v4u pr, pi;
#pragma unroll
    for (int e = 0; e < 4; ++e) { pr[e] = pkbf(t8[2 * e] * wr8[2 * e], t8[2 * e + 1] * wr8[2 * e + 1]); pi[e] = pkbf(t8[2 * e] * wi8[2 * e], t8[2 * e + 1] * wi8[2 * e + 1]); }
    *(LAS v4u*)(bl + wave * 1024 + lane * 16) = pr; *(LAS v4u*)(bl + (8 + wave) * 1024 + lane * 16) = pi;
    if (wave < 2) {
        float sr = 0.f, si = 0.f;
#pragma unroll
        for (int jj = 0; jj < 8; ++jj) { sr += cb8[jj] * wr8[jj]; si += cb8[jj] * wi8[jj]; }
        sr += __shfl_xor(sr, 16); sr += __shfl_xor(sr, 32); si += __shfl_xor(si, 16); si += __shfl_xor(si, 32);
        if (kq == 0) { bsum[(wave * 2 + 0) * 16 + ch] = sr; bsum[(wave * 2 + 1) * 16 + ch] = si; }
    }
    const float lm = lam[(size_t)l * 1024 + U.chn];
    U.c8 = -8.0f * log1pf(expf(-lm));
    U.cw0 = conv_w[((size_t)l * 4 + 0) * 1024 + U.chn]; U.cw1 = conv_w[((size_t)l * 4 + 1) * 1024 + U.chn]; U.cw2 = conv_w[((size_t)l * 4 + 2) * 1024 + U.chn]; U.cw3 = conv_w[((size_t)l * 4 + 3) * 1024 + U.chn];
    U.cb = conv_b[(size_t)l * 1024 + U.chn];
}
constexpr int LX_PITCH = 144, LX_ROWS = 515, LX_CHUNKS = LX_ROWS * 8, LX_EX_OFF = 75776, LX_BL_OFF = 77824, LX_BS_OFF = 94208, LX_GS_OFF = 94720  ;
__device__ __forceinline__ void lru_round_mfma(const LruUnit& U, const LAS unsigned char* slab, const LAS unsigned char* bl, int wtok, f32x4 (&ar)[4], f32x4 (&ai)[4]) {
    const int lane = hw_lane(), tk = lane & 15, kq = lane >> 4;
#pragma unroll
    for (int i = 0; i < 4; ++i) { ar[i] = (f32x4){U.rb, U.rb, U.rb, U.rb}; ai[i] = (f32x4){U.ib, U.ib, U.ib, U.ib}; }
#pragma unroll
    for (int j = 0; j < 4; ++j)
#pragma unroll
        for (int chalf = 0; chalf < 2; ++chalf) {
            const bf16x8 br = *(const LAS bf16x8*)(bl + (j * 2 + chalf) * 1024 + lane * 16), bi = *(const LAS bf16x8*)(bl + (8 + j * 2 + chalf) * 1024 + lane * 16);
#pragma unroll
            for (int i = 0; i < 4; ++i) { const bf16x8 a = *(const LAS bf16x8*)(slab + (wtok + 16 * i + tk + j) * LX_PITCH + (32 * chalf + 8 * kq) * 2); ar[i] = MFMA16(a, br, ar[i]); ai[i] = MFMA16(a, bi, ai[i]); }
        }
}
__device__ __forceinline__ void lru_tile_lds(const LruUnit& U, const LAS unsigned char* slab, const f32x4 ar, const f32x4 ai, int tloc, int dq, float& Ac, float& Hc, float (&P)[4], float (&hl)[4]) {
    const int lane = hw_lane(), tk = lane & 15, kq = lane >> 4, tq = kq;
    float xv[7];
#pragma unroll
    for (int e = 0; e < 7; ++e) xv[e] = bf2f(*(const LAS unsigned short*)(slab + (tloc + 4 * tq + e) * LX_PITCH + (16 * dq + tk) * 2));
    float a[4], u[4];
#pragma unroll
    for (int j = 0; j < 4; ++j) {
        const float xc = U.cb + U.cw0 * xv[j] + U.cw1 * xv[j + 1] + U.cw2 * xv[j + 2] + U.cw3 * xv[j + 3];
        const float rg = sigmoidf_fast(ar[j]), ig = sigmoidf_fast(ai[j]);
        const float la = U.c8 * rg;
        a[j] = fexp2(la * LOG2E);
        const float x2 = 2.0f * la;
        const float om = __builtin_fmaf(-a[j], a[j], 1.0f);
        u[j] = sqrtf(fmaxf(om, 0.f)) * (ig * xc);
    }
    P[0] = a[0]; hl[0] = u[0];
#pragma unroll
    for (int j = 1; j < 4; ++j) { P[j] = P[j - 1] * a[j]; hl[j] = a[j] * hl[j - 1] + u[j]; }
    float A = P[3], H = hl[3];
    { const float Ap = __shfl_up(A, 16), Hp = __shfl_up(H, 16); if (tq >= 1) { H = A * Hp + H; A = A * Ap; } }
    { const float Ap = __shfl_up(A, 32), Hp = __shfl_up(H, 32); if (tq >= 2) { H = A * Hp + H; A = A * Ap; } }
    float Aex = __shfl_up(A, 16), Hex = __shfl_up(H, 16); if (tq == 0) { Aex = 1.0f; Hex = 0.f; }
    const float At = __shfl(A, 48 + tk), Ht = __shfl(H, 48 + tk);
    const float Ae2 = Ac * Aex, He2 = Aex * Hc + Hex;
#pragma unroll
    for (int j = 0; j < 4; ++j) { hl[j] = P[j] * He2 + hl[j]; P[j] = Ae2 * P[j]; }
    Hc = At * Hc + Ht; Ac = Ac * At;
}
__device__ __forceinline__ void lru_round_lds(const LruUnit& U, const LAS unsigned char* slab, const LAS unsigned char* bl, int wtok, int dq, float& At, float& Ht, float (&P)[16], float (&hl)[16]) {
    const int lane = hw_lane(), tk = lane & 15, kq = lane >> 4, tq = kq;
    f32x4 ar[4], ai[4];
#pragma unroll
    for (int i = 0; i < 4; ++i) { ar[i] = (f32x4){U.rb, U.rb, U.rb, U.rb}; ai[i] = (f32x4){U.ib, U.ib, U.ib, U.ib}; }
    const LAS unsigned char* arow = slab + (wtok + 16 * (tk >> 2) + (tk & 3)) * LX_PITCH;
    const int cq0 = 16 * (kq ^ ((tk >> 2) & 3)), cq1 = 16 * (kq ^ (((tk >> 2) + 1) & 3));
#pragma unroll
    for (int j = 0; j < 4; ++j)
#pragma unroll
        for (int chalf = 0; chalf < 2; ++chalf) {
            const bf16x8 br = *(const LAS bf16x8*)(bl + (j * 2 + chalf) * 1024 + lane * 16), bi = *(const LAS bf16x8*)(bl + (8 + j * 2 + chalf) * 1024 + lane * 16);
#pragma unroll
            for (int i = 0; i < 4; ++i) { const int cq = (((tk & 3) + 4 * i + j) >> 4) ? cq1 : cq0;
                const bf16x8 a = *(const LAS bf16x8*)(arow + (4 * i + j) * LX_PITCH + chalf * 64 + cq); ar[i] = MFMA16(a, br, ar[i]); ai[i] = MFMA16(a, bi, ai[i]); }
        }
    float xv[19];
    { const LAS unsigned char* xp = slab + (wtok + 16 * tq) * LX_PITCH + (tk & 7) * 2; const int xc = 2 * dq + (tk >> 3), x0 = 16 * (xc ^ tq), x1 = 16 * (xc ^ ((tq + 1) & 3));
#pragma unroll
      for (int e = 0; e < 19; ++e) xv[e] = bf2f(*(const LAS unsigned short*)(xp + e * LX_PITCH + (e < 16 ? x0 : x1))); }
#pragma unroll
    for (int i = 0; i < 4; ++i)
#pragma unroll
        for (int r = 0; r < 4; ++r) { const int k = 4 * i + r;
            const float xc = U.cb + U.cw0 * xv[k] + U.cw1 * xv[k + 1] + U.cw2 * xv[k + 2] + U.cw3 * xv[k + 3];
            const float rg = sigmoidf_fast(ar[i][r]), ig = sigmoidf_fast(ai[i][r]);
            const float la = U.c8 * rg;
            const float a = fexp2(la * LOG2E);
            const float x2 = 2.0f * la;
            const float om = __builtin_fmaf(-a, a, 1.0f);
            const float u = __builtin_amdgcn_sqrtf(fmaxf(om, 0.f)) * (ig * xc);
            if (k == 0) { P[0] = a; hl[0] = u; } else { P[k] = P[k - 1] * a; hl[k] = a * hl[k - 1] + u; } }
    float A = P[15], H = hl[15];
    { const float Ap = __shfl_up(A, 16), Hp = __shfl_up(H, 16); if (tq >= 1) { H = A * Hp + H; A = A * Ap; } }
    { const float Ap = __shfl_up(A, 32), Hp = __shfl_up(H, 32); if (tq >= 2) { H = A * Hp + H; A = A * Ap; } }
    float Aex = __shfl_up(A, 16), Hex = __shfl_up(H, 16); if (tq == 0) { Aex = 1.0f; Hex = 0.f; }
    At = __shfl(A, 48 + tk); Ht = __shfl(H, 48 + tk);
#pragma unroll
    for (int k = 0; k < 16; ++k) { hl[k] = P[k] * Hex + hl[k]; P[k] = Aex * P[k]; }
}
__device__ __forceinline__ float gelu_tanh(float g) { const float y = 0.7978845608028654f * (g + 0.044715f * g * g * g); return g * sigmoidf_fast(2.0f * y); }


template <int ROWT, int NC, int UNR, class Epi, int ORDER = 0>
__device__ __forceinline__ void skinny_gemm(LAS unsigned char* lds, const bf16* A, int lda, const bf16* Wt, int K, int N, int Mrows, int tid, int bid, int G, const Epi& epi) {
    constexpr int CT = (NC + 15) / 16, PW = CT * 16, ROWS = ROWT * 16; const int RG = Mrows / ROWS;
    const int lane = tid & 63, wave = __builtin_amdgcn_readfirstlane(tid >> 6), r16 = lane & 15, kq = lane >> 4;
    LAS float* P = (LAS float*)lds;
    const int nunits = (N / NC) * RG;
    for (int unit0 = bid; unit0 < nunits * REP_S; unit0 += G) { const int unit = unit0 % nunits;
        const int rg = ORDER ? (unit0 % G) % RG : unit % RG, n0 = (ORDER ? ((unit0 % G) / RG) * 2 + (unit0 / G) : unit / RG) * NC, row0 = rg * ROWS, kw = K / 8, k0 = wave * kw;
        f32x4 acc[ROWT][CT];
#pragma unroll
        for (int rt = 0; rt < ROWT; ++rt)
#pragma unroll
            for (int ct = 0; ct < CT; ++ct) acc[rt][ct] = (f32x4){0.f, 0.f, 0.f, 0.f};
        const bf16* ap = A + (size_t)(row0 + r16) * lda + k0 + 8 * kq;
        const bf16* bp[CT];
#pragma unroll
        for (int ct = 0; ct < CT; ++ct) { int col = ct * 16 + r16; col = col < NC ? col : NC - 1; bp[ct] = Wt + (size_t)(n0 + col) * K + k0 + 8 * kq; }
#pragma unroll UNR
        for (int ks = 0; ks < kw / 32; ++ks) {
            bf16x8 a[ROWT], b[CT];
#pragma unroll
            for (int rt = 0; rt < ROWT; ++rt) a[rt] = *(const bf16x8*)(ap + (size_t)rt * 16 * lda + ks * 32);
#pragma unroll
            for (int ct = 0; ct < CT; ++ct) b[ct] = *(const bf16x8*)(bp[ct] + ks * 32);
#pragma unroll
            for (int rt = 0; rt < ROWT; ++rt)
#pragma unroll
                for (int ct = 0; ct < CT; ++ct) acc[rt][ct] = MFMA16(a[rt], b[ct], acc[rt][ct]);
        }
        __syncthreads();
#pragma unroll
        for (int rt = 0; rt < ROWT; ++rt)
#pragma unroll
            for (int ct = 0; ct < CT; ++ct)
#pragma unroll
                for (int e = 0; e < 4; ++e) P[(size_t)((wave * ROWS + rt * 16 + 4 * kq + e) * PW) + ct * 16 + r16] = acc[rt][ct][e];
        __syncthreads();
        for (int e = tid; e < ROWS * NC; e += 512) { const int row = e / NC, c = e % NC; float sum = 0.f;
#pragma unroll
            for (int w = 0; w < 8; ++w) sum += P[(w * ROWS + row) * PW + c];
            epi(row0 + row, n0 + c, sum); }
    }
    __syncthreads();
}
struct SkEpiBf16 { bf16* C; int ldc; __device__ __forceinline__ void operator()(int row, int col, float v) const { C[(size_t)row * ldc + col] = (bf16)f2bf(v); } };
struct SkEpiF32 { float* C; int ldc; __device__ __forceinline__ void operator()(int row, int col, float v) const { C[(size_t)row * ldc + col] = v; } };
struct SkEpiRelu2 { bf16* C; int ldc; __device__ __forceinline__ void operator()(int row, int col, float v) const { const float r = fmaxf(v, 0.f); C[(size_t)row * ldc + col] = (bf16)f2bf(r * r); } };
struct SkEpiT16 { bf16* Z; float* out; int L;
    __device__ __forceinline__ void operator()(int row, int col, float v) const {
        Z[(size_t)row * DIN + 4096 + col] = (bf16)f2bf(v);
        const int b = row >> 11, t = row & 2047;
        if (t >= 1536) out[pg8::O_BVP + ((size_t)(L * 4 + b) * 512 + (t - 1536)) * 512 + 256 + col] = v;
    } };
struct SkEpiInProj { bf16* Zs; float* out; int L;
    __device__ __forceinline__ void operator()(int row, int col, float v) const {
        Zs[(size_t)row * DIN + col] = (bf16)f2bf(v);
        const int bs = row >> 4, t = row & 15;
        if (col >= C_KA && col < C_XB) { const bool isV = col >= C_VA; const int c = col - (isV ? C_VA : C_KA); out[(isV ? pg8::O_SVS : pg8::O_SKS) + ((size_t)(L * 8 + bs) * 16 + t) * 128 + c] = v; }
        else if (col >= C_XB && col < C_GB) { if (t >= 13) out[pg8::O_LCS + ((size_t)(L * 8 + bs) * 3 + (t - 13)) * 1024 + (col - C_XB)] = v; }
        else if (col >= C_KC) { const bool isV = col >= C_VC; const int c = col - (isV ? C_VC : C_KC); out[(isV ? pg8::O_BVS : pg8::O_BKS) + ((size_t)(L * 8 + bs) * 16 + t) * 512 + c] = v; }
    } };


template <int TR, int TC, int WR, int WC, int KS, int PF, class Epi>
__device__ __forceinline__ void mini_gemm(LAS unsigned char* lds, const bf16* A, int lda, int Mrows, const bf16* Wt, int N, int K, int tid, int bid, int G, const Epi& epi) {
    constexpr int KC = 256, PITCH = 528, NP = (TR + TC) * 32 / 512, MT = TR / WR / 16, NT = TC / WC / 16, KSTEPS = 8 / KS;
    static_assert(WR * WC * KS == 8 && (TR + TC) * 32 % 512 == 0 && MT >= 1 && NT >= 1, "mini_gemm geometry");
    const int lane = tid & 63, wave = __builtin_amdgcn_readfirstlane(tid >> 6), r16 = lane & 15, kq = lane >> 4;
    const int wk = wave / (WR * WC), wrc = wave % (WR * WC), wr = wrc / WC, wc = wrc % WC;
    LAS unsigned char* As = lds; LAS unsigned char* Bs = lds + TR * PITCH;
    const int RG = Mrows / TR, nunits = RG * (N / TC), nch = K / KC;
    for (int unit = bid; unit < nunits; unit += G) {
        const int rg = unit % RG, row0 = rg * TR, n0 = (unit / RG) * TC;
        const bf16* src[NP]; int dst[NP];
#pragma unroll
        for (int i = 0; i < NP; ++i) { const int p = tid + 512 * i, r = p >> 5, c = p & 31;
            src[i] = (r < TR) ? A + (size_t)(row0 + r) * lda + c * 8 : Wt + (size_t)(n0 + r - TR) * K + c * 8; dst[i] = r * PITCH + c * 16; }
        f32x4 acc[MT][NT];
#pragma unroll
        for (int m = 0; m < MT; ++m)
#pragma unroll
            for (int n = 0; n < NT; ++n) acc[m][n] = (f32x4){0.f, 0.f, 0.f, 0.f};
        v4u st[PF][NP];
#pragma unroll
        for (int d = 0; d < PF; ++d)
#pragma unroll
            for (int i = 0; i < NP; ++i) st[d][i] = *(const v4u*)(src[i] + (size_t)(d < nch ? d : 0) * KC);
        for (int ch = 0; ch < nch; ch += PF) {
#pragma unroll
            for (int d = 0; d < PF; ++d) {
                __syncthreads();
#pragma unroll
                for (int i = 0; i < NP; ++i) *(LAS v4u*)(lds + dst[i]) = st[d][i];
                if (ch + d + PF < nch) {
#pragma unroll
                    for (int i = 0; i < NP; ++i) st[d][i] = *(const v4u*)(src[i] + (size_t)(ch + d + PF) * KC);
                }
                __syncthreads();
#pragma unroll
                for (int ks = 0; ks < KSTEPS; ++ks) { const int kb = ((wk * KSTEPS + ks) * 32 + 8 * kq) * 2;
                    bf16x8 a[MT], b[NT];
#pragma unroll
                    for (int m = 0; m < MT; ++m) a[m] = *(const LAS bf16x8*)(As + ((wr * MT + m) * 16 + r16) * PITCH + kb);
#pragma unroll
                    for (int n = 0; n < NT; ++n) b[n] = *(const LAS bf16x8*)(Bs + ((wc * NT + n) * 16 + r16) * PITCH + kb);
#pragma unroll
                    for (int m = 0; m < MT; ++m)
#pragma unroll
                        for (int n = 0; n < NT; ++n) acc[m][n] = MFMA16(a[m], b[n], acc[m][n]);
                }
            }
        }
        __syncthreads();
        if (KS > 1) {
            LAS f32x4* P = (LAS f32x4*)lds;
            if (wk > 0) {
#pragma unroll
                for (int m = 0; m < MT; ++m)
#pragma unroll
                    for (int n = 0; n < NT; ++n) P[(((wk - 1) * (WR * WC) + wrc) * (MT * NT) + m * NT + n) * 64 + lane] = acc[m][n];
            }
            __syncthreads();
            if (wk == 0) {
#pragma unroll
                for (int k2 = 1; k2 < KS; ++k2)
#pragma unroll
                    for (int m = 0; m < MT; ++m)
#pragma unroll
                        for (int n = 0; n < NT; ++n) acc[m][n] += P[(((k2 - 1) * (WR * WC) + wrc) * (MT * NT) + m * NT + n) * 64 + lane];
            }
        }
        if (wk == 0) {
#pragma unroll
            for (int m = 0; m < MT; ++m)
#pragma unroll
                for (int n = 0; n < NT; ++n)
#pragma unroll
                    for (int e = 0; e < 4; ++e) epi(row0 + (wr * MT + m) * 16 + 4 * kq + e, n0 + (wc * NT + n) * 16 + r16, acc[m][n][e]);
        }
    }
    __syncthreads();
}

constexpr int J_IN = (DM / P0_KH) * (DIN / 256), J_OUT = (DM / P0_KH) * (DM / 256), J_UP = (DM / P0_KH) * (DFF / 256), J_DN = (DFF / P0_KH) * (DM / 256), J_L = J_IN + J_OUT + J_UP + J_DN;
#ifndef BARWORK
#define BARWORK 1
#endif
template <class Work>
__device__ __forceinline__ void xcd_barrier_work(const XcdBarrier& b, bool t0, unsigned* queue, unsigned nitems, volatile LAS unsigned* slot, const Work& work) {
    asm volatile("s_waitcnt vmcnt(0)" ::: "memory");
    __syncthreads();
    bool leader = true; unsigned gen = 0u;
    if (t0) {
        unsigned* bar = b.bar;
        __builtin_amdgcn_s_waitcnt(0);
        unsigned nloc = b.st[0], nx = b.st[1];
        if (nloc == 0u) { xcd_barrier_complete(bar, b.x, nloc, nx); b.st[0] = nloc; b.st[1] = nx; }
        const unsigned old = xb_add(&bar[XB_XSUB(b.x)], 1u);
        gen = old / nloc;
        leader = (old + 1u == (gen + 1u) * nloc);
        if (leader) {
            __builtin_amdgcn_fence(__ATOMIC_RELEASE, "agent");
            asm volatile("s_waitcnt vmcnt(0)" ::: "memory");
            const unsigned og = xb_add(&bar[XB_TOP], 1u);
            const unsigned tg = og / nx;
            if (og + 1u == (tg + 1u) * nx) xb_add(&bar[XB_TOPGEN], 1u);
            else XB_SPIN(xb_ld(&bar[XB_TOPGEN]) == tg, bar);
            __builtin_amdgcn_fence(__ATOMIC_ACQUIRE, "agent");
            xb_add(&bar[XB_XGEN(b.x)], 1u);
            asm volatile("s_waitcnt vmcnt(0)" ::: "memory");
            slot[0] = 0xffffffffu;
        } else {
            slot[0] = (nitems != 0u) ? xb_add(queue, 1u) : 0xffffffffu;
        }
    }
    __syncthreads();
    const unsigned ticket = (unsigned)__builtin_amdgcn_readfirstlane((int)slot[0]);
    if (ticket < nitems) work((int)ticket);
    if (t0 && !leader) {
        unsigned* bar = b.bar;
        XB_SPIN(xb_ld(&bar[XB_XGEN(b.x)]) == gen, bar);
        __builtin_amdgcn_fence(__ATOMIC_ACQUIRE, "agent");
        asm volatile("s_waitcnt vmcnt(0)" ::: "memory");
    }
    __syncthreads();
}
struct Args { const float* in[29]; float* out; unsigned char* ws; int ph_lo, ph_hi; };
static_assert(sizeof(Args) == 31 * 8 + 8, "Args has no padding");
constexpr int N_PHASES = 2 + 7 * NL;


typedef const __attribute__((address_space(4))) Args* KArgs;
__device__ __forceinline__ KArgs kargs() { KArgs p = (KArgs)__builtin_amdgcn_kernarg_segment_ptr(); asm volatile("" : "+s"(p)); return p; }
#define TIDS() int tid_ = wave0 * 64 + hw_lane(); asm volatile("" : "+v"(tid_)); const int tid = tid_, lane = tid & 63, wave = __builtin_amdgcn_readfirstlane(tid >> 6); (void)tid; (void)lane; (void)wave
#define GWS() int G_ = gridDim.x, bid_ = blockIdx.x; asm volatile("" : "+s"(G_), "+s"(bid_)); const int G = G_, bid = bid_; const int vcu = (G % 8 == 0) ? (bid % 8) * (G / 8) + bid / 8 : bid; const int gw = vcu * NWAVES + wave, NGW = G * NWAVES; (void)gw; (void)NGW

__global__ void __launch_bounds__(NWAVES * 64, 2) mk_fwd(Args args) {
    extern __shared__ __attribute__((aligned(16))) unsigned char lds_raw[];
    LAS unsigned char* lds = (LAS unsigned char*)lds_raw;
    const int wave0 = __builtin_amdgcn_readfirstlane((int)threadIdx.x >> 6);
    { const int tid0 = threadIdx.x; for (int u = tid0; u < (LDS_BYTES - LDSCTL_OFF) / 4; u += NWAVES * 64) ((LAS unsigned*)(lds + LDSCTL_OFF))[u] = 0u; }
    __syncthreads();
    const int lo = args.ph_lo, hi = args.ph_hi;
    const bool use_bar = (hi - lo) > 1;
    XcdBarrier bar; bar.bar = (unsigned*)(args.ws + WS_CTL) + CW_BAR; bar.x = 0; bar.st = nullptr;
    if (use_bar) bar = xcd_barrier_post((unsigned*)(args.ws + WS_CTL) + CW_BAR, (volatile LAS unsigned*)(lds + MISC_OFF) + 8, threadIdx.x == 0);
#define IN(k) (lo <= (k) && (k) < hi)
    const bool defer = BARWORK && use_bar && lo == 0 && hi == N_PHASES;
    auto conv_item = [&](int lnext, int r) {
        KArgs KA = kargs(); unsigned char* ws = KA->ws; const int tid = wave0 * 64 + hw_lane();
        const float* W; int K, N; bf16* WT; int rr = r;
        if (rr < J_IN) { W = KA->in[13] + (size_t)lnext * DM * DIN; K = DM; N = DIN; WT = (bf16*)(ws + WS_WIN) + (size_t)lnext * DIN * DM; }
        else if ((rr -= J_IN) < J_OUT) { W = KA->in[23] + (size_t)lnext * DM * DM; K = DM; N = DM; WT = (bf16*)(ws + WS_WOUT) + (size_t)lnext * DM * DM; }
        else if ((rr -= J_OUT) < J_UP) { W = KA->in[26] + (size_t)lnext * DM * DFF; K = DM; N = DFF; WT = (bf16*)(ws + WS_WUP) + (size_t)lnext * DFF * DM; }
        else { rr -= J_UP; W = KA->in[27] + (size_t)lnext * DFF * DM; K = DFF; N = DM; WT = (bf16*)(ws + WS_WDN) + (size_t)lnext * DM * DFF; }
        f32x4 pre[P0_NI]; p0_tile_load(W, N, rr, tid, pre); p0_tile_store(pre, K, N, WT, lds, rr, tid);
        __syncthreads();
    };
    auto seam = [&](int k) {
        const bool t0 = (wave0 == 0 && hw_lane() == 0);
        const int L = (k < 2) ? 0 : (k - 2) / 7, lnext = L + 1;
        if (!defer || lnext >= NL) { xcd_barrier(bar, t0); return; }
        unsigned* queue = (unsigned*)(kargs()->ws + WS_CTL) + CW_DQ + 64 * lnext;
        volatile LAS unsigned* slot = (volatile LAS unsigned*)(lds + MISC_OFF) + 10;
        if (k >= 2 && (k - 2) % 7 == 6) {
            for (;;) {
                __syncthreads();
                if (t0) slot[0] = xb_add(queue, 1u);
                __syncthreads();
                const unsigned ticket = (unsigned)__builtin_amdgcn_readfirstlane((int)slot[0]);
                if (ticket >= (unsigned)J_L) break;
                conv_item(lnext, (int)ticket);
            }
            if (lnext + 1 < NL) { unsigned* q2 = queue + 64; const int l2 = lnext + 1;
                xcd_barrier_work(bar, t0, q2, (unsigned)J_L, slot, [&](int r) { conv_item(l2, r); }); }
            else xcd_barrier(bar, t0);
            return;
        }
        xcd_barrier_work(bar, t0, queue, (unsigned)J_L, slot, [&](int r) { conv_item(lnext, r); });
    };
#define SEAM(k) do { if (IN(k) && IN((k) + 1)) { seam(k); } } while (0)

    if (IN(0)) {
        KArgs KA = kargs(); unsigned char* ws = KA->ws; TIDS(); GWS();
#if P0_DYN
        unsigned* qctr = (unsigned*)(ws + WS_CTL) + CW_Q;
        volatile LAS unsigned* mq = (volatile LAS unsigned*)(lds + MISC_OFF) + 12;
        p0_mods<true>(qctr, mq, lds, KA->in[2], KA->in[3], KA->in[10], KA->in[11], KA->in[12], KA->in[24], KA->in[25], KA->in[28], (float*)(ws + WS_MOD), G, bid, tid);
#else
        p0_mods<false>(nullptr, nullptr, lds, KA->in[2], KA->in[3], KA->in[10], KA->in[11], KA->in[12], KA->in[24], KA->in[25], KA->in[28], (float*)(ws + WS_MOD), G, bid, tid);
#endif
        const float* w_in = KA->in[13]; const float* w_out = KA->in[23];
        bf16* WIN = (bf16*)(ws + WS_WIN); bf16* WOUT = (bf16*)(ws + WS_WOUT);
        LAS float* scr = (LAS float*)(lds + wave * 16384);
        constexpr int I_IN = (DM / 64) * (DIN / 32), I_OUT = (DM / 64) * (DM / 32), I_UP = (TAIL_MODE >= 1) ? 0 : (DM / 64) * (DFF / 32), I_DN = (TAIL_MODE >= 2) ? 0 : (DFF / 64) * (DM / 32), I_L = I_IN + I_OUT + I_UP + I_DN;
        const float* w_up = KA->in[26]; const float* w_down = KA->in[27]; bf16* WUP = (bf16*)(ws + WS_WUP); bf16* WDN = (bf16*)(ws + WS_WDN);
        {
        const int nfree = (G > MODS_ITEMS) ? (G - MODS_ITEMS) : 0, nslots = G + nfree;
        const int slot0 = (bid < MODS_ITEMS || nfree == 0) ? bid : MODS_ITEMS + (bid - MODS_ITEMS) * 2, nmine = (bid < MODS_ITEMS || nfree == 0) ? 1 : 2;
        const int NLIST = (BARWORK && (args.ph_hi - args.ph_lo) == N_PHASES) ? J_L : REP_P0 * NL * J_L;
        auto item_of = [&](int q) -> int { const int it = (q / nmine) * nslots + slot0 + (q % nmine); return it < NLIST ? it : -1; };
#if P0_DYN
#define P0_DECODE(it_, W_, K_, N_, WT_) do { const int l_ = ((it_) % (NL * J_L)) / J_L; int r_ = (it_) % J_L; \
            if (r_ < J_IN) { W_ = w_in + (size_t)l_ * DM * DIN; K_ = DM; N_ = DIN; WT_ = WIN + (size_t)l_ * DIN * DM; } \
            else if ((r_ -= J_IN) < J_OUT) { W_ = w_out + (size_t)l_ * DM * DM; K_ = DM; N_ = DM; WT_ = WOUT + (size_t)l_ * DM * DM; } \
            else if ((r_ -= J_OUT) < J_UP) { W_ = w_up + (size_t)l_ * DM * DFF; K_ = DM; N_ = DFF; WT_ = WUP + (size_t)l_ * DFF * DM; } \
            else { r_ -= J_UP; W_ = w_down + (size_t)l_ * DFF * DM; K_ = DFF; N_ = DM; WT_ = WDN + (size_t)l_ * DM * DFF; } \
            it_ = r_; } while (0)
        (void)item_of;
        constexpr int NIT = REP_P0 * NL * J_L;
        unsigned* qc = qctr + 64;
        unsigned nn = 0u;
        __syncthreads();
        if (tid == 0) { mq[0] = __hip_atomic_fetch_add(qc, 1u, __ATOMIC_RELAXED, __HIP_MEMORY_SCOPE_AGENT); mq[1] = __hip_atomic_fetch_add(qc, 1u, __ATOMIC_RELAXED, __HIP_MEMORY_SCOPE_AGENT);
                        nn = __hip_atomic_fetch_add(qc, 1u, __ATOMIC_RELAXED, __HIP_MEMORY_SCOPE_AGENT); }
        __syncthreads();
        int it = __builtin_amdgcn_readfirstlane((int)mq[0]), itn = __builtin_amdgcn_readfirstlane((int)mq[1]);
        f32x4 pre[8];
        const float* Wc = nullptr; int Kc = 0, Nc = 0; bf16* WTc = nullptr; int rc = it;
        if (it < NIT) { P0_DECODE(rc, Wc, Kc, Nc, WTc); p0_tile_load(Wc, Nc, rc, tid, pre); }
        while (it < NIT) {
            f32x4 cur[8];
#pragma unroll
            for (int i = 0; i < 8; ++i) cur[i] = pre[i];
            const float* Wn = nullptr; int Kn = 0, Nn = 0; bf16* WTn = nullptr; int rn = itn;
            if (itn < NIT) { P0_DECODE(rn, Wn, Kn, Nn, WTn); p0_tile_load(Wn, Nn, rn, tid, pre); }
            {
                LAS unsigned char* scr = lds;
                const int nblk = Nc / 256, kb = rc / nblk, nb = rc % nblk;
                __syncthreads();
#pragma unroll
                for (int i = 0; i < 8; ++i) { u32x2 w; w.x = pkbf(cur[i][0], cur[i][1]); w.y = pkbf(cur[i][2], cur[i][3]); *(LAS u32x2*)(scr + (8 * i + (tid >> 6)) * TP_PITCH + (tid & 63) * 8) = w; }
                if (tid == 0) { mq[0] = nn; nn = __hip_atomic_fetch_add(qc, 1u, __ATOMIC_RELAXED, __HIP_MEMORY_SCOPE_AGENT); }
                __syncthreads();
                const int kc = tid & 7;
#pragma unroll
                for (int j = 0; j < 4; ++j) { const int n = (tid >> 3) + 64 * j; const LAS unsigned char* sp = scr + (8 * kc) * TP_PITCH + n * 2;
                    unsigned short e[8];
#pragma unroll
                    for (int q = 0; q < 8; ++q) e[q] = *(const LAS unsigned short*)(sp + q * TP_PITCH);
                    v4u o; o.x = e[0] | ((unsigned)e[1] << 16); o.y = e[2] | ((unsigned)e[3] << 16); o.z = e[4] | ((unsigned)e[5] << 16); o.w = e[6] | ((unsigned)e[7] << 16);
                    *(GAS v4u*)(WTc + (size_t)(256 * nb + n) * Kc + 64 * kb + 8 * kc) = o; }
            }
            const int itnn = __builtin_amdgcn_readfirstlane((int)mq[0]);
            Wc = Wn; Kc = Kn; Nc = Nn; WTc = WTn; rc = rn; it = itn; itn = itnn;
        }
#elif P0_DEEP
#define P0_DECODE(it_, W_, K_, N_, WT_) do { const int l_ = ((it_) % (NL * J_L)) / J_L; int r_ = (it_) % J_L; \
            if (r_ < J_IN) { W_ = w_in + (size_t)l_ * DM * DIN; K_ = DM; N_ = DIN; WT_ = WIN + (size_t)l_ * DIN * DM; } \
            else if ((r_ -= J_IN) < J_OUT) { W_ = w_out + (size_t)l_ * DM * DM; K_ = DM; N_ = DM; WT_ = WOUT + (size_t)l_ * DM * DM; } \
            else if ((r_ -= J_OUT) < J_UP) { W_ = w_up + (size_t)l_ * DM * DFF; K_ = DM; N_ = DFF; WT_ = WUP + (size_t)l_ * DFF * DM; } \
            else { r_ -= J_UP; W_ = w_down + (size_t)l_ * DFF * DM; K_ = DFF; N_ = DM; WT_ = WDN + (size_t)l_ * DM * DFF; } \
            it_ = r_; } while (0)
        f32x4 pa[8], pb[8];
        int q = 0;
        int ita = item_of(0), itb = item_of(1);
        const float* Wa = nullptr; int Ka = 0, Na = 0; bf16* WTa = nullptr; int ra = ita;
        const float* Wb = nullptr; int Kb = 0, Nb = 0; bf16* WTb = nullptr; int rb = itb;
        if (ita >= 0) { P0_DECODE(ra, Wa, Ka, Na, WTa); p0_tile_load(Wa, Na, ra, tid, pa); }
        if (itb >= 0) { P0_DECODE(rb, Wb, Kb, Nb, WTb); p0_tile_load(Wb, Nb, rb, tid, pb); }
        while (ita >= 0) {
            { u32x2 w[8];
#pragma unroll
              for (int i = 0; i < 8; ++i) { w[i].x = pkbf(pa[i][0], pa[i][1]); w[i].y = pkbf(pa[i][2], pa[i][3]); }
              const int itn = item_of(q + 2); const float* Wn = nullptr; int Kn = 0, Nn = 0; bf16* WTn = nullptr; int rn = itn;
              if (itn >= 0) { P0_DECODE(rn, Wn, Kn, Nn, WTn); p0_tile_load(Wn, Nn, rn, tid, pa); }
              p0_tile_store_pk(w, Ka, Na, WTa, lds, ra, tid);
              Wa = Wn; Ka = Kn; Na = Nn; WTa = WTn; ra = rn; ita = itn; }
            if (itb < 0) break;
            { u32x2 w[8];
#pragma unroll
              for (int i = 0; i < 8; ++i) { w[i].x = pkbf(pb[i][0], pb[i][1]); w[i].y = pkbf(pb[i][2], pb[i][3]); }
              const int itn = item_of(q + 3); const float* Wn = nullptr; int Kn = 0, Nn = 0; bf16* WTn = nullptr; int rn = itn;
              if (itn >= 0) { P0_DECODE(rn, Wn, Kn, Nn, WTn); p0_tile_load(Wn, Nn, rn, tid, pb); }
              p0_tile_store_pk(w, Kb, Nb, WTb, lds, rb, tid);
              Wb = Wn; Kb = Kn; Nb = Nn; WTb = WTn; rb = rn; itb = itn; }
            q += 2;
        }
#else
        f32x4 pre[P0_NI];
        int q = 0, it = item_of(0);
#define P0_DECODE(it_, W_, K_, N_, WT_) do { const int l_ = ((it_) % (NL * J_L)) / J_L; int r_ = (it_) % J_L; \
            if (r_ < J_IN) { W_ = w_in + (size_t)l_ * DM * DIN; K_ = DM; N_ = DIN; WT_ = WIN + (size_t)l_ * DIN * DM; } \
            else if ((r_ -= J_IN) < J_OUT) { W_ = w_out + (size_t)l_ * DM * DM; K_ = DM; N_ = DM; WT_ = WOUT + (size_t)l_ * DM * DM; } \
            else if ((r_ -= J_OUT) < J_UP) { W_ = w_up + (size_t)l_ * DM * DFF; K_ = DM; N_ = DFF; WT_ = WUP + (size_t)l_ * DFF * DM; } \
            else { r_ -= J_UP; W_ = w_down + (size_t)l_ * DFF * DM; K_ = DFF; N_ = DM; WT_ = WDN + (size_t)l_ * DM * DFF; } \
            it_ = r_; } while (0)
        const float* Wc = nullptr; int Kc = 0, Nc = 0; bf16* WTc = nullptr; int rc = it;
        if (it >= 0) { P0_DECODE(rc, Wc, Kc, Nc, WTc); p0_tile_load(Wc, Nc, rc, tid, pre); }
        while (it >= 0) {
            const int itn = item_of(q + 1);
            f32x4 cur[P0_NI];
#pragma unroll
            for (int i = 0; i < P0_NI; ++i) cur[i] = pre[i];
            const float* Wn = nullptr; int Kn = 0, Nn = 0; bf16* WTn = nullptr; int rn = itn;
            if (itn >= 0) { P0_DECODE(rn, Wn, Kn, Nn, WTn); if (!(P0_PROBE == 2 && itn >= NL * J_L)) p0_tile_load(Wn, Nn, rn, tid, pre); }
            p0_tile_store(cur, Kc, Nc, WTc, lds, rc, tid, !(P0_PROBE == 1 && it >= NL * J_L));
            Wc = Wn; Kc = Kn; Nc = Nn; WTc = WTn; rc = rn; it = itn; ++q;
        }
#endif
#undef P0_DECODE
        }
    }
    SEAM(0);
    if (IN(1)) {
        KArgs KA = kargs(); unsigned char* ws = KA->ws; TIDS(); GWS();
        const float* x_p = KA->in[0]; const float* x_s = KA->in[1]; const float* g_pre_mix = KA->in[12];
        const float* MOD = (const float*)(ws + WS_MOD); bf16* Hb = (bf16*)(ws + WS_H); bf16* MIXb = (bf16*)(ws + WS_MIX);
        for (int row = MR + gw; row < MT; row += NGW) {
            u32x2* o = (u32x2*)(Hb + (size_t)row * DM) + lane; u32x2* o2 = (u32x2*)(MIXb + (size_t)row * DM) + lane;
#pragma unroll
            for (int j = 0; j < 8; ++j) { o[64 * j] = (u32x2){0u, 0u}; o2[64 * j] = (u32x2){0u, 0u}; }
        }
        for (int r4 = gw; r4 < MP / 4; r4 += NGW) {
            const float* md = MOD + ((size_t)0 * 12 + mod_row_of(4 * r4)) * NMOD;
            f32x4 ev[8], fv[8]; ROW_LD(ev, md + DM); ROW_LD(fv, md);
#pragma unroll 1
            for (int ri = 0; ri < 4; ++ri) {
                const int row = 4 * r4 + ri;
                f32x4 v[8]; ROW_LD(v, x_p + (size_t)row * DM);
                const float rstd = 1.0f / sqrtf(row_sumsq(v) * (1.0f / DM) + RMS_EPS);
                norm_store(v, rstd, ev, fv, Hb + (size_t)row * DM, lane);
            }
        }
        for (int sr = bid; sr < MS; sr += G) {
            __syncthreads();
            const int row = MP + sr; const float* md = MOD + ((size_t)0 * 12 + mod_row_of(row)) * NMOD;
            coop_row(nullptr, x_s + (size_t)sr * DM, nullptr, nullptr, md + DM, md, nullptr, nullptr, Hb + (size_t)row * DM, (LAS float*)lds, tid);
        }
    }
    SEAM(1);

    for (int l = 0; l < NL; ++l) {
        const int pb = 2 + 7 * l;
        if (IN(pb + 0)) {
            { KArgs KA = kargs(); unsigned char* ws = KA->ws;
              pg8::Gemm g{(const bf16*)(ws + WS_H), (const bf16*)(ws + WS_WIN) + (size_t)l * DIN * DM, MP, 4096, DM}; pg8::StaticOrder S; { int G_ = gridDim.x, bid_ = blockIdx.x; asm volatile("" : "+s"(G_), "+s"(bid_)); S.init(MP, 4096, G_, bid_, REP_A); }
              pg8::EpiInProj E{(bf16*)(ws + WS_Z), KA->out, l};
              pg8::gemm_phase<pg8::EpiInProj, pg8::StaticOrder, true, true>(lds, g, S, E, wave0 * 64 + hw_lane()); }
            { KArgs KA = kargs(); unsigned char* ws = KA->ws; TIDS(); GWS();
              SkEpiT16 SE{(bf16*)(ws + WS_Z), KA->out, l};
              mini_gemm<64, 128, 1, 4, 2, 2, SkEpiT16>(lds, (const bf16*)(ws + WS_H), DM, MP, (const bf16*)(ws + WS_WIN) + (size_t)l * DIN * DM + (size_t)4096 * DM, 256, DM, tid, bid, G, SE); }
            { KArgs KA = kargs(); unsigned char* ws = KA->ws; TIDS(); GWS();
              SkEpiInProj SE{(bf16*)(ws + WS_Z) + (size_t)MP * DIN, KA->out, l};
              mini_gemm<32, 128, 1, 4, 2, 2, SkEpiInProj>(lds, (const bf16*)(ws + WS_H) + (size_t)MP * DM, DM, MS, (const bf16*)(ws + WS_WIN) + (size_t)l * DIN * DM, DIN, DM, tid, bid, G, SE); }
        }
        SEAM(pb + 0);
        if (IN(pb + 1)) {
            {
            KArgs KA = kargs(); unsigned char* ws = KA->ws; TIDS(); GWS();
            const bf16* Zb = (const bf16*)(ws + WS_Z); bf16* MIXb = (bf16*)(ws + WS_MIX); float* out = KA->out;
            for (int un0 = bid; un0 < 256 * REP_B1; un0 += G) { const int un = un0 & 255;
                __syncthreads();
                const int unl = (G == 256) ? (((un >> 5) * 8 + (un & 7)) * 4 + ((un >> 3) & 3)) : un;
                const int b = unl >> 6, n = (unl >> 2) & 15, dq = unl & 3;
                LruUnit U; U.zseq = Zb + (size_t)(b * TP) * DIN; U.prefix = nullptr;
                LAS unsigned char* bl = lds + LX_BL_OFF; LAS float* bsum = (LAS float*)(lds + LX_BS_OFF);
                lru_setup_lds(U, bl, bsum, wave, l, n, dq, KA->in[15], KA->in[16], KA->in[17], KA->in[19], KA->in[21]);
                const int ch = lane & 15, tq = lane >> 4;
                LAS unsigned char* slab = lds;
                LAS float* ex = (LAS float*)(lds + LX_EX_OFF);
                const bf16* zcol = U.zseq + C_XB + 64 * n;
                v4u st[8];
                const int r0 = tid >> 3, c8 = tid & 7;
                const bf16* zsrc = zcol + (size_t)r0 * DIN + 8 * c8;
                LAS unsigned char* sdst = slab + (r0 + 3) * LX_PITCH + (c8 ^ (((r0 + 3) >> 4) & 3)) * 16;
                const bf16* gsrc = Zb + (size_t)(b * TP + (tid >> 1)) * DIN + C_GB + U.chn - (lane & 15) + 8 * (tid & 1);
                LAS unsigned char* gdst = lds + LX_GS_OFF + (tid >> 1) * 32 + (tid & 1) * 16;
                v4u gst[2];
#pragma unroll
                for (int i = 0; i < 8; ++i) st[i] = *(const v4u*)(zsrc + (size_t)(64 * i) * DIN);
                gst[0] = *(const v4u*)gsrc; gst[1] = *(const v4u*)(gsrc + (size_t)256 * DIN);
#pragma unroll
                for (int i = 0; i < 8; ++i) *(LAS v4u*)(sdst + i * 64 * LX_PITCH) = st[i];
                *(LAS v4u*)gdst = gst[0]; *(LAS v4u*)(gdst + 256 * 32) = gst[1];
                if (tid < 24) { unsigned z_; asm volatile("v_mov_b32 %0, 0" : "=v"(z_)); *(LAS v4u*)(slab + (tid >> 3) * LX_PITCH + c8 * 16) = (v4u){z_, z_, z_, z_}; }
                __syncthreads();
                U.rb = KA->in[18][(size_t)(l * 16 + n) * 64 + 16 * dq + ch] + bsum[0 * 16 + ch] + bsum[2 * 16 + ch];
                U.ib = KA->in[20][(size_t)(l * 16 + n) * 64 + 16 * dq + ch] + bsum[1 * 16 + ch] + bsum[3 * 16 + ch];
                float hstart = 0.f;
#pragma unroll 1
                for (int R = 0; R < 4; ++R) {
                    v4u hist;
                    if (R + 1 < 4) {
#pragma unroll
                        for (int i = 0; i < 8; ++i) st[i] = *(const v4u*)(zsrc + (size_t)((R + 1) * 512 + 64 * i) * DIN);
                        gst[0] = *(const v4u*)(gsrc + (size_t)((R + 1) * 512) * DIN); gst[1] = *(const v4u*)(gsrc + (size_t)((R + 1) * 512 + 256) * DIN);
                        if (tid < 24) hist = *(const LAS v4u*)(slab + (512 + (tid >> 3)) * LX_PITCH + c8 * 16);
                    }
                    const int tw = R * 512 + wave * 64;
                    float Ac, Hc; float P[16], hl[16];
                    lru_round_lds(U, slab, bl, wave * 64, dq, Ac, Hc, P, hl);
                    if (tq == 0) { ex[(wave * 16 + ch) * 2] = Ac; ex[(wave * 16 + ch) * 2 + 1] = Hc; }
                    __syncthreads();
                    float hs = hstart, hin = 0.f;
#pragma unroll
                    for (int w2 = 0; w2 < 8; ++w2) { const float A2 = ex[(w2 * 16 + ch) * 2], H2 = ex[(w2 * 16 + ch) * 2 + 1]; if (w2 == wave) hin = hs; hs = A2 * hs + H2; }
                    hstart = hs;
                    if (R + 1 < 4) {
#pragma unroll
                        for (int i = 0; i < 8; ++i) *(LAS v4u*)(sdst + i * 64 * LX_PITCH) = st[i];
                        if (tid < 24) *(LAS v4u*)(slab + (tid >> 3) * LX_PITCH + c8 * 16) = hist;
                        *(LAS v4u*)(gdst + ((R + 1) & 1) * 16384) = gst[0]; *(LAS v4u*)(gdst + ((R + 1) & 1) * 16384 + 256 * 32) = gst[1];
                    }
                    float gbv[16];
                    { const LAS unsigned char* gp = lds + LX_GS_OFF + (R & 1) * 16384 + (wave * 64 + 16 * tq) * 32 + ch * 2;
#pragma unroll
                    for (int k = 0; k < 16; ++k) gbv[k] = bf2f(*(const LAS unsigned short*)(gp + k * 32)); }
#pragma unroll
                    for (int k = 0; k < 16; ++k) {
                        const int t = tw + 16 * tq + k; const size_t row = (size_t)(b * TP + t);
                        const float hv = hl[k] + P[k] * hin;
                        MIXb[row * DM + 512 + U.chn] = (bf16)f2bf(hv * gelu_tanh(gbv[k]));
                        if (t == TP - 1) out[O_LHP + (size_t)(l * BP + b) * 1024 + U.chn] = hv;
                    }
                    __syncthreads();
                }
            }
            }
            {
            KArgs KA = kargs(); unsigned char* ws = KA->ws; TIDS(); GWS();
            const bf16* Zb = (const bf16*)(ws + WS_Z); bf16* MIXb = (bf16*)(ws + WS_MIX); const float* rel_bias = KA->in[22];
            for (int un0 = bid; un0 < 256 * REP_B2; un0 += G) { const int un = un0 & 255;
                __syncthreads();
                const int unb = (G == 256) ? ((((un & 7) + 8 * (un >> 6)) * 8) + ((un >> 3) & 7)) : un;
                const int b = unb >> 6, hd = (unb >> 3) & 7, cg = unb & 7;
                LAS float* tbl = (LAS float*)(lds + 2 * AK_BYTES + 2 * AV_BYTES);
                for (int e = tid; e < 257; e += 512) tbl[e] = rel_bias[((size_t)l * 8 + hd) * 257 + e] * LOG2E;
                const int first = (4 * cg - 8) > 0 ? (4 * cg - 8) : 0, ntiles = 2 * (4 * cg + 3 - first + 1);
                const int cq = 4 * cg + (wave >> 1), r = lane & 31;
                const size_t qrowi = (size_t)(b * TP + cq * 64 + 32 * (wave & 1) + r);
                AttnWave W; W.active = true; W.wr = true; W.qrow = Zb + qrowi * DIN + C_QC + hd * 64; W.orow = MIXb + qrowi * DM + 1536 + hd * 64;
                W.qpos = cq * 64 + 32 * (wave & 1) + r; W.m0 = -1e30f; W.l0 = 0.f;
                SrcZ src{Zb + (size_t)(b * TP) * DIN, 64 * first, C_KC + hd * 64, C_VC + hd * 64};
                const int klo = (cq - 8) > first ? (cq - 8) : first;
                RelBandP rel{2 * (klo - first), 2 * (cq - first) + 1};
                attn_run<true, true, false, SrcZ, RelBandP, (ATT_ROT != 0)>(lds, lds + 2 * AK_BYTES, tbl, tid, 0, 1, ntiles, 64 * first, -1, src, rel, W, nullptr);
            }
            }
            {
            KArgs KA = kargs(); unsigned char* ws = KA->ws; TIDS(); GWS();
            const bf16* Zb = (const bf16*)(ws + WS_Z); bf16* MIXb = (bf16*)(ws + WS_MIX); const float* swa_sink = KA->in[14];
            for (int un0 = bid; un0 < 256 * REP_B3; un0 += G) { const int un = un0 & 255;
                __syncthreads();
                const int b = un >> 6, c = (un >> 1) & 31, kvh = un & 1;
                const int first = (c - 2) > 0 ? (c - 2) : 0; int ntiles = 2 * (c - first + 1);
#ifdef B3_PROBE_TILES
                if (un0 + G < 256 * REP_B3) ntiles = ntiles < B3_PROBE_TILES ? ntiles : B3_PROBE_TILES;
#endif
                const int gq = wave >> 1, r = lane & 31;
                const size_t qrowi = (size_t)(b * TP + c * 64 + 32 * (wave & 1) + r);
                AttnWave W; W.active = true; W.wr = true; W.qrow = Zb + qrowi * DIN + C_QA + kvh * 256 + gq * 64; W.orow = MIXb + qrowi * DM + kvh * 256 + gq * 64;
                W.qpos = 0; W.m0 = swa_sink[l * 8 + kvh * 4 + gq] * LOG2E; W.l0 = (lane < 32) ? 1.0f : 0.f;
                SrcZ src{Zb + (size_t)(b * TP) * DIN, 64 * first, C_KA + kvh * 64, C_VA + kvh * 64};
#if SWA_ALL
                attn_run_all<6, SrcZ>(lds, lds + 6 * AK_BYTES, tid, ntiles, src, W);
#else
                attn_run<true, false, false, SrcZ, RelAll>(lds, lds + 2 * AK_BYTES, nullptr, tid, 0, 1, ntiles, 0, -1, src, RelAll{}, W, nullptr);
#endif
            }
            }
            {
            KArgs KA = kargs(); unsigned char* ws = KA->ws; TIDS(); GWS();
            const bf16* Zb = (const bf16*)(ws + WS_Z); bf16* MIXb = (bf16*)(ws + WS_MIX); float* out = KA->out;
            for (int un = bid; un < 256; un += G) {
                if (wave < 2) {
                    const int uidx = un * 2 + wave, bs = uidx >> 6, n = (uidx >> 2) & 15, dq = uidx & 3;
                    LruUnit U; U.zseq = Zb + (size_t)(MP + bs * TS) * DIN; U.prefix = KA->in[9] + ((size_t)(l * BS + bs) * 3) * 1024;
                    lru_setup(U, l, n, dq, KA->in[15], KA->in[16], KA->in[17], KA->in[18], KA->in[19], KA->in[20], KA->in[21]);
                    float Ac = 1.0f, Hc = 0.f, P[4], hl[4];
                    lru_tile(U, 0, Ac, Hc, P, hl);
                    const float hin = KA->in[8][(size_t)(l * BS + bs) * 1024 + U.chn];
                    const int tq = lane >> 4;
#pragma unroll
                    for (int j = 0; j < 4; ++j) {
                        const int t = 4 * tq + j; const size_t row = (size_t)(MP + bs * TS + t);
                        const float hv = hl[j] + P[j] * hin;
                        const float gb = bf2f(Zb[row * DIN + C_GB + U.chn]);
                        MIXb[row * DM + 512 + U.chn] = (bf16)f2bf(hv * gelu_tanh(gb));
                        if (t == TS - 1) out[O_LHS + (size_t)(l * BS + bs) * 1024 + U.chn] = hv;
                    }
                }
            }
            }
            {
            KArgs KA = kargs(); unsigned char* ws = KA->ws; TIDS(); GWS();
            const bf16* Zb = (const bf16*)(ws + WS_Z); bf16* MIXb = (bf16*)(ws + WS_MIX); const float* swa_sink = KA->in[14];
            for (int un = (G == 256) ? ((((bid >> 3) & 7) == 0) ? ((bid & 7) + 8 * (bid >> 6)) : 16) : bid; un < 16; un += G) {
                __syncthreads();
                const int bs = un >> 1, kvh = un & 1, r = lane & 31;
                const int gq = 2 * (wave & 1) + (r >> 4), t = r & 15;
                const size_t qrowi = (size_t)(MP + bs * TS + t);
                AttnWave W; W.active = wave < 2; W.wr = true; W.qrow = Zb + qrowi * DIN + C_QA + kvh * 256 + gq * 64; W.orow = MIXb + qrowi * DM + kvh * 256 + gq * 64;
                W.qpos = 0; W.m0 = swa_sink[l * 8 + kvh * 4 + gq] * LOG2E; W.l0 = (lane < 32) ? 1.0f : 0.f;
                SrcCache src{KA->in[4] + ((size_t)(l * BS + bs) * 128 * 2 + kvh) * 64, KA->in[5] + ((size_t)(l * BS + bs) * 128 * 2 + kvh) * 64, 2 * 64, 4,
                             Zb + (size_t)(MP + bs * TS) * DIN, C_KA + kvh * 64, C_VA + kvh * 64};
                attn_run<true, false, false, SrcCache, RelAll>(lds, lds + 2 * AK_BYTES, nullptr, tid, 0, 1, 5, 0, 4, src, RelAll{}, W, nullptr);
            }
            }
            {
            KArgs KA = kargs(); unsigned char* ws = KA->ws; TIDS(); GWS();
            const bf16* Zb = (const bf16*)(ws + WS_Z); bf16* MIXb = (bf16*)(ws + WS_MIX); const float* rel_bias = KA->in[22];
            constexpr int WREG = AK_BYTES + AV_BYTES + ATBL_BYTES;
            for (int un = (G == 256) ? ((((bid >> 3) & 7) < 2) ? ((bid & 7) + 8 * (bid >> 6)) * 2 + ((bid >> 3) & 7) : 64) : bid; un < 64; un += G) {
                __syncthreads();
                const int bs = un >> 3, hd = un & 7, r = lane & 31, t = r & 15;
                LAS float* tbl = (LAS float*)(lds + 8 * WREG);
                for (int e = tid; e < 257; e += 512) tbl[e] = rel_bias[((size_t)l * 8 + hd) * 257 + e] * LOG2E;
                __syncthreads();
                LAS unsigned char* wb = lds + wave * WREG;
                const size_t qrowi = (size_t)(MP + bs * TS + t);
                AttnWave W; W.active = true; W.wr = false; W.qrow = Zb + qrowi * DIN + C_QC + hd * 64; W.orow = nullptr;
                W.qpos = t; W.m0 = -1e30f; W.l0 = 0.f;
                SrcCache src{KA->in[6] + ((size_t)(l * BS + bs) * 512 * 8 + hd) * 64, KA->in[7] + ((size_t)(l * BS + bs) * 512 * 8 + hd) * 64, 8 * 64, 16,
                             Zb + (size_t)(MP + bs * TS) * DIN, C_KC + hd * 64, C_VC + hd * 64};
                attn_run<false, true, true, SrcCache, RelAll>(wb, wb + AK_BYTES, tbl, lane, wave, 8, wave == 0 ? 3 : 2, -512, 16, src, RelAll{}, W, (LAS float*)wb);
                __syncthreads();
                { const int q = tid & 15, d = tid >> 4;
                  float mw[8], M = -3e38f;
#pragma unroll
                  for (int w = 0; w < 8; ++w) { mw[w] = ((const LAS float*)(lds + w * WREG))[q]; M = fmaxf(M, mw[w]); }
                  float L = 0.f, a0 = 0.f, a1 = 0.f;
#pragma unroll
                  for (int w = 0; w < 8; ++w) { const LAS float* pw = (const LAS float*)(lds + w * WREG); const float f = fexp2(mw[w] - M); L += pw[32 + q] * f; a0 += pw[64 + d * 32 + q] * f; a1 += pw[64 + (d + 32) * 32 + q] * f; }
                  const float inv = 1.0f / L; bf16* orow = MIXb + (size_t)(MP + bs * TS + q) * DM + 1536 + hd * 64;
                  orow[d] = (bf16)f2bf(a0 * inv); orow[d + 32] = (bf16)f2bf(a1 * inv); }
            }
            }
            __syncthreads();
        }
        SEAM(pb + 1);
        if (IN(pb + 2)) {
            { KArgs KA = kargs(); unsigned char* ws = KA->ws; TIDS(); GWS();
              SkEpiBf16 SE{(bf16*)(ws + WS_T) + (size_t)MP * DM, DM};
              mini_gemm<32, 32, 1, 1, 8, 4, SkEpiBf16>(lds, (const bf16*)(ws + WS_MIX) + (size_t)MP * DM, DM, MS, (const bf16*)(ws + WS_WOUT) + (size_t)l * DM * DM, DM, DM, tid, bid, G, SE); }
            KArgs KA = kargs(); unsigned char* ws = KA->ws;
            pg8::Gemm g{(const bf16*)(ws + WS_MIX), (const bf16*)(ws + WS_WOUT) + (size_t)l * DM * DM, MP, DM, DM}; pg8::StaticOrder S; int G_ = gridDim.x, bid_ = blockIdx.x; asm volatile("" : "+s"(G_), "+s"(bid_)); S.init(MP, DM, G_, bid_, REP_C);
            if (FUSE_THIN && G_ == 256) {
                const float* md = (const float*)(ws + WS_MOD) + (size_t)l * 12 * NMOD;
                pg8::PanelRms st{(unsigned long long*)(ws + WS_XCH + (size_t)(2 * l) * MiB), (unsigned*)(ws + WS_CTL) + CW_SEAM + (2 * l) * 32 * 64, (unsigned*)(ws + WS_CTL), 0x700u};
                pg8::EpiFuse E{(l == 0) ? KA->in[0] : (const float*)KA->out, KA->out, (bf16*)(ws + WS_H), md + 2 * DM, md + 4 * DM, md + 3 * DM, NMOD, st};
                pg8::gemm_phase<pg8::EpiFuse, pg8::StaticOrder, false, true>(lds, g, S, E, wave0 * 64 + hw_lane());
            } else {
                pg8::EpiBf16 E{(bf16*)(ws + WS_T), DM};
                pg8::gemm_phase<pg8::EpiBf16, pg8::StaticOrder, true, true>(lds, g, S, E, wave0 * 64 + hw_lane());
            }
        }
        SEAM(pb + 2);
        if (IN(pb + 3)) {
            KArgs KA = kargs(); unsigned char* ws = KA->ws; TIDS(); GWS();
            const float* x_p = KA->in[0]; const float* x_s = KA->in[1]; const float* g_post_mix = KA->in[24]; const float* g_pre_mlp = KA->in[25]; float* out = KA->out;
            const float* MOD = (const float*)(ws + WS_MOD); bf16* Hb = (bf16*)(ws + WS_H); const bf16* Tb = (const bf16*)(ws + WS_T); bf16* XR = (bf16*)(ws + WS_XR);
            const bool fusedp = FUSE_THIN && G == 256;
#if COOP_SPLIT
            const bool has_s = bid < MS;
            if (has_s) { const int row = MP + bid; const float* md = MOD + ((size_t)l * 12 + mod_row_of(row)) * NMOD;
                coop_dma(lds, Tb + (size_t)row * DM, (l == 0) ? x_s + (size_t)bid * DM : (const float*)nullptr, (l == 0) ? (const bf16*)nullptr : XR + (size_t)row * DM, md + 2 * DM, md + 4 * DM, md + 3 * DM, wave, lane); }
#endif
            for (int r4 = fusedp ? MP : gw; r4 < MP / 4; r4 += NGW) {
                const float* md = MOD + ((size_t)l * 12 + mod_row_of(4 * r4)) * NMOD;
                f32x4 cv[8], ev[8], fv[8];
                ROW_LD(cv, md + 2 * DM); ROW_LD(ev, md + 4 * DM); ROW_LD(fv, md + 3 * DM);
#pragma unroll 1
                for (int ri = 0; ri < 4; ++ri) {
                    const int row = 4 * r4 + ri;
                    f32x4 tv[8], xv[8];
                    ROW_LD_BF16(tv, Tb + (size_t)row * DM);
                    if (l == 0) { ROW_LD(xv, x_p + (size_t)row * DM); } else { ROW_LD_BF16(xv, XR + (size_t)row * DM); }
                    const float rt_ = 1.0f / sqrtf(row_sumsq(tv) * (1.0f / DM) + RMS_EPS);
#pragma unroll
                    for (int j = 0; j < 8; ++j) xv[j] = xv[j] + (tv[j] * rt_) * cv[j];
                    ROW_ST_BF16(XR + (size_t)row * DM, xv);
                    const float rx = 1.0f / sqrtf(row_sumsq(xv) * (1.0f / DM) + RMS_EPS);
                    norm_store(xv, rx, ev, fv, Hb + (size_t)row * DM, lane);
                }
            }
#if COOP_SPLIT
            if (has_s) { const int row = MP + bid; asm volatile("s_waitcnt vmcnt(0)" ::: "memory"); __syncthreads(); const unsigned char* Lg = lds_raw + CD_BASE;
                coop_row((const bf16*)(Lg + CD_T), (const float*)(Lg + CD_X), (l == 0) ? (const bf16*)nullptr : (const bf16*)(Lg + CD_X), (const float*)(Lg + CD_C), (const float*)(Lg + CD_E), (const float*)(Lg + CD_F), nullptr, XR + (size_t)row * DM, Hb + (size_t)row * DM, (LAS float*)lds, tid); }
            for (int sr = bid + G; sr < MS; sr += G) {
#else
            for (int sr = bid; sr < MS; sr += G) {
#endif
                __syncthreads();
                const int row = MP + sr; const float* md = MOD + ((size_t)l * 12 + mod_row_of(row)) * NMOD;
                coop_row(Tb + (size_t)row * DM, x_s + (size_t)sr * DM, (l == 0) ? (const bf16*)nullptr : XR + (size_t)row * DM, md + 2 * DM, md + 4 * DM, md + 3 * DM, nullptr, XR + (size_t)row * DM, Hb + (size_t)row * DM, (LAS float*)lds, tid);
            }
        }
        SEAM(pb + 3);
        if (IN(pb + 4)) {
            { KArgs KA = kargs(); unsigned char* ws = KA->ws; TIDS(); GWS();
              SkEpiRelu2 SE{(bf16*)(ws + WS_F1) + (size_t)MP * DFF, DFF};
              mini_gemm<64, 64, 1, 2, 4, 2, SkEpiRelu2>(lds, (const bf16*)(ws + WS_H) + (size_t)MP * DM, DM, MS, (const bf16*)(ws + WS_WUP) + (size_t)l * DFF * DM, DFF, DM, tid, bid, G, SE); }
            KArgs KA = kargs(); unsigned char* ws = KA->ws;
            pg8::Gemm g{(const bf16*)(ws + WS_H), (const bf16*)(ws + WS_WUP) + (size_t)l * DFF * DM, MP, DFF, DM}; pg8::StaticOrder S; { int G_ = gridDim.x, bid_ = blockIdx.x; asm volatile("" : "+s"(G_), "+s"(bid_)); S.init(MP, DFF, G_, bid_, REP_E); }
            pg8::EpiRelu2 E{(bf16*)(ws + WS_F1), DFF};
            pg8::gemm_phase<pg8::EpiRelu2, pg8::StaticOrder, true, true>(lds, g, S, E, wave0 * 64 + hw_lane());
        }
        SEAM(pb + 4);
        if (IN(pb + 5)) {
            { KArgs KA = kargs(); unsigned char* ws = KA->ws; TIDS(); GWS();
              SkEpiBf16 SE{(bf16*)(ws + WS_T) + (size_t)MP * DM, DM};
              mini_gemm<32, 32, 1, 1, 8, 4, SkEpiBf16>(lds, (const bf16*)(ws + WS_F1) + (size_t)MP * DFF, DFF, MS, (const bf16*)(ws + WS_WDN) + (size_t)l * DM * DFF, DM, DFF, tid, bid, G, SE); }
            KArgs KA = kargs(); unsigned char* ws = KA->ws;
            pg8::Gemm g{(const bf16*)(ws + WS_F1), (const bf16*)(ws + WS_WDN) + (size_t)l * DM * DFF, MP, DM, DFF}; pg8::StaticOrder S; int G_ = gridDim.x, bid_ = blockIdx.x; asm volatile("" : "+s"(G_), "+s"(bid_)); S.init(MP, DM, G_, bid_, REP_F);
            if (FUSE_THIN && G_ == 256) {
                const float* md = (const float*)(ws + WS_MOD) + (size_t)l * 12 * NMOD; const float* md2 = (const float*)(ws + WS_MOD) + (size_t)(l + 1 < NL ? l + 1 : l) * 12 * NMOD;
                pg8::PanelRms st{(unsigned long long*)(ws + WS_XCH + (size_t)(2 * l + 1) * MiB), (unsigned*)(ws + WS_CTL) + CW_SEAM + (2 * l + 1) * 32 * 64, (unsigned*)(ws + WS_CTL), 0x780u};
                pg8::EpiFuse E{(const float*)KA->out, KA->out, (l + 1 < NL) ? (bf16*)(ws + WS_H) : (bf16*)nullptr, md + 5 * DM, md2 + DM, md2, NMOD, st};
                pg8::gemm_phase<pg8::EpiFuse, pg8::StaticOrder, false, true>(lds, g, S, E, wave0 * 64 + hw_lane());
            } else {
                pg8::EpiBf16 E{(bf16*)(ws + WS_T), DM};
                pg8::gemm_phase<pg8::EpiBf16, pg8::StaticOrder, true, true>(lds, g, S, E, wave0 * 64 + hw_lane());
            }
        }
        SEAM(pb + 5);
        if (IN(pb + 6)) {
            KArgs KA = kargs(); unsigned char* ws = KA->ws; TIDS(); GWS();
            const float* g_post_mlp = KA->in[28]; const float* g_pre_mix = KA->in[12]; float* out = KA->out;
            const float* MOD = (const float*)(ws + WS_MOD); bf16* Hb = (bf16*)(ws + WS_H); const bf16* Tb = (const bf16*)(ws + WS_T); bf16* XR = (bf16*)(ws + WS_XR);
            const bool fusedp = FUSE_THIN && G == 256;
#if COOP_SPLIT
            const bool has_s = bid < MS;
            if (has_s) { const int row = MP + bid; const float* md = MOD + ((size_t)l * 12 + mod_row_of(row)) * NMOD; const float* md2 = MOD + ((size_t)(l + 1 < NL ? l + 1 : l) * 12 + mod_row_of(row)) * NMOD;
                coop_dma(lds, Tb + (size_t)row * DM, nullptr, XR + (size_t)row * DM, md + 5 * DM, md2 + DM, md2, wave, lane); }
#endif
            for (int r4 = fusedp ? MP : gw; r4 < MP / 4; r4 += NGW) {
                const float* md = MOD + ((size_t)l * 12 + mod_row_of(4 * r4)) * NMOD;
                const float* md2 = MOD + ((size_t)(l + 1 < NL ? l + 1 : l) * 12 + mod_row_of(4 * r4)) * NMOD;
                f32x4 cv[8], ev[8], fv[8];
                ROW_LD(cv, md + 5 * DM); ROW_LD(ev, md2 + DM); ROW_LD(fv, md2);
#pragma unroll 1
                for (int ri = 0; ri < 4; ++ri) {
                    const int row = 4 * r4 + ri;
                    f32x4 tv[8], xv[8];
                    ROW_LD_BF16(tv, Tb + (size_t)row * DM); ROW_LD_BF16(xv, XR + (size_t)row * DM);
                    const float rt_ = 1.0f / sqrtf(row_sumsq(tv) * (1.0f / DM) + RMS_EPS);
#pragma unroll
                    for (int j = 0; j < 8; ++j) xv[j] = xv[j] + (tv[j] * rt_) * cv[j];
                    if (l + 1 < NL) {
                        ROW_ST_BF16(XR + (size_t)row * DM, xv);
                        const float rx = 1.0f / sqrtf(row_sumsq(xv) * (1.0f / DM) + RMS_EPS);
                        norm_store(xv, rx, ev, fv, Hb + (size_t)row * DM, lane);
                    } else {
                        f32x4* o4 = (f32x4*)(out + (size_t)row * DM) + 2 * lane;
#pragma unroll
                        for (int g = 0; g < 4; ++g) { o4[128 * g] = xv[2 * g]; o4[128 * g + 1] = xv[2 * g + 1]; }
                    }
                }
            }
#if COOP_SPLIT
            if (has_s) { const int row = MP + bid; asm volatile("s_waitcnt vmcnt(0)" ::: "memory"); __syncthreads(); const unsigned char* Lg = lds_raw + CD_BASE;
                coop_row((const bf16*)(Lg + CD_T), nullptr, (const bf16*)(Lg + CD_X), (const float*)(Lg + CD_C), (const float*)(Lg + CD_E), (const float*)(Lg + CD_F), out + (size_t)row * DM, (l + 1 < NL) ? XR + (size_t)row * DM : (bf16*)nullptr, (l + 1 < NL) ? Hb + (size_t)row * DM : (bf16*)nullptr, (LAS float*)lds, tid); }
            for (int sr = bid + G; sr < MS; sr += G) {
#else
            for (int sr = bid; sr < MS; sr += G) {
#endif
                __syncthreads();
                const int row = MP + sr; const float* md = MOD + ((size_t)l * 12 + mod_row_of(row)) * NMOD;
                const float* md2 = MOD + ((size_t)(l + 1 < NL ? l + 1 : l) * 12 + mod_row_of(row)) * NMOD;
                coop_row(Tb + (size_t)row * DM, nullptr, XR + (size_t)row * DM, md + 5 * DM, md2 + DM, md2, out + (size_t)row * DM, (l + 1 < NL) ? XR + (size_t)row * DM : (bf16*)nullptr, (l + 1 < NL) ? Hb + (size_t)row * DM : (bf16*)nullptr, (LAS float*)lds, tid);
            }
        }
        SEAM(pb + 6);
    }
#undef IN
#undef SEAM
}

#ifndef MK_SINGLE
#define MK_SINGLE 0
#endif
extern "C" void kernel_launch(void* const* d_in, const int* in_sizes, int n_in, void* d_out, int out_size, void* d_ws, size_t ws_size, hipStream_t stream) {
    static int grid = 0;
    if (grid == 0) {
        if (n_in != 29 || in_sizes[0] != MP * DM || (size_t)out_size != O_END || ws_size < WS_END) {
            fprintf(stderr, "kernel_launch: unexpected shapes: n_in %d in0 %d out %d (want %zu) ws %zu (want %zu); nothing launched\n", n_in, n_in > 0 ? in_sizes[0] : -1, out_size, (size_t)O_END, ws_size, (size_t)WS_END);
            grid = -1; return; }
        int dev = 0, cus = 0, per_cu = 0;
        if (hipGetDevice(&dev) != hipSuccess || hipDeviceGetAttribute(&cus, hipDeviceAttributeMultiprocessorCount, dev) != hipSuccess) { fprintf(stderr, "kernel_launch: device query failed\n"); grid = -1; return; }
        if (hipFuncSetAttribute((const void*)mk_fwd, hipFuncAttributeMaxDynamicSharedMemorySize, LDS_BYTES) != hipSuccess) { fprintf(stderr, "kernel_launch: hipFuncSetAttribute failed\n"); grid = -1; return; }
        if (hipOccupancyMaxActiveBlocksPerMultiprocessor(&per_cu, (const void*)mk_fwd, NWAVES * 64, LDS_BYTES) != hipSuccess || per_cu < 1)
            fprintf(stderr, "kernel_launch: note: occupancy query reports %d workgroups per CU\n", per_cu);
        (void)hipGetLastError();
        grid = cus;
    }
    if (grid < 0) return;
    if (hipMemsetAsync((char*)d_ws + WS_CTL, 0, CTL_ZERO_BYTES, stream) != hipSuccess) { fprintf(stderr, "kernel_launch: memset failed\n"); return; }
    Args a{};
    for (int i = 0; i < 29; ++i) a.in[i] = (const float*)d_in[i];
    a.out = (float*)d_out; a.ws = (unsigned char*)d_ws;
#if MK_SINGLE
    a.ph_lo = 0; a.ph_hi = N_PHASES;
    hipLaunchKernelGGL(mk_fwd, dim3(grid), dim3(NWAVES * 64), LDS_BYTES, stream, a);
#else
    for (int p = 0; p < N_PHASES; ++p) {
        a.ph_lo = p; a.ph_hi = p + 1;
        hipLaunchKernelGGL(mk_fwd, dim3(grid), dim3(NWAVES * 64), LDS_BYTES, stream, a);
    }
#endif
    const hipError_t le = hipPeekAtLastError();
    if (le != hipSuccess) fprintf(stderr, "kernel_launch: launch failed: %s\n", hipGetErrorName(le));
}
```

```cpp
#include <hip/hip_runtime.h>
#include <cstdio>
#include <cstdint>
#include <cmath>
#define MK_SINGLE 1
#define ATT_ROT 1
namespace pg8 {
#define PG8_LAS __attribute__((address_space(3)))
typedef unsigned short bf16_t;
typedef short bf16x8 __attribute__((ext_vector_type(8)));
typedef float f32x4 __attribute__((ext_vector_type(4)));
typedef unsigned u32x4 __attribute__((ext_vector_type(4)));
constexpr int BM = 256, BK = 64, HALF = 128, HTB = HALF * BK * 2  , STAGE_BYTES = 8 * HTB, NXCD = 8, WGM = 8;

__host__ __device__ __forceinline__ int lds_byte(int r, int c) { const int st = (r >> 4) * 2 + (c >> 5), rr = r & 15, cc = c & 31, ob = rr * 64 + cc * 2; return st * 1024 + (ob ^ (((ob >> 9) & 1) << 5)); }
__host__ __device__ __forceinline__ void stage_rc(int b, int& R, int& C) { const int st = b / 1024, sb = b % 1024, swz = sb ^ (((sb >> 9) & 1) << 5); R = (st >> 1) * 16 + swz / 64; C = (st & 1) * 32 + (swz % 64) / 2; }
__host__ __device__ __forceinline__ int perm32(int rho) { const int n = rho >> 4, i = rho & 15; return 8 * (i >> 2) + 4 * n + (i & 3); }

struct Unit { int pm, pn; };
struct Gemm { const bf16_t* A; const bf16_t* Bt; int M, N, K; };

struct StaticOrder {
    int nM, nN, nwg, G, c, rep;
    __host__ __device__ void init(int M, int N, int G_, int c_, int rep_ = 1) { nM = M / BM; nN = N / BM; nwg = nM * nN; G = G_; c = c_; rep = rep_; }
    __host__ __device__ bool next(int i, Unit& u) const {
        long L = (long)i * G + c; if (L >= (long)nwg * rep) return false;
        L %= nwg;
        int wgid = (int)L; { const int q = nwg / NXCD, r = nwg % NXCD, xcd = wgid % NXCD, off = wgid / NXCD; wgid = (xcd < r ? xcd * (q + 1) : r * (q + 1) + (xcd - r) * q) + off; }
        const int nig = WGM * nN, gid = wgid / nig, fm = gid * WGM, gsz = (nM - fm) < WGM ? (nM - fm) : WGM;
        u.pm = fm + ((wgid % nig) % gsz); u.pn = (wgid % nig) / gsz; return true;
    }
    __device__ __forceinline__ void a_ready(const Unit&) const {}
    __device__ __forceinline__ void done(const Unit&) const {}
};

__device__ __forceinline__ unsigned cvt_pk_bf16(float lo, float hi) { unsigned r; asm volatile("v_cvt_pk_bf16_f32 %0, %1, %2" : "=v"(r) : "v"(lo), "v"(hi)); return r; }
typedef float f32x2 __attribute__((ext_vector_type(2)));

constexpr int X_DM = 2048, X_MP = 8192, X_MS = 128, X_DIN = 4352, X_DFF = 8192, X_NL = 4;
constexpr size_t O_YP = 0, O_YS = O_YP + (size_t)X_MP * X_DM, O_SKP = O_YS + (size_t)X_MS * X_DM, O_SVP = O_SKP + (size_t)X_NL * 4 * 128 * 128,
                 O_BKP = O_SVP + (size_t)X_NL * 4 * 128 * 128, O_BVP = O_BKP + (size_t)X_NL * 4 * 512 * 512, O_LHP = O_BVP + (size_t)X_NL * 4 * 512 * 512,
                 O_LCP = O_LHP + (size_t)X_NL * 4 * 1024, O_SKS = O_LCP + (size_t)X_NL * 4 * 3 * 1024, O_SVS = O_SKS + (size_t)X_NL * 8 * 16 * 128,
                 O_BKS = O_SVS + (size_t)X_NL * 8 * 16 * 128, O_BVS = O_BKS + (size_t)X_NL * 8 * 16 * 512, O_LHS = O_BVS + (size_t)X_NL * 8 * 16 * 512,
                 O_LCS = O_LHS + (size_t)X_NL * 8 * 1024, O_END = O_LCS + (size_t)X_NL * 8 * 3 * 1024;

#ifndef EPI_SC1
#define EPI_SC1 0
#endif
__device__ __forceinline__ void st16_wt(void* p, u32x4 w) {
#if EPI_SC1
    asm volatile("global_store_dwordx4 %0, %1, off sc1\n\ts_nop 1" :: "v"(p), "v"(w) : "memory");
#else
    *(u32x4*)p = w;
#endif
}
struct EpiF32 {
    static constexpr bool PERM = false, ADJ = false, AFTER_DRAIN = false;
    float* C; int ldc;
    __device__ __forceinline__ void operator()(const f32x4 (&acc)[2][2][4][2], const Unit& u, int wr, int wc, int fr, int fq) const {
        const int row0 = u.pm * BM + wr * 64 + fr, col0 = u.pn * BM + wc * 32 + 4 * fq;
#pragma unroll
        for (int ai = 0; ai < 2; ++ai)
#pragma unroll
            for (int m = 0; m < 4; ++m) { float* rowp = C + (size_t)(row0 + ai * HALF + m * 16) * ldc + col0;
#pragma unroll
                for (int bj = 0; bj < 2; ++bj)
#pragma unroll
                    for (int n = 0; n < 2; ++n) *(f32x4*)(rowp + bj * HALF + n * 16) = acc[ai][bj][m][n]; }
    }
};
#ifndef EPI_RELU_ASM
#define EPI_RELU_ASM 1
#endif
__device__ __forceinline__ f32x2 relu2_pk(float x, float y) {
    f32x2 m, r;
    asm("v_max_f32 %0, 0, %1" : "=v"(m.x) : "v"(x));
    asm("v_max_f32 %0, 0, %1" : "=v"(m.y) : "v"(y));
    asm("v_pk_mul_f32 %0, %1, %1" : "=v"(r) : "v"(m));
    return r;
}
struct EpiRelu2 {
    static constexpr bool PERM = true, ADJ = true, AFTER_DRAIN = false;
    bf16_t* O; int ldc;
    __device__ __forceinline__ void operator()(const f32x4 (&acc)[2][2][4][2], const Unit& u, int wr, int wc, int fr, int fq) const {
        const int row0 = u.pm * BM + wr * 64 + fr, col0 = u.pn * BM + wc * 64 + 8 * fq;
#pragma unroll
        for (int ai = 0; ai < 2; ++ai)
#pragma unroll
            for (int m = 0; m < 4; ++m) { bf16_t* rowp = O + (size_t)(row0 + ai * HALF + m * 16) * ldc + col0;
#pragma unroll
                for (int bj = 0; bj < 2; ++bj) { f32x4 v0 = acc[ai][bj][m][0], v1 = acc[ai][bj][m][1];
#if EPI_RELU_ASM
                    u32x4 w;
                    { const f32x2 a = relu2_pk(v0[0], v0[1]), b = relu2_pk(v0[2], v0[3]), c = relu2_pk(v1[0], v1[1]), d = relu2_pk(v1[2], v1[3]);
                      w.x = cvt_pk_bf16(a[0], a[1]); w.y = cvt_pk_bf16(b[0], b[1]); w.z = cvt_pk_bf16(c[0], c[1]); w.w = cvt_pk_bf16(d[0], d[1]); }
#else
#pragma unroll
                    for (int e = 0; e < 4; ++e) { v0[e] = v0[e] > 0.f ? v0[e] : 0.f; v1[e] = v1[e] > 0.f ? v1[e] : 0.f; }
                    v0 = v0 * v0; v1 = v1 * v1;
                    u32x4 w; w.x = cvt_pk_bf16(v0[0], v0[1]); w.y = cvt_pk_bf16(v0[2], v0[3]); w.z = cvt_pk_bf16(v1[0], v1[1]); w.w = cvt_pk_bf16(v1[2], v1[3]);
#endif
                    st16_wt(rowp + bj * 32, w); } }
    }
};
struct EpiBf16 {
    static constexpr bool PERM = true, ADJ = true, AFTER_DRAIN = false;
    bf16_t* O; int ldc;
    __device__ __forceinline__ void operator()(const f32x4 (&acc)[2][2][4][2], const Unit& u, int wr, int wc, int fr, int fq) const {
        const int row0 = u.pm * BM + wr * 64 + fr, col0 = u.pn * BM + wc * 64 + 8 * fq;
#pragma unroll
        for (int ai = 0; ai < 2; ++ai)
#pragma unroll
            for (int m = 0; m < 4; ++m) { bf16_t* rowp = O + (size_t)(row0 + ai * HALF + m * 16) * ldc + col0;
#pragma unroll
                for (int bj = 0; bj < 2; ++bj) { const f32x4 v0 = acc[ai][bj][m][0], v1 = acc[ai][bj][m][1];
                    u32x4 w; w.x = cvt_pk_bf16(v0[0], v0[1]); w.y = cvt_pk_bf16(v0[2], v0[3]); w.z = cvt_pk_bf16(v1[0], v1[1]); w.w = cvt_pk_bf16(v1[2], v1[3]);
                    st16_wt(rowp + bj * 32, w); } }
    }
};
struct EpiInProj {
    static constexpr bool PERM = true, ADJ = true, AFTER_DRAIN = false;
    bf16_t* Z; float* out; int layer;
    __device__ __forceinline__ void operator()(const f32x4 (&acc)[2][2][4][2], const Unit& u, int wr, int wc, int fr, int fq) const {
        const int row0 = u.pm * BM + wr * 64 + fr, col0 = u.pn * BM + wc * 64 + 8 * fq;
#pragma unroll
        for (int ai = 0; ai < 2; ++ai)
#pragma unroll
            for (int m = 0; m < 4; ++m) { bf16_t* rowp = Z + (size_t)(row0 + ai * HALF + m * 16) * X_DIN + col0;
#pragma unroll
                for (int bj = 0; bj < 2; ++bj) { const f32x4 v0 = acc[ai][bj][m][0], v1 = acc[ai][bj][m][1];
                    u32x4 w; w.x = cvt_pk_bf16(v0[0], v0[1]); w.y = cvt_pk_bf16(v0[2], v0[3]); w.z = cvt_pk_bf16(v1[0], v1[1]); w.w = cvt_pk_bf16(v1[2], v1[3]);
                    st16_wt(rowp + bj * 32, w); } }
        const int pn = u.pn, pm = u.pm;
        const bool rows_state = (pm == 32) || ((pm & 7) >= 6);
        const bool cols_state = (pn >= 2 && pn <= 6) || (pn >= 13);
        if (rows_state && cols_state) {
            const int L = layer;
#pragma unroll
            for (int ai = 0; ai < 2; ++ai)
#pragma unroll
                for (int m = 0; m < 4; ++m) {
                    const int row = row0 + ai * HALF + m * 16;
                    const bool samp = row >= X_MP;
                    int b, t;
                    if (!samp) { b = row >> 11; t = row & 2047; } else { const int rs = row - X_MP; b = rs >> 4; t = rs & 15; }
                    const bool rowok = row < X_MP + X_MS;
#pragma unroll
                    for (int bj = 0; bj < 2; ++bj) {
                        const int col = col0 + bj * 32;
                        float* dst = nullptr;
                        if (pn == 2) {
                            const bool isV = col >= 640; const int c = col - (isV ? 640 : 512);
                            if (!samp) { if (t >= 1920) dst = out + (isV ? O_SVP : O_SKP) + ((size_t)(L * 4 + b) * 128 + (t - 1920)) * 128 + c; }
                            else dst = out + (isV ? O_SVS : O_SKS) + ((size_t)(L * 8 + b) * 16 + t) * 128 + c;
                        } else if (pn <= 6) {
                            const int ch = col - 768;
                            if (!samp) { if (t >= 2045) dst = out + O_LCP + ((size_t)(L * 4 + b) * 3 + (t - 2045)) * 1024 + ch; }
                            else if (t >= 13) dst = out + O_LCS + ((size_t)(L * 8 + b) * 3 + (t - 13)) * 1024 + ch;
                        } else {
                            const bool isV = pn >= 15; const int c = col - (isV ? 3840 : 3328);
                            if (!samp) { if (t >= 1536) dst = out + (isV ? O_BVP : O_BKP) + ((size_t)(L * 4 + b) * 512 + (t - 1536)) * 512 + c; }
                            else dst = out + (isV ? O_BVS : O_BKS) + ((size_t)(L * 8 + b) * 16 + t) * 512 + c;
                        }
                        if (dst != nullptr && rowok) { *(f32x4*)dst = acc[ai][bj][m][0]; *(f32x4*)(dst + 4) = acc[ai][bj][m][1]; }
                    }
                }
        }
    }
};

struct PanelRms {
    unsigned long long* xbuf;
    unsigned* cnt;
    unsigned* tmo;
    unsigned code;
    __device__ __forceinline__ void run(const f32x4 (&st)[2][4], const Unit& u, int wr, int wc, int fr, int fq, PG8_LAS unsigned char* lds, int wid, int lane) const {
        typedef float f32x2v __attribute__((ext_vector_type(2)));
        PG8_LAS f32x4* P = (PG8_LAS f32x4*)lds;
        PG8_LAS f32x2v* S = (PG8_LAS f32x2v*)(lds + 16384);
#pragma unroll
        for (int ai = 0; ai < 2; ++ai)
#pragma unroll
            for (int m = 0; m < 4; ++m) if (fq == 0) P[(ai * HALF + wr * 64 + m * 16 + fr) * 4 + wc] = st[ai][m];
        asm volatile("s_waitcnt lgkmcnt(0)" ::: "memory"); __builtin_amdgcn_s_barrier(); asm volatile("" ::: "memory");
        const int row = wid * 32 + (lane & 31);
        if (lane < 32) {
            const f32x4 a = P[row * 4 + 0], b = P[row * 4 + 1], c = P[row * 4 + 2], d = P[row * 4 + 3];
            const f32x4 s = (a + b) + (c + d);
            unsigned long long* slot = xbuf + ((size_t)(u.pm * BM + row) * 8 + u.pn) * 2;
            __hip_atomic_store(slot, ((unsigned long long)__float_as_uint(s[1]) << 32) | __float_as_uint(s[0]), __ATOMIC_RELAXED, __HIP_MEMORY_SCOPE_AGENT);
            __hip_atomic_store(slot + 1, ((unsigned long long)__float_as_uint(s[3]) << 32) | __float_as_uint(s[2]), __ATOMIC_RELAXED, __HIP_MEMORY_SCOPE_AGENT);
        }
        asm volatile("s_waitcnt vmcnt(0)" ::: "memory");
        if (lane == 0) __hip_atomic_fetch_add(cnt + 64 * u.pm, 1u, __ATOMIC_RELAXED, __HIP_MEMORY_SCOPE_AGENT);
        if (wid == 0) {
            const unsigned long long t0 = __builtin_amdgcn_s_memrealtime(); const unsigned want = 64u;
            for (;;) {
                if ((unsigned)__builtin_amdgcn_readfirstlane(__hip_atomic_load(cnt + 64 * u.pm, __ATOMIC_RELAXED, __HIP_MEMORY_SCOPE_AGENT)) >= want) break;
                if (__builtin_amdgcn_s_memrealtime() - t0 > 2000000ull) {
                    if (lane == 0) { unsigned expect = 0u; __hip_atomic_compare_exchange_strong(tmo + 1, &expect, code | (unsigned)(u.pm & 0xff), __ATOMIC_RELAXED, __ATOMIC_RELAXED, __HIP_MEMORY_SCOPE_AGENT);
                                     __hip_atomic_store(tmo, 1u, __ATOMIC_RELAXED, __HIP_MEMORY_SCOPE_AGENT); }
                    break; }
                __builtin_amdgcn_s_sleep(2);
            }
            __builtin_amdgcn_fence(__ATOMIC_ACQUIRE, "agent");
        }
        asm volatile("s_waitcnt vmcnt(0) lgkmcnt(0)" ::: "memory"); __builtin_amdgcn_s_barrier(); asm volatile("" ::: "memory");
        if (lane < 32) {
            const unsigned long long* slot = xbuf + (size_t)(u.pm * BM + row) * 8 * 2; float s1 = 0.f, s2 = 0.f, s3 = 0.f, s4 = 0.f;
#pragma unroll
            for (int t = 0; t < 8; ++t) { const unsigned long long w0 = __hip_atomic_load(slot + 2 * t, __ATOMIC_RELAXED, __HIP_MEMORY_SCOPE_AGENT), w1 = __hip_atomic_load(slot + 2 * t + 1, __ATOMIC_RELAXED, __HIP_MEMORY_SCOPE_AGENT);
                s1 += __uint_as_float((unsigned)w0); s2 += __uint_as_float((unsigned)(w0 >> 32)); s3 += __uint_as_float((unsigned)w1); s4 += __uint_as_float((unsigned)(w1 >> 32)); }
            const float rt = 1.0f / sqrtf(s1 * (1.0f / X_DM) + 1e-6f);
            const float q = s2 + 2.0f * rt * s3 + rt * rt * s4;
            S[row] = (f32x2v){rt, 1.0f / sqrtf(fmaxf(q, 0.f) * (1.0f / X_DM) + 1e-6f)};
        }
        asm volatile("s_waitcnt lgkmcnt(0)" ::: "memory"); __builtin_amdgcn_s_barrier(); asm volatile("" ::: "memory");
    }
};
struct EpiFuse {
    static constexpr bool PERM = false, ADJ = false, AFTER_DRAIN = true;
    const float* xin; float* xout; bf16_t* H;
    const float* vc; const float* ve; const float* vf;
    int bstride;
    PanelRms st;
    __device__ __forceinline__ void fused(f32x4 (&acc)[2][2][4][2], const Unit& u, int wr, int wc, int fr, int fq, PG8_LAS unsigned char* lds, int wid, int lane) const {
        typedef float f32x2v __attribute__((ext_vector_type(2))); typedef unsigned u32x2v __attribute__((ext_vector_type(2)));
        PG8_LAS unsigned char* xl = lds + 20480;
        PG8_LAS unsigned* tp = (PG8_LAS unsigned*)xl + (wid * 64 + lane);
        PG8_LAS unsigned* tq = tp + 32 * 512; asm volatile("" : "+v"(tq));
#define TPW(w) (((w) < 32) ? tp[(w) * 512] : tq[((w) - 32) * 512])
        const PG8_LAS f32x2v* S = (const PG8_LAS f32x2v*)(lds + 16384);
        const int col0 = u.pn * BM + wc * 32 + 4 * fq;
        const size_t boff = (size_t)(u.pm >> 3) * bstride + col0;
        float s1[2][4];
#pragma unroll
        for (int ai = 0; ai < 2; ++ai)
#pragma unroll
            for (int m = 0; m < 4; ++m) { float q = 0.f;
#pragma unroll
                for (int bj = 0; bj < 2; ++bj)
#pragma unroll
                    for (int n = 0; n < 2; ++n) { const f32x4 t = acc[ai][bj][m][n]; q += (t[0] * t[0] + t[1] * t[1]) + (t[2] * t[2] + t[3] * t[3]);
                        const int w = ((ai * 4 + m) * 4 + bj * 2 + n) * 2; TPW(w) = cvt_pk_bf16(t[0], t[1]); TPW(w + 1) = cvt_pk_bf16(t[2], t[3]); }
                s1[ai][m] = q; asm volatile("" ::: "memory"); __builtin_amdgcn_sched_barrier(0); }
        asm volatile("s_waitcnt lgkmcnt(0)" ::: "memory"); __builtin_amdgcn_sched_barrier(0);
        f32x4 cv[2][2];
#pragma unroll
        for (int bj = 0; bj < 2; ++bj)
#pragma unroll
            for (int n = 0; n < 2; ++n) cv[bj][n] = *(const f32x4*)(vc + boff + bj * HALF + n * 16);
        f32x4 stt[2][4];
#pragma unroll
        for (int ai = 0; ai < 2; ++ai) {
            f32x4 xv[4][2][2];
#pragma unroll
            for (int m = 0; m < 4; ++m) { const size_t off = (size_t)(u.pm * BM + ai * HALF + wr * 64 + m * 16 + fr) * X_DM + col0;
#pragma unroll
                for (int bj = 0; bj < 2; ++bj)
#pragma unroll
                    for (int n = 0; n < 2; ++n) xv[m][bj][n] = *(const f32x4*)(xin + off + bj * HALF + n * 16); }
#pragma unroll
            for (int m = 0; m < 4; ++m) { float a1 = s1[ai][m], s2 = 0.f, s3 = 0.f, s4 = 0.f;
#pragma unroll
                for (int bj = 0; bj < 2; ++bj)
#pragma unroll
                    for (int n = 0; n < 2; ++n) { const int w = ((ai * 4 + m) * 4 + bj * 2 + n) * 2; const unsigned p0 = TPW(w), p1 = TPW(w + 1);
                        const f32x4 t = {__uint_as_float(p0 << 16), __uint_as_float(p0 & 0xffff0000u), __uint_as_float(p1 << 16), __uint_as_float(p1 & 0xffff0000u)};
                        const f32x4 x = xv[m][bj][n]; const f32x4 ct = cv[bj][n] * t;
                        s2 += (x[0] * x[0] + x[1] * x[1]) + (x[2] * x[2] + x[3] * x[3]);
                        s3 += (x[0] * ct[0] + x[1] * ct[1]) + (x[2] * ct[2] + x[3] * ct[3]); s4 += (ct[0] * ct[0] + ct[1] * ct[1]) + (ct[2] * ct[2] + ct[3] * ct[3]); }
                a1 += __shfl_xor(a1, 16); a1 += __shfl_xor(a1, 32); s2 += __shfl_xor(s2, 16); s2 += __shfl_xor(s2, 32);
                s3 += __shfl_xor(s3, 16); s3 += __shfl_xor(s3, 32); s4 += __shfl_xor(s4, 16); s4 += __shfl_xor(s4, 32);
                stt[ai][m] = (f32x4){a1, s2, s3, s4}; }
            asm volatile("" ::: "memory");
        }
        st.run(stt, u, wr, wc, fr, fq, lds, wid, lane);
        f32x4 ev[2][2], fv[2][2];
#pragma unroll
        for (int bj = 0; bj < 2; ++bj)
#pragma unroll
            for (int n = 0; n < 2; ++n) { ev[bj][n] = H ? *(const f32x4*)(ve + boff + bj * HALF + n * 16) : (f32x4){0.f, 0.f, 0.f, 0.f}; fv[bj][n] = H ? *(const f32x4*)(vf + boff + bj * HALF + n * 16) : (f32x4){0.f, 0.f, 0.f, 0.f}; }
#pragma unroll
        for (int ai = 0; ai < 2; ++ai) {
            f32x4 xv[4][2][2];
#pragma unroll
            for (int m = 0; m < 4; ++m) { const size_t off = (size_t)(u.pm * BM + ai * HALF + wr * 64 + m * 16 + fr) * X_DM + col0;
#pragma unroll
                for (int bj = 0; bj < 2; ++bj)
#pragma unroll
                    for (int n = 0; n < 2; ++n) xv[m][bj][n] = *(const f32x4*)(xin + off + bj * HALF + n * 16); }
#pragma unroll
            for (int m = 0; m < 4; ++m) { const int r = ai * HALF + wr * 64 + m * 16 + fr; const f32x2v sr = S[r]; const size_t off = (size_t)(u.pm * BM + r) * X_DM + col0;
#pragma unroll
                for (int bj = 0; bj < 2; ++bj)
#pragma unroll
                    for (int n = 0; n < 2; ++n) { const int w = ((ai * 4 + m) * 4 + bj * 2 + n) * 2; const unsigned p0 = TPW(w), p1 = TPW(w + 1);
                        const f32x4 t = {__uint_as_float(p0 << 16), __uint_as_float(p0 & 0xffff0000u), __uint_as_float(p1 << 16), __uint_as_float(p1 & 0xffff0000u)};
                        const f32x4 x1 = xv[m][bj][n] + (t * sr.x) * cv[bj][n];
                        *(f32x4*)(xout + off + bj * HALF + n * 16) = x1;
                        if (H) { const f32x4 h = x1 * sr.y * ev[bj][n] + fv[bj][n]; u32x2v w2; w2.x = cvt_pk_bf16(h[0], h[1]); w2.y = cvt_pk_bf16(h[2], h[3]); *(u32x2v*)(H + off + bj * HALF + n * 16) = w2; } } }
            asm volatile("" ::: "memory");
        }
    }
};
#undef TPW
template <class Epi, class Sched, bool ALIGN_EPI = false, bool SP2 = false>
__device__ __forceinline__ void gemm_phase(PG8_LAS unsigned char* lds, const Gemm g, const Sched& S, const Epi& E, int tid_in) {
    int tid_ = tid_in; asm volatile("" : "+v"(tid_));
    const int tid = tid_, wid = __builtin_amdgcn_readfirstlane(tid >> 6), lane = tid & 63, wr = wid >> 2, wc = wid & 3, fr = lane & 15, fq = lane >> 4;
    int K_ = g.K; asm volatile("" : "+s"(K_));
    const int K = K_, nt = K / BK;
    unsigned voffA[2], voffB[2];
#pragma unroll
    for (int i = 0; i < 2; ++i) { int R, C; stage_rc(tid * 16 + i * 8192, R, C); const int Rb = Epi::ADJ ? (64 * (R >> 5) + perm32(R & 31)) : (Epi::PERM ? ((R & ~31) + perm32(R & 31)) : R);
        voffA[i] = (unsigned)(R * K + C) * 2u; voffB[i] = (unsigned)(Rb * K + C) * 2u; }
    const size_t kstep = (size_t)(BK * 2);
    const size_t hstep = (size_t)HALF * K * 2;
    const size_t bhstep = Epi::ADJ ? (size_t)32 * K * 2 : hstep;
    const size_t tstep = 2 * hstep;
    const unsigned ldsw = (unsigned)wid * 1024u;
    const int aoff = lds_byte(wr * 64 + fr, fq * 8), boff = lds_byte(wc * 32 + fr, fq * 8);
#define PG8_SA(b, h) (((b) * 2 + (h)) * HTB)
#define PG8_SB(b, h) ((4 + (b) * 2 + (h)) * HTB)
#define PG8_STAGE(bufoff, gbase, voff) do { _Pragma("unroll") for (int _i = 0; _i < 2; ++_i) \
        __builtin_amdgcn_global_load_lds((const unsigned*)((const char*)(gbase) + (voff)[_i]), (PG8_LAS unsigned*)(lds + (bufoff) + ldsw + _i * 8192), 16, 0, 0); } while (0)
#define PG8_LDA(dst, b, h) do { _Pragma("unroll") for (int m = 0; m < 4; ++m) _Pragma("unroll") for (int k = 0; k < 2; ++k) dst[m][k] = *(const PG8_LAS bf16x8*)(lds + PG8_SA(b, h) + aoff + m * 2048 + k * 1024); } while (0)
#define PG8_LDB(dst, b, h) do { _Pragma("unroll") for (int n = 0; n < 2; ++n) _Pragma("unroll") for (int k = 0; k < 2; ++k) dst[n][k] = *(const PG8_LAS bf16x8*)(lds + PG8_SB(b, h) + boff + n * 2048 + k * 1024); } while (0)
#define PG8_MMA(ai, bj, At, Bt) do { __builtin_amdgcn_s_setprio(1); _Pragma("unroll") for (int m = 0; m < 4; ++m) _Pragma("unroll") for (int n = 0; n < 2; ++n) _Pragma("unroll") for (int k = 0; k < 2; ++k) \
        acc[ai][bj][m][n] = __builtin_amdgcn_mfma_f32_16x16x32_bf16(Bt[n][k], At[m][k], acc[ai][bj][m][n], 0, 0, 0); __builtin_amdgcn_s_setprio(0); } while (0)
#define PG8_WAIT_V(n) asm volatile("s_waitcnt vmcnt(" #n ")" ::: "memory")
#define PG8_WAIT_L(n) asm volatile("s_waitcnt lgkmcnt(" #n ")" ::: "memory")
#define PG8_BAR __builtin_amdgcn_s_barrier()
#define PG8_SCHED __builtin_amdgcn_sched_barrier(0)
    Unit cur, nxt; int ui = 0;
    if (!S.next(0, cur)) return;
    f32x4 acc[2][2][4][2];
#pragma unroll
    for (int a = 0; a < 2; ++a)
#pragma unroll
        for (int b = 0; b < 2; ++b)
#pragma unroll
            for (int m = 0; m < 4; ++m)
#pragma unroll
                for (int n = 0; n < 2; ++n) acc[a][b][m][n] = (f32x4){0.f, 0.f, 0.f, 0.f};
    bf16x8 At[4][2], B0[2][2], B1[2][2];
    const char* cA = (const char*)g.A + (size_t)cur.pm * tstep; const char* cB = (const char*)g.Bt + (size_t)cur.pn * tstep;
    S.a_ready(cur);
    if constexpr (SP2) {
        PG8_STAGE(PG8_SB(0, 0), cB, voffB); PG8_STAGE(PG8_SB(0, 1), cB + bhstep, voffB); PG8_STAGE(PG8_SA(0, 0), cA, voffA); PG8_STAGE(PG8_SA(0, 1), cA + hstep, voffA);
        if (wr == 1) PG8_BAR;
        PG8_WAIT_V(2); PG8_BAR;
        PG8_STAGE(PG8_SB(1, 0), cB + kstep, voffB); PG8_STAGE(PG8_SA(1, 0), cA + kstep, voffA); PG8_STAGE(PG8_SB(1, 1), cB + bhstep + kstep, voffB);
        PG8_WAIT_V(6); PG8_BAR;
    } else {
        PG8_STAGE(PG8_SB(0, 0), cB, voffB); PG8_STAGE(PG8_SA(0, 0), cA, voffA); PG8_STAGE(PG8_SB(0, 1), cB + bhstep, voffB); PG8_STAGE(PG8_SA(0, 1), cA + hstep, voffA);
        if (wr == 1) PG8_BAR;
        PG8_WAIT_V(4); PG8_BAR;
        PG8_STAGE(PG8_SB(1, 0), cB + kstep, voffB); PG8_STAGE(PG8_SA(1, 0), cA + kstep, voffA); PG8_STAGE(PG8_SB(1, 1), cB + bhstep + kstep, voffB);
        PG8_WAIT_V(6); PG8_BAR;
    }
    for (;;) {
        const bool has_next = S.next(ui + 1, nxt);
        const char* nA = has_next ? (const char*)g.A + (size_t)nxt.pm * tstep : cA; const char* nB = has_next ? (const char*)g.Bt + (size_t)nxt.pn * tstep : cB;
        for (int t = 0; t < nt; t += 2) {
            const bool last = (t == nt - 2);
            const char* a1 = cA + (size_t)(t + 1) * kstep;
            const char* a2 = last ? nA : cA + (size_t)(t + 2) * kstep; const char* b2 = last ? nB : cB + (size_t)(t + 2) * kstep;
            const char* a3 = a2 + kstep; const char* b3 = b2 + kstep;
            if (last && has_next) S.a_ready(nxt);
            if constexpr (SP2) {
            PG8_LDB(B0, 0, 0); PG8_LDB(B1, 0, 1); PG8_SCHED; PG8_LDA(At, 0, 0); PG8_STAGE(PG8_SA(1, 1), a1 + hstep, voffA);
            PG8_WAIT_V(8); PG8_WAIT_L(0); PG8_BAR; PG8_MMA(0, 0, At, B0); PG8_MMA(0, 1, At, B1); PG8_BAR; PG8_SCHED;
            PG8_LDA(At, 0, 1); PG8_STAGE(PG8_SB(0, 0), b2, voffB); PG8_STAGE(PG8_SB(0, 1), b2 + bhstep, voffB); PG8_STAGE(PG8_SA(0, 0), a2, voffA);
            PG8_WAIT_V(8); PG8_WAIT_L(0); PG8_BAR; PG8_MMA(1, 0, At, B0); PG8_MMA(1, 1, At, B1); PG8_BAR; PG8_SCHED;
            PG8_LDB(B0, 1, 0); PG8_LDB(B1, 1, 1); PG8_SCHED; PG8_LDA(At, 1, 0); PG8_STAGE(PG8_SA(0, 1), a2 + hstep, voffA);
            PG8_WAIT_V(8); PG8_WAIT_L(0); PG8_BAR; PG8_MMA(0, 0, At, B0); PG8_MMA(0, 1, At, B1); PG8_BAR; PG8_SCHED;
            PG8_LDA(At, 1, 1); PG8_STAGE(PG8_SB(1, 0), b3, voffB); PG8_STAGE(PG8_SB(1, 1), b3 + bhstep, voffB); PG8_STAGE(PG8_SA(1, 0), a3, voffA);
            PG8_WAIT_V(8); PG8_WAIT_L(0); PG8_BAR; PG8_MMA(1, 0, At, B0); PG8_MMA(1, 1, At, B1); PG8_BAR; PG8_SCHED;
            } else {
            PG8_LDB(B0, 0, 0); PG8_SCHED; PG8_LDA(At, 0, 0); PG8_STAGE(PG8_SA(1, 1), a1 + hstep, voffA);
            PG8_WAIT_L(8); PG8_BAR; PG8_WAIT_L(0); PG8_MMA(0, 0, At, B0); PG8_BAR; PG8_SCHED;
            PG8_LDB(B1, 0, 1); PG8_STAGE(PG8_SB(0, 0), b2, voffB);
            PG8_BAR; PG8_WAIT_L(0); PG8_MMA(0, 1, At, B1); PG8_BAR;
            PG8_LDA(At, 0, 1); PG8_STAGE(PG8_SA(0, 0), a2, voffA);
            PG8_BAR; PG8_WAIT_L(0); PG8_MMA(1, 0, At, B0); PG8_BAR; PG8_SCHED;
            PG8_STAGE(PG8_SB(0, 1), b2 + bhstep, voffB);
            PG8_WAIT_V(6); PG8_BAR; PG8_MMA(1, 1, At, B1); PG8_BAR;
            PG8_LDB(B0, 1, 0); PG8_SCHED; PG8_LDA(At, 1, 0); PG8_STAGE(PG8_SA(0, 1), a2 + hstep, voffA);
            PG8_WAIT_L(8); PG8_BAR; PG8_WAIT_L(0); PG8_MMA(0, 0, At, B0); PG8_BAR; PG8_SCHED;
            PG8_LDB(B1, 1, 1); PG8_STAGE(PG8_SB(1, 0), b3, voffB);
            PG8_BAR; PG8_WAIT_L(0); PG8_MMA(0, 1, At, B1); PG8_BAR;
            PG8_LDA(At, 1, 1); PG8_STAGE(PG8_SA(1, 0), a3, voffA);
            PG8_BAR; PG8_WAIT_L(0); PG8_MMA(1, 0, At, B0); PG8_BAR; PG8_SCHED;
            PG8_STAGE(PG8_SB(1, 1), b3 + bhstep, voffB);
            PG8_WAIT_V(6); PG8_BAR; PG8_MMA(1, 1, At, B1); PG8_BAR;
            }
        }
        if constexpr (ALIGN_EPI) { if (wr == 0) PG8_BAR; }
        if constexpr (!Epi::AFTER_DRAIN) { E(acc, cur, wr, wc, fr, fq); S.done(cur); }
        if (!has_next) break;
#pragma unroll
        for (int a = 0; a < 2; ++a)
#pragma unroll
            for (int b = 0; b < 2; ++b)
#pragma unroll
                for (int m = 0; m < 4; ++m)
#pragma unroll
                    for (int n = 0; n < 2; ++n) acc[a][b][m][n] = (f32x4){0.f, 0.f, 0.f, 0.f};
        cur = nxt; cA = nA; cB = nB; ++ui;
        if constexpr (ALIGN_EPI) { if (wr == 1) PG8_BAR; }
    }
    PG8_WAIT_V(0);
    if constexpr (!ALIGN_EPI) { if (wr == 0) PG8_BAR; }
    PG8_BAR;
    if constexpr (Epi::AFTER_DRAIN) { E.fused(acc, cur, wr, wc, fr, fq, lds, wid, lane); S.done(cur); }
#undef PG8_SA
#undef PG8_SB
#undef PG8_STAGE
#undef PG8_LDA
#undef PG8_LDB
#undef PG8_MMA
#undef PG8_WAIT_V
#undef PG8_WAIT_L
#undef PG8_BAR
#undef PG8_SCHED
}
}
#define GAS __attribute__((address_space(1)))
#define LAS __attribute__((address_space(3)))
typedef unsigned short bf16;
typedef unsigned v4u __attribute__((ext_vector_type(4)));
typedef float f32x4 __attribute__((ext_vector_type(4)));
typedef short bf16x8 __attribute__((ext_vector_type(8)));
typedef GAS unsigned gu32;
typedef GAS unsigned long long gu64;
#define RLX_AGENT __ATOMIC_RELAXED, __HIP_MEMORY_SCOPE_AGENT
#define LDS_WAIT() asm volatile("s_waitcnt lgkmcnt(0)" ::: "memory")
#define VM_WAIT() asm volatile("s_waitcnt vmcnt(0)" ::: "memory")
__device__ __forceinline__ unsigned long long rt() { return __builtin_amdgcn_s_memrealtime(); }
__device__ __forceinline__ unsigned f2bf(float f) { unsigned u = __builtin_bit_cast(unsigned, f); return (u + 0x7fffu + ((u >> 16) & 1u)) >> 16; }
__device__ __forceinline__ unsigned pk2(float lo, float hi) { return f2bf(lo) | (f2bf(hi) << 16); }
#define XB_TMO      128
#define XB_XCNT(j)  (256  + 64 * (j))
#define XB_XSUB(j)  (1280 + 64 * (j))
#define XB_XGEN(j)  (2304 + 64 * (j))
#define XB_TOP      3328
#define XB_TOPGEN   3392
#define XCD_BAR_WORDS 3456
#define XB_SPIN_CAP (1u << 18)

__device__ __forceinline__ unsigned xb_ld(unsigned* p)              { return __hip_atomic_load(p, __ATOMIC_RELAXED, __HIP_MEMORY_SCOPE_AGENT); }
__device__ __forceinline__ unsigned xb_add(unsigned* p, unsigned v) { return __hip_atomic_fetch_add(p, v, __ATOMIC_RELAXED, __HIP_MEMORY_SCOPE_AGENT); }
__device__ __forceinline__ unsigned xb_xcc_id() { return (unsigned)__builtin_amdgcn_s_getreg((3 << 11) | 20) & 0xFu; }
#define XB_SPIN(cond, bar) do { unsigned _sp = 0; while (cond) { __builtin_amdgcn_s_sleep(1); \
    if ((++_sp & 255u) == 0u) { if (xb_ld(&(bar)[XB_TMO])) break; if (_sp > XB_SPIN_CAP) { atomicAdd(&(bar)[XB_TMO], 1u); break; } } } } while (0)

struct XcdBarrier {
    unsigned* bar; unsigned x;
    volatile LAS unsigned* st;
};

__device__ __forceinline__ XcdBarrier xcd_barrier_post(unsigned* bar, volatile LAS unsigned* st, bool t0  ) {
    XcdBarrier b; b.bar = bar; b.x = xb_xcc_id(); b.st = st;
    if (t0) (void)xb_add(&bar[XB_XCNT(b.x)], 1u);
    return b;
}
__device__ __forceinline__ void xcd_barrier_complete(unsigned* bar, unsigned x, unsigned& nloc, unsigned& nx) {
    const unsigned G = gridDim.x * gridDim.y * gridDim.z;
    unsigned sum, cnt, mine, sp = 0u;
    for (;;) {
        sum = 0u; cnt = 0u; mine = 0u;
#pragma unroll
        for (unsigned j = 0; j < 16; ++j) { const unsigned c = xb_ld(&bar[XB_XCNT(j)]); sum += c; cnt += (c > 0u) ? 1u : 0u; mine = (j == x) ? c : mine; }
        if (sum == G) break;
        __builtin_amdgcn_s_sleep(1);
        if ((++sp & 255u) == 0u) { if (xb_ld(&bar[XB_TMO])) break; if (sp > XB_SPIN_CAP) { atomicAdd(&bar[XB_TMO], 1u); break; } }
    }
    nloc = mine > 0u ? mine : 1u; nx = cnt > 0u ? cnt : 1u;
}

__device__ __forceinline__ void xcd_barrier(const XcdBarrier& b, bool t0  ) {
    asm volatile("s_waitcnt vmcnt(0)" ::: "memory");
    __syncthreads();
    if (t0) {
        unsigned* bar = b.bar;
        __builtin_amdgcn_s_waitcnt(0);
        unsigned nloc = b.st[0], nx = b.st[1];
        if (nloc == 0u) { xcd_barrier_complete(bar, b.x, nloc, nx); b.st[0] = nloc; b.st[1] = nx; }
        const unsigned old = xb_add(&bar[XB_XSUB(b.x)], 1u);
        const unsigned gen = old / nloc;
        if (old + 1u == (gen + 1u) * nloc) {
            __builtin_amdgcn_fence(__ATOMIC_RELEASE, "agent");
            asm volatile("s_waitcnt vmcnt(0)" ::: "memory");
            const unsigned og = xb_add(&bar[XB_TOP], 1u);
            const unsigned tg = og / nx;
            if (og + 1u == (tg + 1u) * nx) xb_add(&bar[XB_TOPGEN], 1u);
            else XB_SPIN(xb_ld(&bar[XB_TOPGEN]) == tg, bar);
            __builtin_amdgcn_fence(__ATOMIC_ACQUIRE, "agent");
            xb_add(&bar[XB_XGEN(b.x)], 1u);
            asm volatile("s_waitcnt vmcnt(0)" ::: "memory");
        } else {
            XB_SPIN(xb_ld(&bar[XB_XGEN(b.x)]) == gen, bar);
            __builtin_amdgcn_fence(__ATOMIC_ACQUIRE, "agent");
            asm volatile("s_waitcnt vmcnt(0)" ::: "memory");
        }
    }
    __syncthreads();
}

#ifndef FUSE_THIN
#define FUSE_THIN 0
#endif
#ifndef TAIL_MODE
#define TAIL_MODE 0
#endif
#ifndef REP_BAR
#define REP_BAR 1
#endif
#ifndef SWA_ALL
#define SWA_ALL 1
#endif
#ifndef ATT_ROT
#define ATT_ROT 1
#endif
#ifndef P0_KH
#define P0_KH 64
#endif
#ifndef P0_NT_LD
#define P0_NT_LD 0
#endif
#ifndef P0_NT_ST
#define P0_NT_ST 0
#endif
#ifndef P0_DYN
#define P0_DYN 0
#endif
#ifndef COOP_SPLIT
#define COOP_SPLIT 1
#endif
#ifndef P0_DEEP
#define P0_DEEP 0
#endif
#ifndef P0_PROBE
#define P0_PROBE 0
#endif
#ifndef REP_P0M
#define REP_P0M 1
#endif
#ifndef REP_P0
#define REP_P0 1
#endif
#ifndef REP_A
#define REP_A 1
#endif
#ifndef REP_S
#define REP_S 1
#endif
#ifndef REP_B4
#define REP_B4 1
#endif
#ifndef REP_B1
#define REP_B1 1
#endif
#ifndef REP_B2
#define REP_B2 1
#endif
#ifndef REP_B3
#define REP_B3 1
#endif
#ifndef REP_C
#define REP_C 1
#endif
#ifndef REP_E
#define REP_E 1
#endif
#ifndef REP_F
#define REP_F 1
#endif
constexpr int DM = 2048, BP = 4, TP = 2048, MP = BP * TP, BS = 8, TS = 16, MS = BS * TS, MR = MP + MS, MT = 8448;
constexpr int DIN = 4352, DFF = 8192, NL = 4, NMOD = 6 * DM;
constexpr int C_QA = 0, C_KA = 512, C_VA = 640, C_XB = 768, C_GB = 1792, C_QC = 2816, C_KC = 3328, C_VC = 3840;
constexpr float RMS_EPS = 1e-6f, LOG2E = 1.4426950408889634f;
using pg8::O_YP; using pg8::O_YS; using pg8::O_LHP; using pg8::O_LHS; using pg8::O_END;
constexpr int NWAVES = 8;
constexpr size_t MiB = 1u << 20;
constexpr size_t WS_CTL = 0, CTL_ZERO_BYTES = 1 * MiB;
constexpr size_t WS_MOD = 1 * MiB;
constexpr size_t WS_WIN = 4 * MiB;
constexpr size_t WS_WOUT = 72 * MiB;
constexpr size_t WS_WUP = 104 * MiB;
constexpr size_t WS_WDN = 232 * MiB;
constexpr size_t WS_H = 360 * MiB;
constexpr size_t WS_Z = 393 * MiB;
constexpr size_t WS_MIX = 464 * MiB;
constexpr size_t WS_T = 497 * MiB;
constexpr size_t WS_F1 = 563 * MiB;
constexpr size_t WS_XCH = 695 * MiB;
constexpr size_t WS_XR = 703 * MiB;
constexpr size_t WS_END = 736 * MiB;
static_assert(WS_MOD + (size_t)NL * 12 * NMOD * 4 <= WS_WIN && WS_WIN + (size_t)NL * DIN * DM * 2 <= WS_WOUT && WS_WOUT + (size_t)NL * DM * DM * 2 <= WS_WUP &&
              WS_WUP + (size_t)NL * DFF * DM * 2 <= WS_WDN && WS_WDN + (size_t)NL * DFF * DM * 2 <= WS_H && WS_H + (size_t)MT * DM * 2 <= WS_Z &&
              WS_Z + (size_t)MT * DIN * 2 <= WS_MIX && WS_MIX + (size_t)MT * DM * 2 <= WS_T && WS_T + (size_t)MT * DM * 4 <= WS_F1 && WS_F1 + (size_t)MT * DFF * 2 <= WS_END, "d_ws map");
constexpr int CW_SEAM = 16384;
constexpr int CW_Q = 8192;
constexpr int CW_DQ = 9216;
constexpr int CW_BAR = 4096;
constexpr int RING_BYTES = 131072, SCR_BYTES = 163840 - 1024  , LDSCTL_OFF = SCR_BYTES, MISC_OFF = LDSCTL_OFF + 320, LDS_BYTES = 163840;

typedef float f32x16 __attribute__((ext_vector_type(16)));
typedef unsigned u32x2 __attribute__((ext_vector_type(2)));
__device__ __forceinline__ float bf2f(unsigned short b) { return __uint_as_float((unsigned)b << 16); }
__device__ __forceinline__ unsigned pkbf(float lo, float hi) { typedef float f2_t __attribute__((ext_vector_type(2))); typedef __bf16 b2_t __attribute__((ext_vector_type(2)));
    f2_t v = {lo, hi}; b2_t b = __builtin_convertvector(v, b2_t); return __builtin_bit_cast(unsigned, b); }
__device__ __forceinline__ v4u pack8(const f32x4 a, const f32x4 b) { v4u w; w.x = pkbf(a[0], a[1]); w.y = pkbf(a[2], a[3]); w.z = pkbf(b[0], b[1]); w.w = pkbf(b[2], b[3]); return w; }
__device__ __forceinline__ float dpp_add(float v, float w) { return v + w; }
template <int CTRL> __device__ __forceinline__ float dpp_mov(float v) { return __builtin_bit_cast(float, __builtin_amdgcn_update_dpp(0, __builtin_bit_cast(int, v), CTRL, 0xf, 0xf, true)); }
__device__ __forceinline__ float wave_sum(float v) {
    v += dpp_mov<0xB1>(v);
    v += dpp_mov<0x4E>(v);
    v += dpp_mov<0x141>(v);
    v += dpp_mov<0x140>(v);
    const int b = __builtin_bit_cast(int, v);
    const float r0 = __builtin_bit_cast(float, __builtin_amdgcn_readlane(b, 0)), r1 = __builtin_bit_cast(float, __builtin_amdgcn_readlane(b, 16));
    const float r2 = __builtin_bit_cast(float, __builtin_amdgcn_readlane(b, 32)), r3 = __builtin_bit_cast(float, __builtin_amdgcn_readlane(b, 48));
    return (r0 + r1) + (r2 + r3);
}
__device__ __forceinline__ int hw_lane() { int l; asm volatile("v_mbcnt_lo_u32_b32 %0, -1, 0\n\tv_mbcnt_hi_u32_b32 %0, -1, %0" : "=v"(l)); return l; }
__device__ __forceinline__ float fexp2(float x) { return __builtin_amdgcn_exp2f(x); }
__device__ __forceinline__ float frcp(float x) { return __builtin_amdgcn_rcpf(x); }
__device__ __forceinline__ float sigmoidf_fast(float x) { return frcp(1.0f + fexp2(-x * LOG2E)); }

__device__ __forceinline__ void p0_transpose_item(const float* W, int K, int N, bf16* WT, LAS float* scr, int item, int lane) {
    const int nblk = N / 32, kb = item / nblk, nb = item % nblk, k0 = 64 * kb, n0 = 32 * nb;
    const int lr = lane >> 3, lc = lane & 7;
    const float* src = W + (size_t)(k0 + lr) * N + n0 + 4 * lc;
    f32x4 v[8];
#pragma unroll
    for (int i = 0; i < 8; ++i) v[i] = *(const f32x4*)(src + (size_t)(8 * i) * N);
#pragma unroll
    for (int i = 0; i < 8; ++i) *(LAS f32x4*)(scr + (8 * i + lr) * 36 + 4 * lc) = v[i];
    LDS_WAIT(); asm volatile("" ::: "memory");
    const int c = lane & 7;
#pragma unroll
    for (int j = 0; j < 4; ++j) { const int n = (lane >> 3) + 8 * j; const LAS float* s = scr + (8 * c) * 36 + n;
        v4u o; o.x = pkbf(s[0 * 36], s[1 * 36]); o.y = pkbf(s[2 * 36], s[3 * 36]); o.z = pkbf(s[4 * 36], s[5 * 36]); o.w = pkbf(s[6 * 36], s[7 * 36]);
        *(GAS v4u*)(WT + (size_t)(n0 + n) * K + k0 + 8 * c) = o; }
    LDS_WAIT(); asm volatile("" ::: "memory");
}
constexpr int TP_PITCH = 520;
constexpr int P0_NI = P0_KH / 8;
__device__ __forceinline__ void p0_tile_load(const float* W, int N, int item, int tid, f32x4 (&pre)[P0_NI]) {
    const int nblk = N / 256, kb = item / nblk, nb = item % nblk;
    const float* src = W + (size_t)(P0_KH * kb + (tid >> 6)) * N + 256 * nb + 4 * (tid & 63);
#pragma unroll
    for (int i = 0; i < P0_NI; ++i) pre[i] = *(const f32x4*)(src + (size_t)(8 * i) * N);
}
__device__ __forceinline__ void p0_tile_store(const f32x4 (&pre)[P0_NI], int K, int N, bf16* WT, LAS unsigned char* scr, int item, int tid, bool dost = true) {
    const int nblk = N / 256, kb = item / nblk, nb = item % nblk;
    __syncthreads();
#pragma unroll
    for (int i = 0; i < P0_NI; ++i) { u32x2 w; w.x = pkbf(pre[i][0], pre[i][1]); w.y = pkbf(pre[i][2], pre[i][3]); *(LAS u32x2*)(scr + (8 * i + (tid >> 6)) * TP_PITCH + (tid & 63) * 8) = w; }
    __syncthreads();
    const int kc = tid % P0_NI;
#pragma unroll
    for (int j = 0; j < P0_NI / 2; ++j) { const int n = (tid / P0_NI) + (512 / P0_NI) * j; const LAS unsigned char* sp = scr + (8 * kc) * TP_PITCH + n * 2;
        unsigned short e[8];
#pragma unroll
        for (int q = 0; q < 8; ++q) e[q] = *(const LAS unsigned short*)(sp + q * TP_PITCH);
        v4u o; o.x = e[0] | ((unsigned)e[1] << 16); o.y = e[2] | ((unsigned)e[3] << 16); o.z = e[4] | ((unsigned)e[5] << 16); o.w = e[6] | ((unsigned)e[7] << 16);
        if (dost) *(GAS v4u*)(WT + (size_t)(256 * nb + n) * K + P0_KH * kb + 8 * kc) = o; }
}
__device__ __forceinline__ void p0_tile_store_pk(const u32x2 (&w)[8], int K, int N, bf16* WT, LAS unsigned char* scr, int item, int tid) {
    const int nblk = N / 256, kb = item / nblk, nb = item % nblk;
    __syncthreads();
#pragma unroll
    for (int i = 0; i < 8; ++i) *(LAS u32x2*)(scr + (8 * i + (tid >> 6)) * TP_PITCH + (tid & 63) * 8) = w[i];
    __syncthreads();
    const int kc = tid & 7;
#pragma unroll
    for (int j = 0; j < 4; ++j) { const int n = (tid >> 3) + 64 * j; const LAS unsigned char* sp = scr + (8 * kc) * TP_PITCH + n * 2;
        unsigned short e[8];
#pragma unroll
        for (int q = 0; q < 8; ++q) e[q] = *(const LAS unsigned short*)(sp + q * TP_PITCH);
        v4u o; o.x = e[0] | ((unsigned)e[1] << 16); o.y = e[2] | ((unsigned)e[3] << 16); o.z = e[4] | ((unsigned)e[5] << 16); o.w = e[6] | ((unsigned)e[7] << 16);
        *(GAS v4u*)(WT + (size_t)(256 * nb + n) * K + 64 * kb + 8 * kc) = o; }
}
constexpr int MODS_ITEMS = NL * (NMOD / 256);
template <bool DYN> __device__ __forceinline__ void p0_mods(unsigned* qm, volatile LAS unsigned* mq, LAS unsigned char* lds, const float* c_p, const float* c_s, const float* w_mod, const float* b_mod, const float* g_pre_mix, const float* g_post_mix, const float* g_pre_mlp, const float* g_post_mlp, float* MOD, int G, int bid, int tid) {
    const int lane = tid & 63, wave = __builtin_amdgcn_readfirstlane(tid >> 6);
    LAS float* S = (LAS float*)lds;
    LAS float* PS = (LAS float*)lds;
    for (int item0 = bid; DYN || (item0 < MODS_ITEMS * REP_P0M && (REP_P0M == 1 || bid < MODS_ITEMS)); item0 += (REP_P0M > 1 ? MODS_ITEMS : G)) { int item = item0 % MODS_ITEMS;
        __syncthreads();
        if (DYN) {
            if (tid == 0) mq[0] = __hip_atomic_fetch_add(qm, 1u, __ATOMIC_RELAXED, __HIP_MEMORY_SCOPE_AGENT);
            __syncthreads();
            item = __builtin_amdgcn_readfirstlane((int)mq[0]);
            if (item >= MODS_ITEMS * REP_P0M) break;
            item %= MODS_ITEMS;
        }
        for (int e = tid; e < 12 * 2048; e += 512) { const int row = e >> 11, k = e & 2047; const float c = row < 4 ? c_p[row * 2048 + k] : c_s[(row - 4) * 2048 + k]; S[k * 12 + row] = c / (1.0f + expf(-c)); }
        __syncthreads();
        const int l = item / (NMOD / 256), cg = item % (NMOD / 256), col0 = cg * 256;
        const float* W = w_mod + (size_t)l * DM * NMOD + col0 + 4 * lane;
        f32x4 acc[12];
#pragma unroll
        for (int r = 0; r < 12; ++r) acc[r] = (f32x4){0.f, 0.f, 0.f, 0.f};
        const int k0 = wave * 256;
        for (int kk = 0; kk < 256; kk += 8) {
            f32x4 w[8];
#pragma unroll
            for (int u = 0; u < 8; ++u) w[u] = *(const f32x4*)(W + (size_t)(k0 + kk + u) * NMOD);
#pragma unroll
            for (int u = 0; u < 8; ++u) {
                const LAS f32x4* sp = (const LAS f32x4*)(S + (k0 + kk + u) * 12); const f32x4 s0 = sp[0], s1 = sp[1], s2 = sp[2];
#pragma unroll
                for (int r = 0; r < 4; ++r) { acc[r] += w[u] * s0[r]; acc[4 + r] += w[u] * s1[r]; acc[8 + r] += w[u] * s2[r]; }
            }
        }
        __syncthreads();
#pragma unroll
        for (int r = 0; r < 12; ++r) *(LAS f32x4*)(PS + (wave * 12 + r) * 256 + 4 * lane) = acc[r];
        __syncthreads();
        for (int e = tid; e < 12 * 256; e += 512) { const int r = e >> 8, c = e & 255; float s = b_mod[(size_t)l * NMOD + col0 + c];
#pragma unroll
            for (int w = 0; w < 8; ++w) s += PS[(w * 12 + r) * 256 + c];
            const int col = col0 + c, j = col >> 11, d = col & 2047;
            if (j == 1) s = g_pre_mix[l * DM + d] * (1.0f + s); else if (j == 2) s = s * g_post_mix[l * DM + d]; else if (j == 4) s = g_pre_mlp[l * DM + d] * (1.0f + s); else if (j == 5) s = s * g_post_mlp[l * DM + d];
            MOD[((size_t)l * 12 + r) * NMOD + col] = s; }
    }
    __syncthreads();
}

#define ROW_LD_NT(dst, ptr) do { const f32x4* _p = (const f32x4*)(ptr) + lane; _Pragma("unroll") for (int _j = 0; _j < 8; ++_j) dst[_j] = __builtin_nontemporal_load(_p + 64 * _j); } while (0)
#define ROW_LD(dst, ptr) do { const f32x4* _p = (const f32x4*)(ptr) + 2 * lane; _Pragma("unroll") for (int _g = 0; _g < 4; ++_g) { dst[2 * _g] = _p[128 * _g]; dst[2 * _g + 1] = _p[128 * _g + 1]; } } while (0)
__device__ __forceinline__ float row_sumsq(const f32x4 (&v)[8]) { float s = 0.f;
#pragma unroll
    for (int j = 0; j < 8; ++j) s += (v[j][0] * v[j][0] + v[j][1] * v[j][1]) + (v[j][2] * v[j][2] + v[j][3] * v[j][3]);
    return wave_sum(s); }
#ifndef THIN_SC1
#define THIN_SC1 0
#endif
__device__ __forceinline__ void st16_row(v4u* p, v4u w) {
#if THIN_SC1
    asm volatile("global_store_dwordx4 %0, %1, off sc1\n\ts_nop 1" :: "v"(p), "v"(w) : "memory");
#else
    *p = w;
#endif
}
#define ROW_ST_BF16(ptr, src) do { v4u* _o = (v4u*)(ptr) + lane; _Pragma("unroll") for (int _g = 0; _g < 4; ++_g) { v4u _w; _w.x = pkbf(src[2 * _g][0], src[2 * _g][1]); _w.y = pkbf(src[2 * _g][2], src[2 * _g][3]); _w.z = pkbf(src[2 * _g + 1][0], src[2 * _g + 1][1]); _w.w = pkbf(src[2 * _g + 1][2], src[2 * _g + 1][3]); st16_row(_o + 64 * _g, _w); } } while (0)
#define ROW_LD_BF16(dst, ptr) do { const v4u* _p = (const v4u*)(ptr) + lane; _Pragma("unroll") for (int _g = 0; _g < 4; ++_g) { const v4u _w = _p[64 * _g]; \
    dst[2 * _g] = (f32x4){__uint_as_float(_w.x << 16), __uint_as_float(_w.x & 0xffff0000u), __uint_as_float(_w.y << 16), __uint_as_float(_w.y & 0xffff0000u)}; \
    dst[2 * _g + 1] = (f32x4){__uint_as_float(_w.z << 16), __uint_as_float(_w.z & 0xffff0000u), __uint_as_float(_w.w << 16), __uint_as_float(_w.w & 0xffff0000u)}; } } while (0)
__device__ __forceinline__ void norm_store(const f32x4 (&v)[8], float rstd, const f32x4 (&e)[8], const f32x4 (&f)[8], bf16* hrow, int lane) {
    f32x4 h[8];
#pragma unroll
    for (int j = 0; j < 8; ++j) h[j] = v[j] * rstd * e[j] + f[j];
    ROW_ST_BF16(hrow, h);
}
__device__ __forceinline__ void coop_row(const bf16* trow, const float* xr, const bf16* xr16, const float* cp, const float* ep, const float* fp, float* orow, bf16* orow16, bf16* hrow, LAS float* red, int tid) {
    const int lane = tid & 63, wave = tid >> 6;
    f32x4 x;
    if (xr16 != nullptr) { const u32x2 w = ((const u32x2*)xr16)[tid]; x = (f32x4){__uint_as_float(w.x << 16), __uint_as_float(w.x & 0xffff0000u), __uint_as_float(w.y << 16), __uint_as_float(w.y & 0xffff0000u)}; }
    else x = ((const f32x4*)xr)[tid];
    if (trow != nullptr) {
        const u32x2 w = ((const u32x2*)trow)[tid];
        const f32x4 t = {__uint_as_float(w.x << 16), __uint_as_float(w.x & 0xffff0000u), __uint_as_float(w.y << 16), __uint_as_float(w.y & 0xffff0000u)};
        const f32x4 c = ((const f32x4*)cp)[tid];
        const float ss = wave_sum((t[0] * t[0] + t[1] * t[1]) + (t[2] * t[2] + t[3] * t[3]));
        if (lane == 0) red[wave] = ss;
        __syncthreads();
        float tot = 0.f;
#pragma unroll
        for (int w2 = 0; w2 < 8; ++w2) tot += red[w2];
        const float rt_ = 1.0f / sqrtf(tot * (1.0f / DM) + RMS_EPS);
        x = x + (t * rt_) * c;
        if (orow16 != nullptr) { u32x2 o; o.x = pkbf(x[0], x[1]); o.y = pkbf(x[2], x[3]); ((u32x2*)orow16)[tid] = o; } else ((f32x4*)orow)[tid] = x;
    }
    if (hrow != nullptr) {
        const f32x4 e = ((const f32x4*)ep)[tid], f = ((const f32x4*)fp)[tid];
        const float ss = wave_sum((x[0] * x[0] + x[1] * x[1]) + (x[2] * x[2] + x[3] * x[3]));
        if (lane == 0) red[8 + wave] = ss;
        __syncthreads();
        float tot = 0.f;
#pragma unroll
        for (int w2 = 0; w2 < 8; ++w2) tot += red[8 + w2];
        const float rx = 1.0f / sqrtf(tot * (1.0f / DM) + RMS_EPS);
        const f32x4 h = x * rx * e + f;
        u32x2 o; o.x = pkbf(h[0], h[1]); o.y = pkbf(h[2], h[3]); ((u32x2*)hrow)[tid] = o;
    }
}
constexpr int CD_BASE = 1024, CD_C = 0, CD_E = 8192, CD_F = 16384, CD_T = 24576, CD_X = 28672;
__device__ __forceinline__ void coop_dma(LAS unsigned char* lds, const bf16* trow, const float* xr, const bf16* xr16, const float* cp, const float* ep, const float* fp, int wave, int lane) {
    LAS unsigned char* L = lds + CD_BASE + wave * 1024;
    if (cp != nullptr) __builtin_amdgcn_global_load_lds((const unsigned*)(cp + wave * 256 + lane * 4), (LAS unsigned*)(L + CD_C), 16, 0, 0);
    __builtin_amdgcn_global_load_lds((const unsigned*)(ep + wave * 256 + lane * 4), (LAS unsigned*)(L + CD_E), 16, 0, 0);
    __builtin_amdgcn_global_load_lds((const unsigned*)(fp + wave * 256 + lane * 4), (LAS unsigned*)(L + CD_F), 16, 0, 0);
    if (trow != nullptr && wave < 4) __builtin_amdgcn_global_load_lds((const unsigned*)(trow + wave * 512 + lane * 8), (LAS unsigned*)(L + CD_T), 16, 0, 0);
    if (xr != nullptr) __builtin_amdgcn_global_load_lds((const unsigned*)(xr + wave * 256 + lane * 4), (LAS unsigned*)(L + CD_X), 16, 0, 0);
    else if (wave >= 4) __builtin_amdgcn_global_load_lds((const unsigned*)(xr16 + (wave - 4) * 512 + lane * 8), (LAS unsigned*)(L - 4096 + CD_X), 16, 0, 0);
}
__device__ __forceinline__ int mod_row_of(int row) { return row < MP ? (row >> 11) : 4 + ((row - MP) >> 4); }

constexpr int AK_PITCH = 144, AV_PITCH = 80, AK_BYTES = 32 * AK_PITCH  , AV_BYTES = 64 * AV_PITCH  , ATBL_BYTES = 1088;
struct AttnWave { bool active; bool wr; const bf16* qrow; bf16* orow; int qpos; float m0, l0; };
#define MFMA32(a, b, c) __builtin_amdgcn_mfma_f32_32x32x16_bf16((a), (b), (c), 0, 0, 0)
#define MFMA16(a, b, c) __builtin_amdgcn_mfma_f32_16x16x32_bf16((a), (b), (c), 0, 0, 0)

template <int NTASK>
__device__ __forceinline__ void attn_stage_store(const v4u (&st)[NTASK], LAS unsigned char* kb, LAS unsigned char* vb, int gtid, int nthr) {
#pragma unroll
    for (int i = 0; i < NTASK; ++i) {
        const int task = gtid + nthr * i; const bool isV = task >= 256; const int idx = task & 255, key = idx >> 3, dc = idx & 7;
        if (!isV) { *(LAS v4u*)(kb + key * AK_PITCH + dc * 16) = st[i]; }
        else {
            LAS unsigned short* vp = (LAS unsigned short*)(vb + (dc * 8) * AV_PITCH + key * 2);
#pragma unroll
            for (int e = 0; e < 4; ++e) { const unsigned w = st[i][e]; vp[(2 * e) * (AV_PITCH / 2)] = (unsigned short)(w & 0xffffu); vp[(2 * e + 1) * (AV_PITCH / 2)] = (unsigned short)(w >> 16); }
        }
    }
}
template <bool SHARED, bool BIAS, bool MERGE, class Src, class Rel, bool ROT = false>
__device__ __forceinline__ void attn_run(LAS unsigned char* kbuf, LAS unsigned char* vbuf, const LAS float* tbl, int gtid, int tstart, int tstride, int ntiles, int kbase, int partial_tile,
                                         const Src& src, const Rel& rel, const AttnWave& W, LAS float* mg) {
    constexpr int NTHR = SHARED ? 512 : 64, NTASK = 512 / NTHR, NBUF = SHARED ? 2 : 1;
    const int lane = hw_lane(), r = lane & 31, h = lane >> 5;
    const int fr = (r & 0x13) | ((r & 4) << 1) | ((r & 8) >> 1);
    bf16x8 qf[4];
#pragma unroll
    for (int ks = 0; ks < 4; ++ks) qf[ks] = (bf16x8){0, 0, 0, 0, 0, 0, 0, 0};
    if (W.active) {
#pragma unroll
        for (int ks = 0; ks < 4; ++ks) qf[ks] = *(const bf16x8*)(W.qrow + ks * 16 + h * 8);
    }
    float m = W.m0, l = W.l0;
    f32x16 o0, o1;
#pragma unroll
    for (int i = 0; i < 16; ++i) { o0[i] = 0.f; o1[i] = 0.f; }
    if constexpr (SHARED && ROT) {
        const int idx0 = gtid & 255; const bool isV0 = gtid >= 256;
        v4u rA = src(tstart, isV0, idx0 >> 3, idx0 & 7);
        v4u rB = src(tstart + ((1 < ntiles) ? 1 : (ntiles - 1)) * tstride, isV0, idx0 >> 3, idx0 & 7);
        v4u rC = src(tstart + ((2 < ntiles) ? 2 : (ntiles - 1)) * tstride, isV0, idx0 >> 3, idx0 & 7);
        { const v4u one_[1] = {rA}; attn_stage_store<1>(one_, kbuf, vbuf, gtid, NTHR); }
        __syncthreads();
#pragma unroll 1
        for (int k0 = 0; k0 < ntiles; k0 += 3) {
            { const int k = k0; const int t = tstart + k * tstride;
              { const int kc = (k + 3 < ntiles) ? (k + 3) : (ntiles - 1); const int idx = gtid & 255; rA = src(tstart + kc * tstride, gtid >= 256, idx >> 3, idx & 7); }
              if (k < ntiles) {
                if (W.active && rel(t)) {
                    const LAS unsigned char* kb = kbuf + (NBUF == 2 ? (k & 1) * AK_BYTES : 0);
                    const LAS unsigned char* vb = vbuf + (NBUF == 2 ? (k & 1) * AV_BYTES : 0);
                    f32x16 x;
#pragma unroll
                    for (int i = 0; i < 16; ++i) x[i] = 0.f;
#pragma unroll
                    for (int ks = 0; ks < 4; ++ks) { const bf16x8 kf = *(const LAS bf16x8*)(kb + fr * AK_PITCH + ks * 32 + h * 16); x = MFMA32(kf, qf[ks], x); }
                    float tt[16];
                    const float c = 0.125f * LOG2E;
                    if (BIAS) {
                        const int dbase = W.qpos - (kbase + 32 * t) - 8 * h;
                        const int dmin = __builtin_amdgcn_readfirstlane(W.qpos - (int)(hw_lane() & 31)) - (kbase + 32 * t) - 31;
                        if (dmin >= 128) {
                            const float bfar = tbl[256];
#pragma unroll
                            for (int i = 0; i < 16; ++i) tt[i] = x[i] * c + bfar;
                        } else {
#pragma unroll
                            for (int i = 0; i < 16; ++i) { int d = dbase - ((i & 7) + 16 * (i >> 3)); d = d < -128 ? -128 : (d > 128 ? 128 : d); tt[i] = x[i] * c + tbl[d + 128]; }
                        }
                    } else {
#pragma unroll
                        for (int i = 0; i < 16; ++i) tt[i] = x[i] * c;
                    }
                    if (t == partial_tile) {
#pragma unroll
                        for (int i = 8; i < 16; ++i) tt[i] = -1e30f;
                    }
                    float mt = tt[0];
#pragma unroll
                    for (int i = 1; i < 16; ++i) mt = fmaxf(mt, tt[i]);
                    mt = fmaxf(mt, __shfl_xor(mt, 32));
                    if (__any(mt > m + 6.0f)) {
                        const float mn = fmaxf(m, mt); const float alpha = fexp2(m - mn); m = mn;
                        l *= alpha;
#pragma unroll
                        for (int i = 0; i < 16; ++i) { o0[i] *= alpha; o1[i] *= alpha; }
                    }
                    float ps = 0.f;
#pragma unroll
                    for (int i = 0; i < 16; ++i) { tt[i] = fexp2(tt[i] - m); ps += tt[i]; }
                    l += ps;
#pragma unroll
                    for (int s = 0; s < 2; ++s) {
                        v4u pw; pw.x = pkbf(tt[8 * s], tt[8 * s + 1]); pw.y = pkbf(tt[8 * s + 2], tt[8 * s + 3]); pw.z = pkbf(tt[8 * s + 4], tt[8 * s + 5]); pw.w = pkbf(tt[8 * s + 6], tt[8 * s + 7]);
                        const bf16x8 pf = __builtin_bit_cast(bf16x8, pw);
                        const bf16x8 v0 = *(const LAS bf16x8*)(vb + r * AV_PITCH + s * 32 + h * 16);
                        const bf16x8 v1 = *(const LAS bf16x8*)(vb + (r + 32) * AV_PITCH + s * 32 + h * 16);
                        o0 = MFMA32(v0, pf, o0); o1 = MFMA32(v1, pf, o1);
                    }
                }
              }
              if (k + 1 < ntiles) { const v4u one_[1] = {rB}; attn_stage_store<1>(one_, kbuf + ((k + 1) & 1) * AK_BYTES, vbuf + ((k + 1) & 1) * AV_BYTES, gtid, NTHR); }
              __syncthreads(); }
            { const int k = k0 + 1; const int t = tstart + k * tstride;
              { const int kc = (k + 3 < ntiles) ? (k + 3) : (ntiles - 1); const int idx = gtid & 255; rB = src(tstart + kc * tstride, gtid >= 256, idx >> 3, idx & 7); }
              if (k < ntiles) {
                if (W.active && rel(t)) {
                    const LAS unsigned char* kb = kbuf + (NBUF == 2 ? (k & 1) * AK_BYTES : 0);
                    const LAS unsigned char* vb = vbuf + (NBUF == 2 ? (k & 1) * AV_BYTES : 0);
                    f32x16 x;
#pragma unroll
                    for (int i = 0; i < 16; ++i) x[i] = 0.f;
#pragma unroll
                    for (int ks = 0; ks < 4; ++ks) { const bf16x8 kf = *(const LAS bf16x8*)(kb + fr * AK_PITCH + ks * 32 + h * 16); x = MFMA32(kf, qf[ks], x); }
                    float tt[16];
                    const float c = 0.125f * LOG2E;
                    if (BIAS) {
                        const int dbase = W.qpos - (kbase + 32 * t) - 8 * h;
                        const int dmin = __builtin_amdgcn_readfirstlane(W.qpos - (int)(hw_lane() & 31)) - (kbase + 32 * t) - 31;
                        if (dmin >= 128) {
                            const float bfar = tbl[256];
#pragma unroll
                            for (int i = 0; i < 16; ++i) tt[i] = x[i] * c + bfar;
                        } else {
#pragma unroll
                            for (int i = 0; i < 16; ++i) { int d = dbase - ((i & 7) + 16 * (i >> 3)); d = d < -128 ? -128 : (d > 128 ? 128 : d); tt[i] = x[i] * c + tbl[d + 128]; }
                        }
                    } else {
#pragma unroll
                        for (int i = 0; i < 16; ++i) tt[i] = x[i] * c;
                    }
                    if (t == partial_tile) {
#pragma unroll
                        for (int i = 8; i < 16; ++i) tt[i] = -1e30f;
                    }
                    float mt = tt[0];
#pragma unroll
                    for (int i = 1; i < 16; ++i) mt = fmaxf(mt, tt[i]);
                    mt = fmaxf(mt, __shfl_xor(mt, 32));
                    if (__any(mt > m + 6.0f)) {
                        const float mn = fmaxf(m, mt); const float alpha = fexp2(m - mn); m = mn;
                        l *= alpha;
#pragma unroll
                        for (int i = 0; i < 16; ++i) { o0[i] *= alpha; o1[i] *= alpha; }
                    }
                    float ps = 0.f;
#pragma unroll
                    for (int i = 0; i < 16; ++i) { tt[i] = fexp2(tt[i] - m); ps += tt[i]; }
                    l += ps;
#pragma unroll
                    for (int s = 0; s < 2; ++s) {
                        v4u pw; pw.x = pkbf(tt[8 * s], tt[8 * s + 1]); pw.y = pkbf(tt[8 * s + 2], tt[8 * s + 3]); pw.z = pkbf(tt[8 * s + 4], tt[8 * s + 5]); pw.w = pkbf(tt[8 * s + 6], tt[8 * s + 7]);
                        const bf16x8 pf = __builtin_bit_cast(bf16x8, pw);
                        const bf16x8 v0 = *(const LAS bf16x8*)(vb + r * AV_PITCH + s * 32 + h * 16);
                        const bf16x8 v1 = *(const LAS bf16x8*)(vb + (r + 32) * AV_PITCH + s * 32 + h * 16);
                        o0 = MFMA32(v0, pf, o0); o1 = MFMA32(v1, pf, o1);
                    }
                }
              }
              if (k + 1 < ntiles) { const v4u one_[1] = {rC}; attn_stage_store<1>(one_, kbuf + ((k + 1) & 1) * AK_BYTES, vbuf + ((k + 1) & 1) * AV_BYTES, gtid, NTHR); }
              __syncthreads(); }
            { const int k = k0 + 2; const int t = tstart + k * tstride;
              { const int kc = (k + 3 < ntiles) ? (k + 3) : (ntiles - 1); const int idx = gtid & 255; rC = src(tstart + kc * tstride, gtid >= 256, idx >> 3, idx & 7); }
              if (k < ntiles) {
                if (W.active && rel(t)) {
                    const LAS unsigned char* kb = kbuf + (NBUF == 2 ? (k & 1) * AK_BYTES : 0);
                    const LAS unsigned char* vb = vbuf + (NBUF == 2 ? (k & 1) * AV_BYTES : 0);
                    f32x16 x;
#pragma unroll
                    for (int i = 0; i < 16; ++i) x[i] = 0.f;
#pragma unroll
                    for (int ks = 0; ks < 4; ++ks) { const bf16x8 kf = *(const LAS bf16x8*)(kb + fr * AK_PITCH + ks * 32 + h * 16); x = MFMA32(kf, qf[ks], x); }
                    float tt[16];
                    const float c = 0.125f * LOG2E;
                    if (BIAS) {
                        const int dbase = W.qpos - (kbase + 32 * t) - 8 * h;
                        const int dmin = __builtin_amdgcn_readfirstlane(W.qpos - (int)(hw_lane() & 31)) - (kbase + 32 * t) - 31;
                        if (dmin >= 128) {
                            const float bfar = tbl[256];
#pragma unroll
                            for (int i = 0; i < 16; ++i) tt[i] = x[i] * c + bfar;
                        } else {
#pragma unroll
                            for (int i = 0; i < 16; ++i) { int d = dbase - ((i & 7) + 16 * (i >> 3)); d = d < -128 ? -128 : (d > 128 ? 128 : d); tt[i] = x[i] * c + tbl[d + 128]; }
                        }
                    } else {
#pragma unroll
                        for (int i = 0; i < 16; ++i) tt[i] = x[i] * c;
                    }
                    if (t == partial_tile) {
#pragma unroll
                        for (int i = 8; i < 16; ++i) tt[i] = -1e30f;
                    }
                    float mt = tt[0];
#pragma unroll
                    for (int i = 1; i < 16; ++i) mt = fmaxf(mt, tt[i]);
                    mt = fmaxf(mt, __shfl_xor(mt, 32));
                    if (__any(mt > m + 6.0f)) {
                        const float mn = fmaxf(m, mt); const float alpha = fexp2(m - mn); m = mn;
                        l *= alpha;
#pragma unroll
                        for (int i = 0; i < 16; ++i) { o0[i] *= alpha; o1[i] *= alpha; }
                    }
                    float ps = 0.f;
#pragma unroll
                    for (int i = 0; i < 16; ++i) { tt[i] = fexp2(tt[i] - m); ps += tt[i]; }
                    l += ps;
#pragma unroll
                    for (int s = 0; s < 2; ++s) {
                        v4u pw; pw.x = pkbf(tt[8 * s], tt[8 * s + 1]); pw.y = pkbf(tt[8 * s + 2], tt[8 * s + 3]); pw.z = pkbf(tt[8 * s + 4], tt[8 * s + 5]); pw.w = pkbf(tt[8 * s + 6], tt[8 * s + 7]);
                        const bf16x8 pf = __builtin_bit_cast(bf16x8, pw);
                        const bf16x8 v0 = *(const LAS bf16x8*)(vb + r * AV_PITCH + s * 32 + h * 16);
                        const bf16x8 v1 = *(const LAS bf16x8*)(vb + (r + 32) * AV_PITCH + s * 32 + h * 16);
                        o0 = MFMA32(v0, pf, o0); o1 = MFMA32(v1, pf, o1);
                    }
                }
              }
              if (k + 1 < ntiles) { const v4u one_[1] = {rA}; attn_stage_store<1>(one_, kbuf + ((k + 1) & 1) * AK_BYTES, vbuf + ((k + 1) & 1) * AV_BYTES, gtid, NTHR); }
              __syncthreads(); }
        }
    } else {
    v4u st[NTASK], st2[NTASK], st3[NTASK];
#pragma unroll
    for (int i = 0; i < NTASK; ++i) { const int task = gtid + NTHR * i; const int idx = task & 255; st[i] = src(tstart, task >= 256, idx >> 3, idx & 7);
        if (SHARED) { st2[i] = (1 < ntiles) ? src(tstart + tstride, task >= 256, idx >> 3, idx & 7) : st[i]; st3[i] = (2 < ntiles) ? src(tstart + 2 * tstride, task >= 256, idx >> 3, idx & 7) : st[i]; } }
    attn_stage_store<NTASK>(st, kbuf, vbuf, gtid, NTHR);
    if (SHARED) {
#pragma unroll
        for (int i = 0; i < NTASK; ++i) { st[i] = st2[i]; st2[i] = st3[i]; }
        __syncthreads();
    }
    for (int k = 0; k < ntiles; ++k) {
        const int t = tstart + k * tstride;
        const bool more = (k + 1 < ntiles);
        if (SHARED) {
            if (k + 3 < ntiles) {
#pragma unroll
                for (int i = 0; i < NTASK; ++i) { const int task = gtid + NTHR * i; const int idx = task & 255; st3[i] = src(t + 3 * tstride, task >= 256, idx >> 3, idx & 7); }
            }
        } else if (more) {
#pragma unroll
            for (int i = 0; i < NTASK; ++i) { const int task = gtid + NTHR * i; const int idx = task & 255; st[i] = src(t + tstride, task >= 256, idx >> 3, idx & 7); }
        }
        if (W.active && rel(t)) {
            const LAS unsigned char* kb = kbuf + (NBUF == 2 ? (k & 1) * AK_BYTES : 0);
            const LAS unsigned char* vb = vbuf + (NBUF == 2 ? (k & 1) * AV_BYTES : 0);
            f32x16 x;
#pragma unroll
            for (int i = 0; i < 16; ++i) x[i] = 0.f;
#pragma unroll
            for (int ks = 0; ks < 4; ++ks) { const bf16x8 kf = *(const LAS bf16x8*)(kb + fr * AK_PITCH + ks * 32 + h * 16); x = MFMA32(kf, qf[ks], x); }
            float tt[16];
            const float c = 0.125f * LOG2E;
            if (BIAS) {
                const int dbase = W.qpos - (kbase + 32 * t) - 8 * h;
                const int dmin = __builtin_amdgcn_readfirstlane(W.qpos - (int)(hw_lane() & 31)) - (kbase + 32 * t) - 31;
                if (dmin >= 128) {
                    const float bfar = tbl[256];
#pragma unroll
                    for (int i = 0; i < 16; ++i) tt[i] = x[i] * c + bfar;
                } else {
#pragma unroll
                    for (int i = 0; i < 16; ++i) { int d = dbase - ((i & 7) + 16 * (i >> 3)); d = d < -128 ? -128 : (d > 128 ? 128 : d); tt[i] = x[i] * c + tbl[d + 128]; }
                }
            } else {
#pragma unroll
                for (int i = 0; i < 16; ++i) tt[i] = x[i] * c;
            }
            if (t == partial_tile) {
#pragma unroll
                for (int i = 8; i < 16; ++i) tt[i] = -1e30f;
            }
            float mt = tt[0];
#pragma unroll
            for (int i = 1; i < 16; ++i) mt = fmaxf(mt, tt[i]);
            mt = fmaxf(mt, __shfl_xor(mt, 32));
            if (__any(mt > m + 6.0f)) {
                const float mn = fmaxf(m, mt); const float alpha = fexp2(m - mn); m = mn;
                l *= alpha;
#pragma unroll
                for (int i = 0; i < 16; ++i) { o0[i] *= alpha; o1[i] *= alpha; }
            }
            float ps = 0.f;
#pragma unroll
            for (int i = 0; i < 16; ++i) { tt[i] = fexp2(tt[i] - m); ps += tt[i]; }
            l += ps;
#pragma unroll
            for (int s = 0; s < 2; ++s) {
                v4u pw; pw.x = pkbf(tt[8 * s], tt[8 * s + 1]); pw.y = pkbf(tt[8 * s + 2], tt[8 * s + 3]); pw.z = pkbf(tt[8 * s + 4], tt[8 * s + 5]); pw.w = pkbf(tt[8 * s + 6], tt[8 * s + 7]);
                const bf16x8 pf = __builtin_bit_cast(bf16x8, pw);
                const bf16x8 v0 = *(const LAS bf16x8*)(vb + r * AV_PITCH + s * 32 + h * 16);
                const bf16x8 v1 = *(const LAS bf16x8*)(vb + (r + 32) * AV_PITCH + s * 32 + h * 16);
                o0 = MFMA32(v0, pf, o0); o1 = MFMA32(v1, pf, o1);
            }
        }
        if (more) attn_stage_store<NTASK>(st, kbuf + (NBUF == 2 ? ((k + 1) & 1) * AK_BYTES : 0), vbuf + (NBUF == 2 ? ((k + 1) & 1) * AV_BYTES : 0), gtid, NTHR);
        if (SHARED) {
#pragma unroll
            for (int i = 0; i < NTASK; ++i) { st[i] = st2[i]; st2[i] = st3[i]; }
            __syncthreads();
        }
    }
    }
    if (MERGE) {
        const float lt = l + __shfl_xor(l, 32);
        if (h == 0) { mg[r] = m; mg[32 + r] = lt; }
#pragma unroll
        for (int i = 0; i < 16; ++i) { const int d = (i & 3) + 8 * (i >> 2) + 4 * h; mg[64 + d * 32 + r] = o0[i]; mg[64 + (d + 32) * 32 + r] = o1[i]; }
    } else if (W.active) {
        const float lt = l + __shfl_xor(l, 32); const float inv = 1.0f / lt;
        if (W.wr) {
#pragma unroll
            for (int g = 0; g < 4; ++g) {
                u32x2 w0; w0.x = pkbf(o0[4 * g] * inv, o0[4 * g + 1] * inv); w0.y = pkbf(o0[4 * g + 2] * inv, o0[4 * g + 3] * inv);
                u32x2 w1; w1.x = pkbf(o1[4 * g] * inv, o1[4 * g + 1] * inv); w1.y = pkbf(o1[4 * g + 2] * inv, o1[4 * g + 3] * inv);
                *(u32x2*)(W.orow + 8 * g + 4 * h) = w0; *(u32x2*)(W.orow + 32 + 8 * g + 4 * h) = w1;
            }
        }
    }
}
struct RelAll { __device__ __forceinline__ bool operator()(int) const { return true; } };
struct RelBandP { int lo, hi; __device__ __forceinline__ bool operator()(int t) const { return t >= lo && t <= hi; } };
struct SrcZ { const bf16* zb; int kpos_first, kcol, vcol;
    __device__ __forceinline__ v4u operator()(int t, bool isV, int key, int dc) const { const int col = kcol + (isV ? (vcol - kcol) : 0); return *(const v4u*)(zb + (size_t)(kpos_first + 32 * t + key) * DIN + col + dc * 8); } };
struct SrcCache { const float* ck; const float* cv; int hstride  ; int ncache; const bf16* znew; int kcol, vcol;
    __device__ __forceinline__ v4u operator()(int t, bool isV, int key, int dc) const {
        const long vd = isV ? (long)(cv - ck) : 0l; const int col = kcol + (isV ? (vcol - kcol) : 0);
        if (t < ncache) { const float* p = ck + vd + (size_t)(32 * t + key) * hstride + dc * 8; const f32x4 a = *(const f32x4*)p, b = *(const f32x4*)(p + 4); return pack8(a, b); }
        if (key < 16) return *(const v4u*)(znew + (size_t)key * DIN + col + dc * 8);
        return (v4u){0u, 0u, 0u, 0u}; } };

template <int NTMAX, class Src>
__device__ __forceinline__ void attn_run_all(LAS unsigned char* kbuf, LAS unsigned char* vbuf, int tid, int ntiles, const Src& src, const AttnWave& W) {
    const int lane = hw_lane(), r = lane & 31, h = lane >> 5;
    const int fr = (r & 0x13) | ((r & 4) << 1) | ((r & 8) >> 1);
    bf16x8 qf[4];
#pragma unroll
    for (int ks = 0; ks < 4; ++ks) qf[ks] = *(const bf16x8*)(W.qrow + ks * 16 + h * 8);
    { const int idx = tid & 255; const bool isV = tid >= 256;
      v4u st[NTMAX];
#pragma unroll
      for (int k = 0; k < NTMAX; ++k) if (k < ntiles) st[k] = src(k, isV, idx >> 3, idx & 7);
#pragma unroll
      for (int k = 0; k < NTMAX; ++k) if (k < ntiles) { const v4u one[1] = {st[k]}; attn_stage_store<1>(one, kbuf + k * AK_BYTES, vbuf + k * AV_BYTES, tid, 512); } }
    __syncthreads();
    float m = W.m0, l = W.l0;
    f32x16 o0, o1;
#pragma unroll
    for (int i = 0; i < 16; ++i) { o0[i] = 0.f; o1[i] = 0.f; }
#pragma unroll 1
    for (int k = 0; k < ntiles; ++k) {
        const LAS unsigned char* kb = kbuf + k * AK_BYTES;
        const LAS unsigned char* vb = vbuf + k * AV_BYTES;
        f32x16 x;
#pragma unroll
        for (int i = 0; i < 16; ++i) x[i] = 0.f;
#pragma unroll
        for (int ks = 0; ks < 4; ++ks) { const bf16x8 kf = *(const LAS bf16x8*)(kb + fr * AK_PITCH + ks * 32 + h * 16); x = MFMA32(kf, qf[ks], x); }
        float tt[16];
        const float c = 0.125f * LOG2E;
#pragma unroll
        for (int i = 0; i < 16; ++i) tt[i] = x[i] * c;
        float mt = tt[0];
#pragma unroll
        for (int i = 1; i < 16; ++i) mt = fmaxf(mt, tt[i]);
        mt = fmaxf(mt, __shfl_xor(mt, 32));
        if (__any(mt > m + 6.0f)) {
            const float mn = fmaxf(m, mt); const float alpha = fexp2(m - mn); m = mn;
            l *= alpha;
#pragma unroll
            for (int i = 0; i < 16; ++i) { o0[i] *= alpha; o1[i] *= alpha; }
        }
        float ps = 0.f;
#pragma unroll
        for (int i = 0; i < 16; ++i) { tt[i] = fexp2(tt[i] - m); ps += tt[i]; }
        l += ps;
#pragma unroll
        for (int s = 0; s < 2; ++s) {
            v4u pw; pw.x = pkbf(tt[8 * s], tt[8 * s + 1]); pw.y = pkbf(tt[8 * s + 2], tt[8 * s + 3]); pw.z = pkbf(tt[8 * s + 4], tt[8 * s + 5]); pw.w = pkbf(tt[8 * s + 6], tt[8 * s + 7]);
            const bf16x8 pf = __builtin_bit_cast(bf16x8, pw);
            const bf16x8 v0 = *(const LAS bf16x8*)(vb + r * AV_PITCH + s * 32 + h * 16);
            const bf16x8 v1 = *(const LAS bf16x8*)(vb + (r + 32) * AV_PITCH + s * 32 + h * 16);
            o0 = MFMA32(v0, pf, o0); o1 = MFMA32(v1, pf, o1);
        }
    }
    const float lt = l + __shfl_xor(l, 32); const float inv = 1.0f / lt;
#pragma unroll
    for (int g = 0; g < 4; ++g) {
        u32x2 w0; w0.x = pkbf(o0[4 * g] * inv, o0[4 * g + 1] * inv); w0.y = pkbf(o0[4 * g + 2] * inv, o0[4 * g + 3] * inv);
        u32x2 w1; w1.x = pkbf(o1[4 * g] * inv, o1[4 * g + 1] * inv); w1.y = pkbf(o1[4 * g + 2] * inv, o1[4 * g + 3] * inv);
        *(u32x2*)(W.orow + 8 * g + 4 * h) = w0; *(u32x2*)(W.orow + 32 + 8 * g + 4 * h) = w1;
    }
}

struct LruUnit {
    const bf16* zseq;
    const float* prefix;
    int n;
    int chn;
    float c8, cw0, cw1, cw2, cw3, cb, rb, ib;
    bf16x8 bfr[8], bfi[8];
};
__device__ __forceinline__ void lru_setup(LruUnit& U, int l, int n, int dq, const float* conv_w, const float* conv_b, const float* w_r, const float* b_r, const float* w_i, const float* b_i, const float* lam) {
    const int lane = hw_lane(), ch = lane & 15, kq = lane >> 4;
    U.n = n; U.chn = 64 * n + 16 * dq + ch;
    const float* Wr = w_r + ((size_t)(l * 16 + n) * 64) * 64 + 16 * dq + ch;
    const float* Wi = w_i + ((size_t)(l * 16 + n) * 64) * 64 + 16 * dq + ch;
    const float* cw = conv_w + (size_t)l * 4 * 1024 + 64 * n;
    const float* cbp = conv_b + (size_t)l * 1024 + 64 * n;
    float sr = 0.f, si = 0.f;
#pragma unroll
    for (int chalf = 0; chalf < 2; ++chalf) {
        float wr8[8], wi8[8];
#pragma unroll
        for (int jj = 0; jj < 8; ++jj) { const int c = 32 * chalf + 8 * kq + jj; wr8[jj] = Wr[c * 64]; wi8[jj] = Wi[c * 64]; const float cbv = cbp[c]; sr += cbv * wr8[jj]; si += cbv * wi8[jj]; }
#pragma unroll
        for (int j = 0; j < 4; ++j) {
            float t8[8];
#pragma unroll
            for (int jj = 0; jj < 8; ++jj) t8[jj] = cw[j * 1024 + 32 * chalf + 8 * kq + jj];
            v4u pr, pi;
#pragma unroll
            for (int e = 0; e < 4; ++e) { pr[e] = pkbf(t8[2 * e] * wr8[2 * e], t8[2 * e + 1] * wr8[2 * e + 1]); pi[e] = pkbf(t8[2 * e] * wi8[2 * e], t8[2 * e + 1] * wi8[2 * e + 1]); }
            U.bfr[j * 2 + chalf] = __builtin_bit_cast(bf16x8, pr); U.bfi[j * 2 + chalf] = __builtin_bit_cast(bf16x8, pi);
        }
    }
    sr += __shfl_xor(sr, 16); sr += __shfl_xor(sr, 32); si += __shfl_xor(si, 16); si += __shfl_xor(si, 32);
    U.rb = sr + b_r[(size_t)(l * 16 + n) * 64 + 16 * dq + ch]; U.ib = si + b_i[(size_t)(l * 16 + n) * 64 + 16 * dq + ch];
    const float lm = lam[(size_t)l * 1024 + U.chn];
    U.c8 = -8.0f * log1pf(expf(-lm));
    U.cw0 = conv_w[((size_t)l * 4 + 0) * 1024 + U.chn]; U.cw1 = conv_w[((size_t)l * 4 + 1) * 1024 + U.chn]; U.cw2 = conv_w[((size_t)l * 4 + 2) * 1024 + U.chn]; U.cw3 = conv_w[((size_t)l * 4 + 3) * 1024 + U.chn];
    U.cb = conv_b[(size_t)l * 1024 + U.chn];
}
__device__ __forceinline__ bf16x8 lru_ld8(const LruUnit& U, int trow, int c0) {
    v4u w;
    if (trow >= 0) w = *(const v4u*)(U.zseq + (size_t)trow * DIN + C_XB + 64 * U.n + c0);
    else if (U.prefix != nullptr) { const float* p = U.prefix + (trow + 3) * 1024 + 64 * U.n + c0; w = pack8(*(const f32x4*)p, *(const f32x4*)(p + 4)); }
    else w = (v4u){0u, 0u, 0u, 0u};
    return __builtin_bit_cast(bf16x8, w);
}
__device__ __forceinline__ float lru_xb(const LruUnit& U, int trow) {
    if (trow >= 0) return bf2f(U.zseq[(size_t)trow * DIN + C_XB + U.chn]);
    if (U.prefix != nullptr) return U.prefix[(trow + 3) * 1024 + U.chn];
    return 0.f;
}
__device__ __forceinline__ void lru_tile(const LruUnit& U, int t0, float& Ac, float& Hc, float (&P)[4], float (&hl)[4]) {
    const int lane = hw_lane(), tk = lane & 15, kq = lane >> 4, tq = kq;
    f32x4 ar = {U.rb, U.rb, U.rb, U.rb}, ai = {U.ib, U.ib, U.ib, U.ib};
#pragma unroll
    for (int j = 0; j < 4; ++j)
#pragma unroll
        for (int chalf = 0; chalf < 2; ++chalf) { const bf16x8 a = lru_ld8(U, t0 + tk - 3 + j, 32 * chalf + 8 * kq); ar = MFMA16(a, U.bfr[j * 2 + chalf], ar); ai = MFMA16(a, U.bfi[j * 2 + chalf], ai); }
    float xv[7];
#pragma unroll
    for (int e = 0; e < 7; ++e) xv[e] = lru_xb(U, t0 + 4 * tq - 3 + e);
    float a[4], u[4];
#pragma unroll
    for (int j = 0; j < 4; ++j) {
        const float xc = U.cb + U.cw0 * xv[j] + U.cw1 * xv[j + 1] + U.cw2 * xv[j + 2] + U.cw3 * xv[j + 3];
        const float rg = sigmoidf_fast(ar[j]), ig = sigmoidf_fast(ai[j]);
        const float la = U.c8 * rg;
        a[j] = fexp2(la * LOG2E);
        const float x2 = 2.0f * la;
        const float om = __builtin_fmaf(-a[j], a[j], 1.0f);
        u[j] = sqrtf(fmaxf(om, 0.f)) * (ig * xc);
    }
    P[0] = a[0]; hl[0] = u[0];
#pragma unroll
    for (int j = 1; j < 4; ++j) { P[j] = P[j - 1] * a[j]; hl[j] = a[j] * hl[j - 1] + u[j]; }
    float A = P[3], H = hl[3];
    { const float Ap = __shfl_up(A, 16), Hp = __shfl_up(H, 16); if (tq >= 1) { H = A * Hp + H; A = A * Ap; } }
    { const float Ap = __shfl_up(A, 32), Hp = __shfl_up(H, 32); if (tq >= 2) { H = A * Hp + H; A = A * Ap; } }
    float Aex = __shfl_up(A, 16), Hex = __shfl_up(H, 16); if (tq == 0) { Aex = 1.0f; Hex = 0.f; }
    const float At = __shfl(A, 48 + tk), Ht = __shfl(H, 48 + tk);
    const float Ae2 = Ac * Aex, He2 = Aex * Hc + Hex;
#pragma unroll
    for (int j = 0; j < 4; ++j) { hl[j] = P[j] * He2 + hl[j]; P[j] = Ae2 * P[j]; }
    Hc = At * Hc + Ht; Ac = Ac * At;
}
__device__ __forceinline__ void lru_setup_lds(LruUnit& U, LAS unsigned char* bl, LAS float* bsum, int wave, int l, int n, int dq, const float* conv_w, const float* conv_b, const float* w_r, const float* w_i, const float* lam) {
    const int lane = hw_lane(), ch = lane & 15, kq = lane >> 4;
    U.n = n; U.chn = 64 * n + 16 * dq + ch;
    const float* Wr = w_r + ((size_t)(l * 16 + n) * 64) * 64 + 16 * dq + ch;
    const float* Wi = w_i + ((size_t)(l * 16 + n) * 64) * 64 + 16 * dq + ch;
    const int j = wave >> 1, chalf = wave & 1;
    const float* cw = conv_w + ((size_t)l * 4 + j) * 1024 + 64 * n + 32 * chalf + 8 * kq;
    const float* cbp = conv_b + (size_t)l * 1024 + 64 * n + 32 * chalf + 8 * kq;
    float wr8[8], wi8[8], t8[8], cb8[8];
#pragma unroll
    for (int jj = 0; jj < 8; ++jj) { const int c = 32 * chalf + 8 * kq + jj; wr8[jj] = Wr[c * 64]; wi8[jj] = Wi[c * 64]; t8[jj] = cw[jj]; cb8[jj] = cbp[jj]; }
    v4u pr, pi;
#pragma unroll
    for (int e = 0; e < 4; ++e) { pr[e] = pkbf(t8[2 * e] * wr8[2 * e], t8[2 * e + 1] * wr8[2 * e + 1]); pi[e] = pkbf(t8[2 * e] * wi8[2 * e], t8[2 * e + 1] * wi8[2 * e + 1]); }
    *(LAS v4u*)(bl + wave * 1024 + lane * 16) = pr; *(LAS v4u*)(bl + (8 + wave) * 1024 + lane * 16) = pi;
    if (wave < 2) {
        float sr = 0.f, si = 0.f;
#pragma unroll
        for (int jj = 0; jj < 8; ++jj) { sr += cb8[jj] * wr8[jj]; si += cb8[jj] * wi8[jj]; }
        sr += __shfl_xor(sr, 16); sr += __shfl_xor(sr, 32); si += __shfl_xor(si, 16); si += __shfl_xor(si, 32);
        if (kq == 0) { bsum[(wave * 2 + 0) * 16 + ch] = sr; bsum[(wave * 2 + 1) * 16 + ch] = si; }
    }
    const float lm = lam[(size_t)l * 1024 + U.chn];
    U.c8 = -8.0f * log1pf(expf(-lm));
    U.cw0 = conv_w[((size_t)l * 4 + 0) * 1024 + U.chn]; U.cw1 = conv_w[((size_t)l * 4 + 1) * 1024 + U.chn]; U.cw2 = conv_w[((size_t)l * 4 + 2) * 1024 + U.chn]; U.cw3 = conv_w[((size_t)l * 4 + 3) * 1024 + U.chn];
    U.cb = conv_b[(size_t)l * 1024 + U.chn];
}
constexpr int LX_PITCH = 144, LX_ROWS = 515, LX_CHUNKS = LX_ROWS * 8, LX_EX_OFF = 75776, LX_BL_OFF = 77824, LX_BS_OFF = 94208, LX_GS_OFF = 94720  ;
__device__ __forceinline__ void lru_round_mfma(const LruUnit& U, const LAS unsigned char* slab, const LAS unsigned char* bl, int wtok, f32x4 (&ar)[4], f32x4 (&ai)[4]) {
    const int lane = hw_lane(), tk = lane & 15, kq = lane >> 4;
#pragma unroll
    for (int i = 0; i < 4; ++i) { ar[i] = (f32x4){U.rb, U.rb, U.rb, U.rb}; ai[i] = (f32x4){U.ib, U.ib, U.ib, U.ib}; }
#pragma unroll
    for (int j = 0; j < 4; ++j)
#pragma unroll
        for (int chalf = 0; chalf < 2; ++chalf) {
            const bf16x8 br = *(const LAS bf16x8*)(bl + (j * 2 + chalf) * 1024 + lane * 16), bi = *(const LAS bf16x8*)(bl + (8 + j * 2 + chalf) * 1024 + lane * 16);
#pragma unroll
            for (int i = 0; i < 4; ++i) { const bf16x8 a = *(const LAS bf16x8*)(slab + (wtok + 16 * i + tk + j) * LX_PITCH + (32 * chalf + 8 * kq) * 2); ar[i] = MFMA16(a, br, ar[i]); ai[i] = MFMA16(a, bi, ai[i]); }
        }
}
__device__ __forceinline__ void lru_tile_lds(const LruUnit& U, const LAS unsigned char* slab, const f32x4 ar, const f32x4 ai, int tloc, int dq, float& Ac, float& Hc, float (&P)[4], float (&hl)[4]) {
    const int lane = hw_lane(), tk = lane & 15, kq = lane >> 4, tq = kq;
    float xv[7];
#pragma unroll
    for (int e = 0; e < 7; ++e) xv[e] = bf2f(*(const LAS unsigned short*)(slab + (tloc + 4 * tq + e) * LX_PITCH + (16 * dq + tk) * 2));
    float a[4], u[4];
#pragma unroll
    for (int j = 0; j < 4; ++j) {
        const float xc = U.cb + U.cw0 * xv[j] + U.cw1 * xv[j + 1] + U.cw2 * xv[j + 2] + U.cw3 * xv[j + 3];
        const float rg = sigmoidf_fast(ar[j]), ig = sigmoidf_fast(ai[j]);
        const float la = U.c8 * rg;
        a[j] = fexp2(la * LOG2E);
        const float x2 = 2.0f * la;
        const float om = __builtin_fmaf(-a[j], a[j], 1.0f);
        u[j] = sqrtf(fmaxf(om, 0.f)) * (ig * xc);
    }
    P[0] = a[0]; hl[0] = u[0];
#pragma unroll
    for (int j = 1; j < 4; ++j) { P[j] = P[j - 1] * a[j]; hl[j] = a[j] * hl[j - 1] + u[j]; }
    float A = P[3], H = hl[3];
    { const float Ap = __shfl_up(A, 16), Hp = __shfl_up(H, 16); if (tq >= 1) { H = A * Hp + H; A = A * Ap; } }
    { const float Ap = __shfl_up(A, 32), Hp = __shfl_up(H, 32); if (tq >= 2) { H = A * Hp + H; A = A * Ap; } }
    float Aex = __shfl_up(A, 16), Hex = __shfl_up(H, 16); if (tq == 0) { Aex = 1.0f; Hex = 0.f; }
    const float At = __shfl(A, 48 + tk), Ht = __shfl(H, 48 + tk);
    const float Ae2 = Ac * Aex, He2 = Aex * Hc + Hex;
#pragma unroll
    for (int j = 0; j < 4; ++j) { hl[j] = P[j] * He2 + hl[j]; P[j] = Ae2 * P[j]; }
    Hc = At * Hc + Ht; Ac = Ac * At;
}
__device__ __forceinline__ void lru_round_lds(const LruUnit& U, const LAS unsigned char* slab, const LAS unsigned char* bl, int wtok, int dq, float& At, float& Ht, float (&P)[16], float (&hl)[16]) {
    const int lane = hw_lane(), tk = lane & 15, kq = lane >> 4, tq = kq;
    f32x4 ar[4], ai[4];
#pragma unroll
    for (int i = 0; i < 4; ++i) { ar[i] = (f32x4){U.rb, U.rb, U.rb, U.rb}; ai[i] = (f32x4){U.ib, U.ib, U.ib, U.ib}; }
    const LAS unsigned char* arow = slab + (wtok + 16 * (tk >> 2) + (tk & 3)) * LX_PITCH;
    const int cq0 = 16 * (kq ^ ((tk >> 2) & 3)), cq1 = 16 * (kq ^ (((tk >> 2) + 1) & 3));
#pragma unroll
    for (int j = 0; j < 4; ++j)
#pragma unroll
        for (int chalf = 0; chalf < 2; ++chalf) {
            const bf16x8 br = *(const LAS bf16x8*)(bl + (j * 2 + chalf) * 1024 + lane * 16), bi = *(const LAS bf16x8*)(bl + (8 + j * 2 + chalf) * 1024 + lane * 16);
#pragma unroll
            for (int i = 0; i < 4; ++i) { const int cq = (((tk & 3) + 4 * i + j) >> 4) ? cq1 : cq0;
                const bf16x8 a = *(const LAS bf16x8*)(arow + (4 * i + j) * LX_PITCH + chalf * 64 + cq); ar[i] = MFMA16(a, br, ar[i]); ai[i] = MFMA16(a, bi, ai[i]); }
        }
    float xv[19];
    { const LAS unsigned char* xp = slab + (wtok + 16 * tq) * LX_PITCH + (tk & 7) * 2; const int xc = 2 * dq + (tk >> 3), x0 = 16 * (xc ^ tq), x1 = 16 * (xc ^ ((tq + 1) & 3));
#pragma unroll
      for (int e = 0; e < 19; ++e) xv[e] = bf2f(*(const LAS unsigned short*)(xp + e * LX_PITCH + (e < 16 ? x0 : x1))); }
#pragma unroll
    for (int i = 0; i < 4; ++i)
#pragma unroll
        for (int r = 0; r < 4; ++r) { const int k = 4 * i + r;
            const float xc = U.cb + U.cw0 * xv[k] + U.cw1 * xv[k + 1] + U.cw2 * xv[k + 2] + U.cw3 * xv[k + 3];
            const float rg = sigmoidf_fast(ar[i][r]), ig = sigmoidf_fast(ai[i][r]);
            const float la = U.c8 * rg;
            const float a = fexp2(la * LOG2E);
            const float x2 = 2.0f * la;
            const float om = __builtin_fmaf(-a, a, 1.0f);
            const float u = __builtin_amdgcn_sqrtf(fmaxf(om, 0.f)) * (ig * xc);
            if (k == 0) { P[0] = a; hl[0] = u; } else { P[k] = P[k - 1] * a; hl[k] = a * hl[k - 1] + u; } }
    float A = P[15], H = hl[15];
    { const float Ap = __shfl_up(A, 16), Hp = __shfl_up(H, 16); if (tq >= 1) { H = A * Hp + H; A = A * Ap; } }
    { const float Ap = __shfl_up(A, 32), Hp = __shfl_up(H, 32); if (tq >= 2) { H = A * Hp + H; A = A * Ap; } }
    float Aex = __shfl_up(A, 16), Hex = __shfl_up(H, 16); if (tq == 0) { Aex = 1.0f; Hex = 0.f; }
    At = __shfl(A, 48 + tk); Ht = __shfl(H, 48 + tk);
#pragma unroll
    for (int k = 0; k < 16; ++k) { hl[k] = P[k] * Hex + hl[k]; P[k] = Aex * P[k]; }
}
__device__ __forceinline__ float gelu_tanh(float g) { const float y = 0.7978845608028654f * (g + 0.044715f * g * g * g); return g * sigmoidf_fast(2.0f * y); }


template <int ROWT, int NC, int UNR, class Epi, int ORDER = 0>
__device__ __forceinline__ void skinny_gemm(LAS unsigned char* lds, const bf16* A, int lda, const bf16* Wt, int K, int N, int Mrows, int tid, int bid, int G, const Epi& epi) {
    constexpr int CT = (NC + 15) / 16, PW = CT * 16, ROWS = ROWT * 16; const int RG = Mrows / ROWS;
    const int lane = tid & 63, wave = __builtin_amdgcn_readfirstlane(tid >> 6), r16 = lane & 15, kq = lane >> 4;
    LAS float* P = (LAS float*)lds;
    const int nunits = (N / NC) * RG;
    for (int unit0 = bid; unit0 < nunits * REP_S; unit0 += G) { const int unit = unit0 % nunits;
        const int rg = ORDER ? (unit0 % G) % RG : unit % RG, n0 = (ORDER ? ((unit0 % G) / RG) * 2 + (unit0 / G) : unit / RG) * NC, row0 = rg * ROWS, kw = K / 8, k0 = wave * kw;
        f32x4 acc[ROWT][CT];
#pragma unroll
        for (int rt = 0; rt < ROWT; ++rt)
#pragma unroll
            for (int ct = 0; ct < CT; ++ct) acc[rt][ct] = (f32x4){0.f, 0.f, 0.f, 0.f};
        const bf16* ap = A + (size_t)(row0 + r16) * lda + k0 + 8 * kq;
        const bf16* bp[CT];
#pragma unroll
        for (int ct = 0; ct < CT; ++ct) { int col = ct * 16 + r16; col = col < NC ? col : NC - 1; bp[ct] = Wt + (size_t)(n0 + col) * K + k0 + 8 * kq; }
#pragma unroll UNR
        for (int ks = 0; ks < kw / 32; ++ks) {
            bf16x8 a[ROWT], b[CT];
#pragma unroll
            for (int rt = 0; rt < ROWT; ++rt) a[rt] = *(const bf16x8*)(ap + (size_t)rt * 16 * lda + ks * 32);
#pragma unroll
            for (int ct = 0; ct < CT; ++ct) b[ct] = *(const bf16x8*)(bp[ct] + ks * 32);
#pragma unroll
            for (int rt = 0; rt < ROWT; ++rt)
#pragma unroll
                for (int ct = 0; ct < CT; ++ct) acc[rt][ct] = MFMA16(a[rt], b[ct], acc[rt][ct]);
        }
        __syncthreads();
#pragma unroll
        for (int rt = 0; rt < ROWT; ++rt)
#pragma unroll
            for (int ct = 0; ct < CT; ++ct)
#pragma unroll
                for (int e = 0; e < 4; ++e) P[(size_t)((wave * ROWS + rt * 16 + 4 * kq + e) * PW) + ct * 16 + r16] = acc[rt][ct][e];
        __syncthreads();
        for (int e = tid; e < ROWS * NC; e += 512) { const int row = e / NC, c = e % NC; float sum = 0.f;
#pragma unroll
            for (int w = 0; w < 8; ++w) sum += P[(w * ROWS + row) * PW + c];
            epi(row0 + row, n0 + c, sum); }
    }
    __syncthreads();
}
struct SkEpiBf16 { bf16* C; int ldc; __device__ __forceinline__ void operator()(int row, int col, float v) const { C[(size_t)row * ldc + col] = (bf16)f2bf(v); } };
struct SkEpiF32 { float* C; int ldc; __device__ __forceinline__ void operator()(int row, int col, float v) const { C[(size_t)row * ldc + col] = v; } };
struct SkEpiRelu2 { bf16* C; int ldc; __device__ __forceinline__ void operator()(int row, int col, float v) const { const float r = fmaxf(v, 0.f); C[(size_t)row * ldc + col] = (bf16)f2bf(r * r); } };
struct SkEpiT16 { bf16* Z; float* out; int L;
    __device__ __forceinline__ void operator()(int row, int col, float v) const {
        Z[(size_t)row * DIN + 4096 + col] = (bf16)f2bf(v);
        const int b = row >> 11, t = row & 2047;
        if (t >= 1536) out[pg8::O_BVP + ((size_t)(L * 4 + b) * 512 + (t - 1536)) * 512 + 256 + col] = v;
    } };
struct SkEpiInProj { bf16* Zs; float* out; int L;
    __device__ __forceinline__ void operator()(int row, int col, float v) const {
        Zs[(size_t)row * DIN + col] = (bf16)f2bf(v);
        const int bs = row >> 4, t = row & 15;
        if (col >= C_KA && col < C_XB) { const bool isV = col >= C_VA; const int c = col - (isV ? C_VA : C_KA); out[(isV ? pg8::O_SVS : pg8::O_SKS) + ((size_t)(L * 8 + bs) * 16 + t) * 128 + c] = v; }
        else if (col >= C_XB && col < C_GB) { if (t >= 13) out[pg8::O_LCS + ((size_t)(L * 8 + bs) * 3 + (t - 13)) * 1024 + (col - C_XB)] = v; }
        else if (col >= C_KC) { const bool isV = col >= C_VC; const int c = col - (isV ? C_VC : C_KC); out[(isV ? pg8::O_BVS : pg8::O_BKS) + ((size_t)(L * 8 + bs) * 16 + t) * 512 + c] = v; }
    } };


template <int TR, int TC, int WR, int WC, int KS, int PF, class Epi>
__device__ __forceinline__ void mini_gemm(LAS unsigned char* lds, const bf16* A, int lda, int Mrows, const bf16* Wt, int N, int K, int tid, int bid, int G, const Epi& epi) {
    constexpr int KC = 256, PITCH = 528, NP = (TR + TC) * 32 / 512, MT = TR / WR / 16, NT = TC / WC / 16, KSTEPS = 8 / KS;
    static_assert(WR * WC * KS == 8 && (TR + TC) * 32 % 512 == 0 && MT >= 1 && NT >= 1, "mini_gemm geometry");
    const int lane = tid & 63, wave = __builtin_amdgcn_readfirstlane(tid >> 6), r16 = lane & 15, kq = lane >> 4;
    const int wk = wave / (WR * WC), wrc = wave % (WR * WC), wr = wrc / WC, wc = wrc % WC;
    LAS unsigned char* As = lds; LAS unsigned char* Bs = lds + TR * PITCH;
    const int RG = Mrows / TR, nunits = RG * (N / TC), nch = K / KC;
    for (int unit = bid; unit < nunits; unit += G) {
        const int rg = unit % RG, row0 = rg * TR, n0 = (unit / RG) * TC;
        const bf16* src[NP]; int dst[NP];
#pragma unroll
        for (int i = 0; i < NP; ++i) { const int p = tid + 512 * i, r = p >> 5, c = p & 31;
            src[i] = (r < TR) ? A + (size_t)(row0 + r) * lda + c * 8 : Wt + (size_t)(n0 + r - TR) * K + c * 8; dst[i] = r * PITCH + c * 16; }
        f32x4 acc[MT][NT];
#pragma unroll
        for (int m = 0; m < MT; ++m)
#pragma unroll
            for (int n = 0; n < NT; ++n) acc[m][n] = (f32x4){0.f, 0.f, 0.f, 0.f};
        v4u st[PF][NP];
#pragma unroll
        for (int d = 0; d < PF; ++d)
#pragma unroll
            for (int i = 0; i < NP; ++i) st[d][i] = *(const v4u*)(src[i] + (size_t)(d < nch ? d : 0) * KC);
        for (int ch = 0; ch < nch; ch += PF) {
#pragma unroll
            for (int d = 0; d < PF; ++d) {
                __syncthreads();
#pragma unroll
                for (int i = 0; i < NP; ++i) *(LAS v4u*)(lds + dst[i]) = st[d][i];
                if (ch + d + PF < nch) {
#pragma unroll
                    for (int i = 0; i < NP; ++i) st[d][i] = *(const v4u*)(src[i] + (size_t)(ch + d + PF) * KC);
                }
                __syncthreads();
#pragma unroll
                for (int ks = 0; ks < KSTEPS; ++ks) { const int kb = ((wk * KSTEPS + ks) * 32 + 8 * kq) * 2;
                    bf16x8 a[MT], b[NT];
#pragma unroll
                    for (int m = 0; m < MT; ++m) a[m] = *(const LAS bf16x8*)(As + ((wr * MT + m) * 16 + r16) * PITCH + kb);
#pragma unroll
                    for (int n = 0; n < NT; ++n) b[n] = *(const LAS bf16x8*)(Bs + ((wc * NT + n) * 16 + r16) * PITCH + kb);
#pragma unroll
                    for (int m = 0; m < MT; ++m)
#pragma unroll
                        for (int n = 0; n < NT; ++n) acc[m][n] = MFMA16(a[m], b[n], acc[m][n]);
                }
            }
        }
        __syncthreads();
        if (KS > 1) {
            LAS f32x4* P = (LAS f32x4*)lds;
            if (wk > 0) {
#pragma unroll
                for (int m = 0; m < MT; ++m)
#pragma unroll
                    for (int n = 0; n < NT; ++n) P[(((wk - 1) * (WR * WC) + wrc) * (MT * NT) + m * NT + n) * 64 + lane] = acc[m][n];
            }
            __syncthreads();
            if (wk == 0) {
#pragma unroll
                for (int k2 = 1; k2 < KS; ++k2)
#pragma unroll
                    for (int m = 0; m < MT; ++m)
#pragma unroll
                        for (int n = 0; n < NT; ++n) acc[m][n] += P[(((k2 - 1) * (WR * WC) + wrc) * (MT * NT) + m * NT + n) * 64 + lane];
            }
        }
        if (wk == 0) {
#pragma unroll
            for (int m = 0; m < MT; ++m)
#pragma unroll
                for (int n = 0; n < NT; ++n)
#pragma unroll
                    for (int e = 0; e < 4; ++e) epi(row0 + (wr * MT + m) * 16 + 4 * kq + e, n0 + (wc * NT + n) * 16 + r16, acc[m][n][e]);
        }
    }
    __syncthreads();
}

constexpr int J_IN = (DM / P0_KH) * (DIN / 256), J_OUT = (DM / P0_KH) * (DM / 256), J_UP = (DM / P0_KH) * (DFF / 256), J_DN = (DFF / P0_KH) * (DM / 256), J_L = J_IN + J_OUT + J_UP + J_DN;
#ifndef BARWORK
#define BARWORK 1
#endif
#ifndef BARWORK_LATE
#define BARWORK_LATE 1
#endif
template <class Work>
__device__ __forceinline__ void xcd_barrier_work(const XcdBarrier& b, bool t0, unsigned* queue, unsigned nitems, volatile LAS unsigned* slot, const Work& work) {
    asm volatile("s_waitcnt vmcnt(0)" ::: "memory");
    __syncthreads();
    bool leader = true; unsigned gen = 0u;
    if (t0) {
        unsigned* bar = b.bar;
        __builtin_amdgcn_s_waitcnt(0);
        unsigned nloc = b.st[0], nx = b.st[1];
        if (nloc == 0u) { xcd_barrier_complete(bar, b.x, nloc, nx); b.st[0] = nloc; b.st[1] = nx; }
        const unsigned old = xb_add(&bar[XB_XSUB(b.x)], 1u);
        gen = old / nloc;
        leader = (old + 1u == (gen + 1u) * nloc);
        if (leader) {
            __builtin_amdgcn_fence(__ATOMIC_RELEASE, "agent");
            asm volatile("s_waitcnt vmcnt(0)" ::: "memory");
            const unsigned og = xb_add(&bar[XB_TOP], 1u);
            const unsigned tg = og / nx;
            if (og + 1u == (tg + 1u) * nx) xb_add(&bar[XB_TOPGEN], 1u);
            else XB_SPIN(xb_ld(&bar[XB_TOPGEN]) == tg, bar);
            __builtin_amdgcn_fence(__ATOMIC_ACQUIRE, "agent");
            xb_add(&bar[XB_XGEN(b.x)], 1u);
            asm volatile("s_waitcnt vmcnt(0)" ::: "memory");
            slot[0] = 0xffffffffu;
        } else {
            slot[0] = (nitems != 0u) ? xb_add(queue, 1u) : 0xffffffffu;
        }
    }
    __syncthreads();
    const unsigned ticket = (unsigned)__builtin_amdgcn_readfirstlane((int)slot[0]);
    if (ticket < nitems) work((int)ticket);
    if (t0 && !leader) {
        unsigned* bar = b.bar;
        XB_SPIN(xb_ld(&bar[XB_XGEN(b.x)]) == gen, bar);
        __builtin_amdgcn_fence(__ATOMIC_ACQUIRE, "agent");
        asm volatile("s_waitcnt vmcnt(0)" ::: "memory");
    }
    __syncthreads();
}
struct Args { const float* in[29]; float* out; unsigned char* ws; int ph_lo, ph_hi; };
static_assert(sizeof(Args) == 31 * 8 + 8, "Args has no padding");
constexpr int N_PHASES = 2 + 7 * NL;


typedef const __attribute__((address_space(4))) Args* KArgs;
__device__ __forceinline__ KArgs kargs() { KArgs p = (KArgs)__builtin_amdgcn_kernarg_segment_ptr(); asm volatile("" : "+s"(p)); return p; }
#define TIDS() int tid_ = wave0 * 64 + hw_lane(); asm volatile("" : "+v"(tid_)); const int tid = tid_, lane = tid & 63, wave = __builtin_amdgcn_readfirstlane(tid >> 6); (void)tid; (void)lane; (void)wave
#define GWS() int G_ = gridDim.x, bid_ = blockIdx.x; asm volatile("" : "+s"(G_), "+s"(bid_)); const int G = G_, bid = bid_; const int vcu = (G % 8 == 0) ? (bid % 8) * (G / 8) + bid / 8 : bid; const int gw = vcu * NWAVES + wave, NGW = G * NWAVES; (void)gw; (void)NGW

__global__ void __launch_bounds__(NWAVES * 64, 2) mk_fwd(Args args) {
    extern __shared__ __attribute__((aligned(16))) unsigned char lds_raw[];
    LAS unsigned char* lds = (LAS unsigned char*)lds_raw;
    const int wave0 = __builtin_amdgcn_readfirstlane((int)threadIdx.x >> 6);
    { const int tid0 = threadIdx.x; for (int u = tid0; u < (LDS_BYTES - LDSCTL_OFF) / 4; u += NWAVES * 64) ((LAS unsigned*)(lds + LDSCTL_OFF))[u] = 0u; }
    __syncthreads();
    const int lo = args.ph_lo, hi = args.ph_hi;
    const bool use_bar = (hi - lo) > 1;
    XcdBarrier bar; bar.bar = (unsigned*)(args.ws + WS_CTL) + CW_BAR; bar.x = 0; bar.st = nullptr;
    if (use_bar) bar = xcd_barrier_post((unsigned*)(args.ws + WS_CTL) + CW_BAR, (volatile LAS unsigned*)(lds + MISC_OFF) + 8, threadIdx.x == 0);
#define IN(k) (lo <= (k) && (k) < hi)
    const bool defer = BARWORK && use_bar && lo == 0 && hi == N_PHASES;
    auto conv_item = [&](int lnext, int r) {
        KArgs KA = kargs(); unsigned char* ws = KA->ws; const int tid = wave0 * 64 + hw_lane();
        const float* W; int K, N; bf16* WT; int rr = r;
        if (rr < J_IN) { W = KA->in[13] + (size_t)lnext * DM * DIN; K = DM; N = DIN; WT = (bf16*)(ws + WS_WIN) + (size_t)lnext * DIN * DM; }
        else if ((rr -= J_IN) < J_OUT) { W = KA->in[23] + (size_t)lnext * DM * DM; K = DM; N = DM; WT = (bf16*)(ws + WS_WOUT) + (size_t)lnext * DM * DM; }
        else if ((rr -= J_OUT) < J_UP) { W = KA->in[26] + (size_t)lnext * DM * DFF; K = DM; N = DFF; WT = (bf16*)(ws + WS_WUP) + (size_t)lnext * DFF * DM; }
        else { rr -= J_UP; W = KA->in[27] + (size_t)lnext * DFF * DM; K = DFF; N = DM; WT = (bf16*)(ws + WS_WDN) + (size_t)lnext * DM * DFF; }
        f32x4 pre[P0_NI]; p0_tile_load(W, N, rr, tid, pre); p0_tile_store(pre, K, N, WT, lds, rr, tid);
        __syncthreads();
    };
    auto qitems = [&](int lq) -> unsigned { return (unsigned)((BARWORK_LATE && lq == NL - 1) ? J_L - J_DN : J_L); };
    auto seam = [&](int k) {
        const bool t0 = (wave0 == 0 && hw_lane() == 0);
        const int L = (k < 2) ? 0 : (k - 2) / 7, lnext = L + 1;
        if (!defer) { xcd_barrier(bar, t0); return; }
        unsigned* qbase = (unsigned*)(kargs()->ws + WS_CTL) + CW_DQ;
        volatile LAS unsigned* slot = (volatile LAS unsigned*)(lds + MISC_OFF) + 10;
        if (lnext >= NL) {
            const int j = (k - 2) % 7;
            if (!BARWORK_LATE || j >= 5) { xcd_barrier(bar, t0); return; }
            unsigned* queue = qbase + 64 * NL;
            if (j == 4) {
                for (;;) {
                    __syncthreads();
                    if (t0) slot[0] = xb_add(queue, 1u);
                    __syncthreads();
                    const unsigned ticket = (unsigned)__builtin_amdgcn_readfirstlane((int)slot[0]);
                    if (ticket >= (unsigned)J_DN) break;
                    conv_item(L, J_L - J_DN + (int)ticket);
                }
                xcd_barrier(bar, t0);
                return;
            }
            xcd_barrier_work(bar, t0, queue, (unsigned)J_DN, slot, [&](int r) { conv_item(L, J_L - J_DN + r); });
            return;
        }
        unsigned* queue = qbase + 64 * lnext;
        if (k >= 2 && (k - 2) % 7 == 6) {
            const unsigned nq = qitems(lnext);
            for (;;) {
                __syncthreads();
                if (t0) slot[0] = xb_add(queue, 1u);
                __syncthreads();
                const unsigned ticket = (unsigned)__builtin_amdgcn_readfirstlane((int)slot[0]);
                if (ticket >= nq) break;
                conv_item(lnext, (int)ticket);
            }
            if (lnext + 1 < NL) { unsigned* q2 = queue + 64; const int l2 = lnext + 1;
                xcd_barrier_work(bar, t0, q2, qitems(l2), slot, [&](int r) { conv_item(l2, r); }); }
            else if (BARWORK_LATE) { unsigned* q2 = qbase + 64 * NL;
                xcd_barrier_work(bar, t0, q2, (unsigned)J_DN, slot, [&](int r) { conv_item(NL - 1, J_L - J_DN + r); }); }
            else xcd_barrier(bar, t0);
            return;
        }
        xcd_barrier_work(bar, t0, queue, qitems(lnext), slot, [&](int r) { conv_item(lnext, r); });
    };
#define SEAM(k) do { if (IN(k) && IN((k) + 1)) { seam(k); } } while (0)

    if (IN(0)) {
        KArgs KA = kargs(); unsigned char* ws = KA->ws; TIDS(); GWS();
#if P0_DYN
        unsigned* qctr = (unsigned*)(ws + WS_CTL) + CW_Q;
        volatile LAS unsigned* mq = (volatile LAS unsigned*)(lds + MISC_OFF) + 12;
        p0_mods<true>(qctr, mq, lds, KA->in[2], KA->in[3], KA->in[10], KA->in[11], KA->in[12], KA->in[24], KA->in[25], KA->in[28], (float*)(ws + WS_MOD), G, bid, tid);
#else
        p0_mods<false>(nullptr, nullptr, lds, KA->in[2], KA->in[3], KA->in[10], KA->in[11], KA->in[12], KA->in[24], KA->in[25], KA->in[28], (float*)(ws + WS_MOD), G, bid, tid);
#endif
        const float* w_in = KA->in[13]; const float* w_out = KA->in[23];
        bf16* WIN = (bf16*)(ws + WS_WIN); bf16* WOUT = (bf16*)(ws + WS_WOUT);
        LAS float* scr = (LAS float*)(lds + wave * 16384);
        constexpr int I_IN = (DM / 64) * (DIN / 32), I_OUT = (DM / 64) * (DM / 32), I_UP = (TAIL_MODE >= 1) ? 0 : (DM / 64) * (DFF / 32), I_DN = (TAIL_MODE >= 2) ? 0 : (DFF / 64) * (DM / 32), I_L = I_IN + I_OUT + I_UP + I_DN;
        const float* w_up = KA->in[26]; const float* w_down = KA->in[27]; bf16* WUP = (bf16*)(ws + WS_WUP); bf16* WDN = (bf16*)(ws + WS_WDN);
        {
        const int nfree = (G > MODS_ITEMS) ? (G - MODS_ITEMS) : 0, nslots = G + nfree;
        const int slot0 = (bid < MODS_ITEMS || nfree == 0) ? bid : MODS_ITEMS + (bid - MODS_ITEMS) * 2, nmine = (bid < MODS_ITEMS || nfree == 0) ? 1 : 2;
        const int NLIST = (BARWORK && (args.ph_hi - args.ph_lo) == N_PHASES) ? J_L : REP_P0 * NL * J_L;
        auto item_of = [&](int q) -> int { const int it = (q / nmine) * nslots + slot0 + (q % nmine); return it < NLIST ? it : -1; };
#if P0_DYN
#define P0_DECODE(it_, W_, K_, N_, WT_) do { const int l_ = ((it_) % (NL * J_L)) / J_L; int r_ = (it_) % J_L; \
            if (r_ < J_IN) { W_ = w_in + (size_t)l_ * DM * DIN; K_ = DM; N_ = DIN; WT_ = WIN + (size_t)l_ * DIN * DM; } \
            else if ((r_ -= J_IN) < J_OUT) { W_ = w_out + (size_t)l_ * DM * DM; K_ = DM; N_ = DM; WT_ = WOUT + (size_t)l_ * DM * DM; } \
            else if ((r_ -= J_OUT) < J_UP) { W_ = w_up + (size_t)l_ * DM * DFF; K_ = DM; N_ = DFF; WT_ = WUP + (size_t)l_ * DFF * DM; } \
            else { r_ -= J_UP; W_ = w_down + (size_t)l_ * DFF * DM; K_ = DFF; N_ = DM; WT_ = WDN + (size_t)l_ * DM * DFF; } \
            it_ = r_; } while (0)
        (void)item_of;
        constexpr int NIT = REP_P0 * NL * J_L;
        unsigned* qc = qctr + 64;
        unsigned nn = 0u;
        __syncthreads();
        if (tid == 0) { mq[0] = __hip_atomic_fetch_add(qc, 1u, __ATOMIC_RELAXED, __HIP_MEMORY_SCOPE_AGENT); mq[1] = __hip_atomic_fetch_add(qc, 1u, __ATOMIC_RELAXED, __HIP_MEMORY_SCOPE_AGENT);
                        nn = __hip_atomic_fetch_add(qc, 1u, __ATOMIC_RELAXED, __HIP_MEMORY_SCOPE_AGENT); }
        __syncthreads();
        int it = __builtin_amdgcn_readfirstlane((int)mq[0]), itn = __builtin_amdgcn_readfirstlane((int)mq[1]);
        f32x4 pre[8];
        const float* Wc = nullptr; int Kc = 0, Nc = 0; bf16* WTc = nullptr; int rc = it;
        if (it < NIT) { P0_DECODE(rc, Wc, Kc, Nc, WTc); p0_tile_load(Wc, Nc, rc, tid, pre); }
        while (it < NIT) {
            f32x4 cur[8];
#pragma unroll
            for (int i = 0; i < 8; ++i) cur[i] = pre[i];
            const float* Wn = nullptr; int Kn = 0, Nn = 0; bf16* WTn = nullptr; int rn = itn;
            if (itn < NIT) { P0_DECODE(rn, Wn, Kn, Nn, WTn); p0_tile_load(Wn, Nn, rn, tid, pre); }
            {
                LAS unsigned char* scr = lds;
                const int nblk = Nc / 256, kb = rc / nblk, nb = rc % nblk;
                __syncthreads();
#pragma unroll
                for (int i = 0; i < 8; ++i) { u32x2 w; w.x = pkbf(cur[i][0], cur[i][1]); w.y = pkbf(cur[i][2], cur[i][3]); *(LAS u32x2*)(scr + (8 * i + (tid >> 6)) * TP_PITCH + (tid & 63) * 8) = w; }
                if (tid == 0) { mq[0] = nn; nn = __hip_atomic_fetch_add(qc, 1u, __ATOMIC_RELAXED, __HIP_MEMORY_SCOPE_AGENT); }
                __syncthreads();
                const int kc = tid & 7;
#pragma unroll
                for (int j = 0; j < 4; ++j) { const int n = (tid >> 3) + 64 * j; const LAS unsigned char* sp = scr + (8 * kc) * TP_PITCH + n * 2;
                    unsigned short e[8];
#pragma unroll
                    for (int q = 0; q < 8; ++q) e[q] = *(const LAS unsigned short*)(sp + q * TP_PITCH);
                    v4u o; o.x = e[0] | ((unsigned)e[1] << 16); o.y = e[2] | ((unsigned)e[3] << 16); o.z = e[4] | ((unsigned)e[5] << 16); o.w = e[6] | ((unsigned)e[7] << 16);
                    *(GAS v4u*)(WTc + (size_t)(256 * nb + n) * Kc + 64 * kb + 8 * kc) = o; }
            }
            const int itnn = __builtin_amdgcn_readfirstlane((int)mq[0]);
            Wc = Wn; Kc = Kn; Nc = Nn; WTc = WTn; rc = rn; it = itn; itn = itnn;
        }
#elif P0_DEEP
#define P0_DECODE(it_, W_, K_, N_, WT_) do { const int l_ = ((it_) % (NL * J_L)) / J_L; int r_ = (it_) % J_L; \
            if (r_ < J_IN) { W_ = w_in + (size_t)l_ * DM * DIN; K_ = DM; N_ = DIN; WT_ = WIN + (size_t)l_ * DIN * DM; } \
            else if ((r_ -= J_IN) < J_OUT) { W_ = w_out + (size_t)l_ * DM * DM; K_ = DM; N_ = DM; WT_ = WOUT + (size_t)l_ * DM * DM; } \
            else if ((r_ -= J_OUT) < J_UP) { W_ = w_up + (size_t)l_ * DM * DFF; K_ = DM; N_ = DFF; WT_ = WUP + (size_t)l_ * DFF * DM; } \
            else { r_ -= J_UP; W_ = w_down + (size_t)l_ * DFF * DM; K_ = DFF; N_ = DM; WT_ = WDN + (size_t)l_ * DM * DFF; } \
            it_ = r_; } while (0)
        f32x4 pa[8], pb[8];
        int q = 0;
        int ita = item_of(0), itb = item_of(1);
        const float* Wa = nullptr; int Ka = 0, Na = 0; bf16* WTa = nullptr; int ra = ita;
        const float* Wb = nullptr; int Kb = 0, Nb = 0; bf16* WTb = nullptr; int rb = itb;
        if (ita >= 0) { P0_DECODE(ra, Wa, Ka, Na, WTa); p0_tile_load(Wa, Na, ra, tid, pa); }
        if (itb >= 0) { P0_DECODE(rb, Wb, Kb, Nb, WTb); p0_tile_load(Wb, Nb, rb, tid, pb); }
        while (ita >= 0) {
            { u32x2 w[8];
#pragma unroll
              for (int i = 0; i < 8; ++i) { w[i].x = pkbf(pa[i][0], pa[i][1]); w[i].y = pkbf(pa[i][2], pa[i][3]); }
              const int itn = item_of(q + 2); const float* Wn = nullptr; int Kn = 0, Nn = 0; bf16* WTn = nullptr; int rn = itn;
              if (itn >= 0) { P0_DECODE(rn, Wn, Kn, Nn, WTn); p0_tile_load(Wn, Nn, rn, tid, pa); }
              p0_tile_store_pk(w, Ka, Na, WTa, lds, ra, tid);
              Wa = Wn; Ka = Kn; Na = Nn; WTa = WTn; ra = rn; ita = itn; }
            if (itb < 0) break;
            { u32x2 w[8];
#pragma unroll
              for (int i = 0; i < 8; ++i) { w[i].x = pkbf(pb[i][0], pb[i][1]); w[i].y = pkbf(pb[i][2], pb[i][3]); }
              const int itn = item_of(q + 3); const float* Wn = nullptr; int Kn = 0, Nn = 0; bf16* WTn = nullptr; int rn = itn;
              if (itn >= 0) { P0_DECODE(rn, Wn, Kn, Nn, WTn); p0_tile_load(Wn, Nn, rn, tid, pb); }
              p0_tile_store_pk(w, Kb, Nb, WTb, lds, rb, tid);
              Wb = Wn; Kb = Kn; Nb = Nn; WTb = WTn; rb = rn; itb = itn; }
            q += 2;
        }
#else
        f32x4 pre[P0_NI];
        int q = 0, it = item_of(0);
#define P0_DECODE(it_, W_, K_, N_, WT_) do { const int l_ = ((it_) % (NL * J_L)) / J_L; int r_ = (it_) % J_L; \
            if (r_ < J_IN) { W_ = w_in + (size_t)l_ * DM * DIN; K_ = DM; N_ = DIN; WT_ = WIN + (size_t)l_ * DIN * DM; } \
            else if ((r_ -= J_IN) < J_OUT) { W_ = w_out + (size_t)l_ * DM * DM; K_ = DM; N_ = DM; WT_ = WOUT + (size_t)l_ * DM * DM; } \
            else if ((r_ -= J_OUT) < J_UP) { W_ = w_up + (size_t)l_ * DM * DFF; K_ = DM; N_ = DFF; WT_ = WUP + (size_t)l_ * DFF * DM; } \
            else { r_ -= J_UP; W_ = w_down + (size_t)l_ * DFF * DM; K_ = DFF; N_ = DM; WT_ = WDN + (size_t)l_ * DM * DFF; } \
            it_ = r_; } while (0)
        const float* Wc = nullptr; int Kc = 0, Nc = 0; bf16* WTc = nullptr; int rc = it;
        if (it >= 0) { P0_DECODE(rc, Wc, Kc, Nc, WTc); p0_tile_load(Wc, Nc, rc, tid, pre); }
        while (it >= 0) {
            const int itn = item_of(q + 1);
            f32x4 cur[P0_NI];
#pragma unroll
            for (int i = 0; i < P0_NI; ++i) cur[i] = pre[i];
            const float* Wn = nullptr; int Kn = 0, Nn = 0; bf16* WTn = nullptr; int rn = itn;
            if (itn >= 0) { P0_DECODE(rn, Wn, Kn, Nn, WTn); if (!(P0_PROBE == 2 && itn >= NL * J_L)) p0_tile_load(Wn, Nn, rn, tid, pre); }
            p0_tile_store(cur, Kc, Nc, WTc, lds, rc, tid, !(P0_PROBE == 1 && it >= NL * J_L));
            Wc = Wn; Kc = Kn; Nc = Nn; WTc = WTn; rc = rn; it = itn; ++q;
        }
#endif
#undef P0_DECODE
        }
    }
    SEAM(0);
    if (IN(1)) {
        KArgs KA = kargs(); unsigned char* ws = KA->ws; TIDS(); GWS();
        const float* x_p = KA->in[0]; const float* x_s = KA->in[1]; const float* g_pre_mix = KA->in[12];
        const float* MOD = (const float*)(ws + WS_MOD); bf16* Hb = (bf16*)(ws + WS_H); bf16* MIXb = (bf16*)(ws + WS_MIX);
        for (int row = MR + gw; row < MT; row += NGW) {
            u32x2* o = (u32x2*)(Hb + (size_t)row * DM) + lane; u32x2* o2 = (u32x2*)(MIXb + (size_t)row * DM) + lane;
#pragma unroll
            for (int j = 0; j < 8; ++j) { o[64 * j] = (u32x2){0u, 0u}; o2[64 * j] = (u32x2){0u, 0u}; }
        }
        for (int r4 = gw; r4 < MP / 4; r4 += NGW) {
            const float* md = MOD + ((size_t)0 * 12 + mod_row_of(4 * r4)) * NMOD;
            f32x4 ev[8], fv[8]; ROW_LD(ev, md + DM); ROW_LD(fv, md);
#pragma unroll 1
            for (int ri = 0; ri < 4; ++ri) {
                const int row = 4 * r4 + ri;
                f32x4 v[8]; ROW_LD(v, x_p + (size_t)row * DM);
                const float rstd = 1.0f / sqrtf(row_sumsq(v) * (1.0f / DM) + RMS_EPS);
                norm_store(v, rstd, ev, fv, Hb + (size_t)row * DM, lane);
            }
        }
        for (int sr = bid; sr < MS; sr += G) {
            __syncthreads();
            const int row = MP + sr; const float* md = MOD + ((size_t)0 * 12 + mod_row_of(row)) * NMOD;
            coop_row(nullptr, x_s + (size_t)sr * DM, nullptr, nullptr, md + DM, md, nullptr, nullptr, Hb + (size_t)row * DM, (LAS float*)lds, tid);
        }
    }
    SEAM(1);

    for (int l = 0; l < NL; ++l) {
        const int pb = 2 + 7 * l;
        if (IN(pb + 0)) {
            { KArgs KA = kargs(); unsigned char* ws = KA->ws;
              pg8::Gemm g{(const bf16*)(ws + WS_H), (const bf16*)(ws + WS_WIN) + (size_t)l * DIN * DM, MP, 4096, DM}; pg8::StaticOrder S; { int G_ = gridDim.x, bid_ = blockIdx.x; asm volatile("" : "+s"(G_), "+s"(bid_)); S.init(MP, 4096, G_, bid_, REP_A); }
              pg8::EpiInProj E{(bf16*)(ws + WS_Z), KA->out, l};
              pg8::gemm_phase<pg8::EpiInProj, pg8::StaticOrder, true, true>(lds, g, S, E, wave0 * 64 + hw_lane()); }
            { KArgs KA = kargs(); unsigned char* ws = KA->ws; TIDS(); GWS();
              SkEpiT16 SE{(bf16*)(ws + WS_Z), KA->out, l};
              mini_gemm<64, 128, 1, 4, 2, 2, SkEpiT16>(lds, (const bf16*)(ws + WS_H), DM, MP, (const bf16*)(ws + WS_WIN) + (size_t)l * DIN * DM + (size_t)4096 * DM, 256, DM, tid, bid, G, SE); }
            { KArgs KA = kargs(); unsigned char* ws = KA->ws; TIDS(); GWS();
              SkEpiInProj SE{(bf16*)(ws + WS_Z) + (size_t)MP * DIN, KA->out, l};
              mini_gemm<32, 128, 1, 4, 2, 2, SkEpiInProj>(lds, (const bf16*)(ws + WS_H) + (size_t)MP * DM, DM, MS, (const bf16*)(ws + WS_WIN) + (size_t)l * DIN * DM, DIN, DM, tid, bid, G, SE); }
        }
        SEAM(pb + 0);
        if (IN(pb + 1)) {
            {
            KArgs KA = kargs(); unsigned char* ws = KA->ws; TIDS(); GWS();
            const bf16* Zb = (const bf16*)(ws + WS_Z); bf16* MIXb = (bf16*)(ws + WS_MIX); float* out = KA->out;
            for (int un0 = bid; un0 < 256 * REP_B1; un0 += G) { const int un = un0 & 255;
                __syncthreads();
                const int unl = (G == 256) ? (((un >> 5) * 8 + (un & 7)) * 4 + ((un >> 3) & 3)) : un;
                const int b = unl >> 6, n = (unl >> 2) & 15, dq = unl & 3;
                LruUnit U; U.zseq = Zb + (size_t)(b * TP) * DIN; U.prefix = nullptr;
                LAS unsigned char* bl = lds + LX_BL_OFF; LAS float* bsum = (LAS float*)(lds + LX_BS_OFF);
                lru_setup_lds(U, bl, bsum, wave, l, n, dq, KA->in[15], KA->in[16], KA->in[17], KA->in[19], KA->in[21]);
                const int ch = lane & 15, tq = lane >> 4;
                LAS unsigned char* slab = lds;
                LAS float* ex = (LAS float*)(lds + LX_EX_OFF);
                const bf16* zcol = U.zseq + C_XB + 64 * n;
                v4u st[8];
                const int r0 = tid >> 3, c8 = tid & 7;
                const bf16* zsrc = zcol + (size_t)r0 * DIN + 8 * c8;
                LAS unsigned char* sdst = slab + (r0 + 3) * LX_PITCH + (c8 ^ (((r0 + 3) >> 4) & 3)) * 16;
                const bf16* gsrc = Zb + (size_t)(b * TP + (tid >> 1)) * DIN + C_GB + U.chn - (lane & 15) + 8 * (tid & 1);
                LAS unsigned char* gdst = lds + LX_GS_OFF + (tid >> 1) * 32 + (tid & 1) * 16;
                v4u gst[2];
#pragma unroll
                for (int i = 0; i < 8; ++i) st[i] = *(const v4u*)(zsrc + (size_t)(64 * i) * DIN);
                gst[0] = *(const v4u*)gsrc; gst[1] = *(const v4u*)(gsrc + (size_t)256 * DIN);
#pragma unroll
                for (int i = 0; i < 8; ++i) *(LAS v4u*)(sdst + i * 64 * LX_PITCH) = st[i];
                *(LAS v4u*)gdst = gst[0]; *(LAS v4u*)(gdst + 256 * 32) = gst[1];
                if (tid < 24) { unsigned z_; asm volatile("v_mov_b32 %0, 0" : "=v"(z_)); *(LAS v4u*)(slab + (tid >> 3) * LX_PITCH + c8 * 16) = (v4u){z_, z_, z_, z_}; }
                __syncthreads();
                U.rb = KA->in[18][(size_t)(l * 16 + n) * 64 + 16 * dq + ch] + bsum[0 * 16 + ch] + bsum[2 * 16 + ch];
                U.ib = KA->in[20][(size_t)(l * 16 + n) * 64 + 16 * dq + ch] + bsum[1 * 16 + ch] + bsum[3 * 16 + ch];
                float hstart = 0.f;
#pragma unroll 1
                for (int R = 0; R < 4; ++R) {
                    v4u hist;
                    if (R + 1 < 4) {
#pragma unroll
                        for (int i = 0; i < 8; ++i) st[i] = *(const v4u*)(zsrc + (size_t)((R + 1) * 512 + 64 * i) * DIN);
                        gst[0] = *(const v4u*)(gsrc + (size_t)((R + 1) * 512) * DIN); gst[1] = *(const v4u*)(gsrc + (size_t)((R + 1) * 512 + 256) * DIN);
                        if (tid < 24) hist = *(const LAS v4u*)(slab + (512 + (tid >> 3)) * LX_PITCH + c8 * 16);
                    }
                    const int tw = R * 512 + wave * 64;
                    float Ac, Hc; float P[16], hl[16];
                    lru_round_lds(U, slab, bl, wave * 64, dq, Ac, Hc, P, hl);
                    if (tq == 0) { ex[(wave * 16 + ch) * 2] = Ac; ex[(wave * 16 + ch) * 2 + 1] = Hc; }
                    __syncthreads();
                    float hs = hstart, hin = 0.f;
#pragma unroll
                    for (int w2 = 0; w2 < 8; ++w2) { const float A2 = ex[(w2 * 16 + ch) * 2], H2 = ex[(w2 * 16 + ch) * 2 + 1]; if (w2 == wave) hin = hs; hs = A2 * hs + H2; }
                    hstart = hs;
                    if (R + 1 < 4) {
#pragma unroll
                        for (int i = 0; i < 8; ++i) *(LAS v4u*)(sdst + i * 64 * LX_PITCH) = st[i];
                        if (tid < 24) *(LAS v4u*)(slab + (tid >> 3) * LX_PITCH + c8 * 16) = hist;
                        *(LAS v4u*)(gdst + ((R + 1) & 1) * 16384) = gst[0]; *(LAS v4u*)(gdst + ((R + 1) & 1) * 16384 + 256 * 32) = gst[1];
                    }
                    float gbv[16];
                    { const LAS unsigned char* gp = lds + LX_GS_OFF + (R & 1) * 16384 + (wave * 64 + 16 * tq) * 32 + ch * 2;
#pragma unroll
                    for (int k = 0; k < 16; ++k) gbv[k] = bf2f(*(const LAS unsigned short*)(gp + k * 32)); }
#pragma unroll
                    for (int k = 0; k < 16; ++k) {
                        const int t = tw + 16 * tq + k; const size_t row = (size_t)(b * TP + t);
                        const float hv = hl[k] + P[k] * hin;
                        MIXb[row * DM + 512 + U.chn] = (bf16)f2bf(hv * gelu_tanh(gbv[k]));
                        if (t == TP - 1) out[O_LHP + (size_t)(l * BP + b) * 1024 + U.chn] = hv;
                    }
                    __syncthreads();
                }
            }
            }
            {
            KArgs KA = kargs(); unsigned char* ws = KA->ws; TIDS(); GWS();
            const bf16* Zb = (const bf16*)(ws + WS_Z); bf16* MIXb = (bf16*)(ws + WS_MIX); const float* rel_bias = KA->in[22];
            for (int un0 = bid; un0 < 256 * REP_B2; un0 += G) { const int un = un0 & 255;
                __syncthreads();
                const int unb = (G == 256) ? ((((un & 7) + 8 * (un >> 6)) * 8) + ((un >> 3) & 7)) : un;
                const int b = unb >> 6, hd = (unb >> 3) & 7, cg = unb & 7;
                LAS float* tbl = (LAS float*)(lds + 2 * AK_BYTES + 2 * AV_BYTES);
                for (int e = tid; e < 257; e += 512) tbl[e] = rel_bias[((size_t)l * 8 + hd) * 257 + e] * LOG2E;
                const int first = (4 * cg - 8) > 0 ? (4 * cg - 8) : 0, ntiles = 2 * (4 * cg + 3 - first + 1);
                const int cq = 4 * cg + (wave >> 1), r = lane & 31;
                const size_t qrowi = (size_t)(b * TP + cq * 64 + 32 * (wave & 1) + r);
                AttnWave W; W.active = true; W.wr = true; W.qrow = Zb + qrowi * DIN + C_QC + hd * 64; W.orow = MIXb + qrowi * DM + 1536 + hd * 64;
                W.qpos = cq * 64 + 32 * (wave & 1) + r; W.m0 = -1e30f; W.l0 = 0.f;
                SrcZ src{Zb + (size_t)(b * TP) * DIN, 64 * first, C_KC + hd * 64, C_VC + hd * 64};
                const int klo = (cq - 8) > first ? (cq - 8) : first;
                RelBandP rel{2 * (klo - first), 2 * (cq - first) + 1};
                attn_run<true, true, false, SrcZ, RelBandP, (ATT_ROT != 0)>(lds, lds + 2 * AK_BYTES, tbl, tid, 0, 1, ntiles, 64 * first, -1, src, rel, W, nullptr);
            }
            }
            {
            KArgs KA = kargs(); unsigned char* ws = KA->ws; TIDS(); GWS();
            const bf16* Zb = (const bf16*)(ws + WS_Z); bf16* MIXb = (bf16*)(ws + WS_MIX); const float* swa_sink = KA->in[14];
            for (int un0 = bid; un0 < 256 * REP_B3; un0 += G) { const int un = un0 & 255;
                __syncthreads();
                const int b = un >> 6, c = (un >> 1) & 31, kvh = un & 1;
                const int first = (c - 2) > 0 ? (c - 2) : 0; int ntiles = 2 * (c - first + 1);
#ifdef B3_PROBE_TILES
                if (un0 + G < 256 * REP_B3) ntiles = ntiles < B3_PROBE_TILES ? ntiles : B3_PROBE_TILES;
#endif
                const int gq = wave >> 1, r = lane & 31;
                const size_t qrowi = (size_t)(b * TP + c * 64 + 32 * (wave & 1) + r);
                AttnWave W; W.active = true; W.wr = true; W.qrow = Zb + qrowi * DIN + C_QA + kvh * 256 + gq * 64; W.orow = MIXb + qrowi * DM + kvh * 256 + gq * 64;
                W.qpos = 0; W.m0 = swa_sink[l * 8 + kvh * 4 + gq] * LOG2E; W.l0 = (lane < 32) ? 1.0f : 0.f;
                SrcZ src{Zb + (size_t)(b * TP) * DIN, 64 * first, C_KA + kvh * 64, C_VA + kvh * 64};
#if SWA_ALL
                attn_run_all<6, SrcZ>(lds, lds + 6 * AK_BYTES, tid, ntiles, src, W);
#else
                attn_run<true, false, false, SrcZ, RelAll>(lds, lds + 2 * AK_BYTES, nullptr, tid, 0, 1, ntiles, 0, -1, src, RelAll{}, W, nullptr);
#endif
            }
            }
            {
            KArgs KA = kargs(); unsigned char* ws = KA->ws; TIDS(); GWS();
            const bf16* Zb = (const bf16*)(ws + WS_Z); bf16* MIXb = (bf16*)(ws + WS_MIX); float* out = KA->out;
            for (int un = bid; un < 256; un += G) {
                if (wave < 2) {
                    const int uidx = un * 2 + wave, bs = uidx >> 6, n = (uidx >> 2) & 15, dq = uidx & 3;
                    LruUnit U; U.zseq = Zb + (size_t)(MP + bs * TS) * DIN; U.prefix = KA->in[9] + ((size_t)(l * BS + bs) * 3) * 1024;
                    lru_setup(U, l, n, dq, KA->in[15], KA->in[16], KA->in[17], KA->in[18], KA->in[19], KA->in[20], KA->in[21]);
                    float Ac = 1.0f, Hc = 0.f, P[4], hl[4];
                    lru_tile(U, 0, Ac, Hc, P, hl);
                    const float hin = KA->in[8][(size_t)(l * BS + bs) * 1024 + U.chn];
                    const int tq = lane >> 4;
#pragma unroll
                    for (int j = 0; j < 4; ++j) {
                        const int t = 4 * tq + j; const size_t row = (size_t)(MP + bs * TS + t);
                        const float hv = hl[j] + P[j] * hin;
                        const float gb = bf2f(Zb[row * DIN + C_GB + U.chn]);
                        MIXb[row * DM + 512 + U.chn] = (bf16)f2bf(hv * gelu_tanh(gb));
                        if (t == TS - 1) out[O_LHS + (size_t)(l * BS + bs) * 1024 + U.chn] = hv;
                    }
                }
            }
            }
            {
            KArgs KA = kargs(); unsigned char* ws = KA->ws; TIDS(); GWS();
            const bf16* Zb = (const bf16*)(ws + WS_Z); bf16* MIXb = (bf16*)(ws + WS_MIX); const float* swa_sink = KA->in[14];
            for (int un = (G == 256) ? ((((bid >> 3) & 7) == 0) ? ((bid & 7) + 8 * (bid >> 6)) : 16) : bid; un < 16; un += G) {
                __syncthreads();
                const int bs = un >> 1, kvh = un & 1, r = lane & 31;
                const int gq = 2 * (wave & 1) + (r >> 4), t = r & 15;
                const size_t qrowi = (size_t)(MP + bs * TS + t);
                AttnWave W; W.active = wave < 2; W.wr = true; W.qrow = Zb + qrowi * DIN + C_QA + kvh * 256 + gq * 64; W.orow = MIXb + qrowi * DM + kvh * 256 + gq * 64;
                W.qpos = 0; W.m0 = swa_sink[l * 8 + kvh * 4 + gq] * LOG2E; W.l0 = (lane < 32) ? 1.0f : 0.f;
                SrcCache src{KA->in[4] + ((size_t)(l * BS + bs) * 128 * 2 + kvh) * 64, KA->in[5] + ((size_t)(l * BS + bs) * 128 * 2 + kvh) * 64, 2 * 64, 4,
                             Zb + (size_t)(MP + bs * TS) * DIN, C_KA + kvh * 64, C_VA + kvh * 64};
                attn_run<true, false, false, SrcCache, RelAll>(lds, lds + 2 * AK_BYTES, nullptr, tid, 0, 1, 5, 0, 4, src, RelAll{}, W, nullptr);
            }
            }
            {
            KArgs KA = kargs(); unsigned char* ws = KA->ws; TIDS(); GWS();
            const bf16* Zb = (const bf16*)(ws + WS_Z); bf16* MIXb = (bf16*)(ws + WS_MIX); const float* rel_bias = KA->in[22];
            constexpr int WREG = AK_BYTES + AV_BYTES + ATBL_BYTES;
            for (int un = (G == 256) ? ((((bid >> 3) & 7) < 2) ? ((bid & 7) + 8 * (bid >> 6)) * 2 + ((bid >> 3) & 7) : 64) : bid; un < 64; un += G) {
                __syncthreads();
                const int bs = un >> 3, hd = un & 7, r = lane & 31, t = r & 15;
                LAS float* tbl = (LAS float*)(lds + 8 * WREG);
                for (int e = tid; e < 257; e += 512) tbl[e] = rel_bias[((size_t)l * 8 + hd) * 257 + e] * LOG2E;
                __syncthreads();
                LAS unsigned char* wb = lds + wave * WREG;
                const size_t qrowi = (size_t)(MP + bs * TS + t);
                AttnWave W; W.active = true; W.wr = false; W.qrow = Zb + qrowi * DIN + C_QC + hd * 64; W.orow = nullptr;
                W.qpos = t; W.m0 = -1e30f; W.l0 = 0.f;
                SrcCache src{KA->in[6] + ((size_t)(l * BS + bs) * 512 * 8 + hd) * 64, KA->in[7] + ((size_t)(l * BS + bs) * 512 * 8 + hd) * 64, 8 * 64, 16,
                             Zb + (size_t)(MP + bs * TS) * DIN, C_KC + hd * 64, C_VC + hd * 64};
                attn_run<false, true, true, SrcCache, RelAll>(wb, wb + AK_BYTES, tbl, lane, wave, 8, wave == 0 ? 3 : 2, -512, 16, src, RelAll{}, W, (LAS float*)wb);
                __syncthreads();
                { const int q = tid & 15, d = tid >> 4;
                  float mw[8], M = -3e38f;
#pragma unroll
                  for (int w = 0; w < 8; ++w) { mw[w] = ((const LAS float*)(lds + w * WREG))[q]; M = fmaxf(M, mw[w]); }
                  float L = 0.f, a0 = 0.f, a1 = 0.f;
#pragma unroll
                  for (int w = 0; w < 8; ++w) { const LAS float* pw = (const LAS float*)(lds + w * WREG); const float f = fexp2(mw[w] - M); L += pw[32 + q] * f; a0 += pw[64 + d * 32 + q] * f; a1 += pw[64 + (d + 32) * 32 + q] * f; }
                  const float inv = 1.0f / L; bf16* orow = MIXb + (size_t)(MP + bs * TS + q) * DM + 1536 + hd * 64;
                  orow[d] = (bf16)f2bf(a0 * inv); orow[d + 32] = (bf16)f2bf(a1 * inv); }
            }
            }
            __syncthreads();
        }
        SEAM(pb + 1);
        if (IN(pb + 2)) {
            { KArgs KA = kargs(); unsigned char* ws = KA->ws; TIDS(); GWS();
              SkEpiBf16 SE{(bf16*)(ws + WS_T) + (size_t)MP * DM, DM};
              mini_gemm<32, 32, 1, 1, 8, 4, SkEpiBf16>(lds, (const bf16*)(ws + WS_MIX) + (size_t)MP * DM, DM, MS, (const bf16*)(ws + WS_WOUT) + (size_t)l * DM * DM, DM, DM, tid, bid, G, SE); }
            KArgs KA = kargs(); unsigned char* ws = KA->ws;
            pg8::Gemm g{(const bf16*)(ws + WS_MIX), (const bf16*)(ws + WS_WOUT) + (size_t)l * DM * DM, MP, DM, DM}; pg8::StaticOrder S; int G_ = gridDim.x, bid_ = blockIdx.x; asm volatile("" : "+s"(G_), "+s"(bid_)); S.init(MP, DM, G_, bid_, REP_C);
            if (FUSE_THIN && G_ == 256) {
                const float* md = (const float*)(ws + WS_MOD) + (size_t)l * 12 * NMOD;
                pg8::PanelRms st{(unsigned long long*)(ws + WS_XCH + (size_t)(2 * l) * MiB), (unsigned*)(ws + WS_CTL) + CW_SEAM + (2 * l) * 32 * 64, (unsigned*)(ws + WS_CTL), 0x700u};
                pg8::EpiFuse E{(l == 0) ? KA->in[0] : (const float*)KA->out, KA->out, (bf16*)(ws + WS_H), md + 2 * DM, md + 4 * DM, md + 3 * DM, NMOD, st};
                pg8::gemm_phase<pg8::EpiFuse, pg8::StaticOrder, false, true>(lds, g, S, E, wave0 * 64 + hw_lane());
            } else {
                pg8::EpiBf16 E{(bf16*)(ws + WS_T), DM};
                pg8::gemm_phase<pg8::EpiBf16, pg8::StaticOrder, true, true>(lds, g, S, E, wave0 * 64 + hw_lane());
            }
        }
        SEAM(pb + 2);
        if (IN(pb + 3)) {
            KArgs KA = kargs(); unsigned char* ws = KA->ws; TIDS(); GWS();
            const float* x_p = KA->in[0]; const float* x_s = KA->in[1]; const float* g_post_mix = KA->in[24]; const float* g_pre_mlp = KA->in[25]; float* out = KA->out;
            const float* MOD = (const float*)(ws + WS_MOD); bf16* Hb = (bf16*)(ws + WS_H); const bf16* Tb = (const bf16*)(ws + WS_T); bf16* XR = (bf16*)(ws + WS_XR);
            const bool fusedp = FUSE_THIN && G == 256;
#if COOP_SPLIT
            const bool has_s = bid < MS;
            if (has_s) { const int row = MP + bid; const float* md = MOD + ((size_t)l * 12 + mod_row_of(row)) * NMOD;
                coop_dma(lds, Tb + (size_t)row * DM, (l == 0) ? x_s + (size_t)bid * DM : (const float*)nullptr, (l == 0) ? (const bf16*)nullptr : XR + (size_t)row * DM, md + 2 * DM, md + 4 * DM, md + 3 * DM, wave, lane); }
#endif
            for (int r4 = fusedp ? MP : gw; r4 < MP / 4; r4 += NGW) {
                const float* md = MOD + ((size_t)l * 12 + mod_row_of(4 * r4)) * NMOD;
                f32x4 cv[8], ev[8], fv[8];
                ROW_LD(cv, md + 2 * DM); ROW_LD(ev, md + 4 * DM); ROW_LD(fv, md + 3 * DM);
#pragma unroll 1
                for (int ri = 0; ri < 4; ++ri) {
                    const int row = 4 * r4 + ri;
                    f32x4 tv[8], xv[8];
                    ROW_LD_BF16(tv, Tb + (size_t)row * DM);
                    if (l == 0) { ROW_LD(xv, x_p + (size_t)row * DM); } else { ROW_LD_BF16(xv, XR + (size_t)row * DM); }
                    const float rt_ = 1.0f / sqrtf(row_sumsq(tv) * (1.0f / DM) + RMS_EPS);
#pragma unroll
                    for (int j = 0; j < 8; ++j) xv[j] = xv[j] + (tv[j] * rt_) * cv[j];
                    ROW_ST_BF16(XR + (size_t)row * DM, xv);
                    const float rx = 1.0f / sqrtf(row_sumsq(xv) * (1.0f / DM) + RMS_EPS);
                    norm_store(xv, rx, ev, fv, Hb + (size_t)row * DM, lane);
                }
            }
#if COOP_SPLIT
            if (has_s) { const int row = MP + bid; asm volatile("s_waitcnt vmcnt(0)" ::: "memory"); __syncthreads(); const unsigned char* Lg = lds_raw + CD_BASE;
                coop_row((const bf16*)(Lg + CD_T), (const float*)(Lg + CD_X), (l == 0) ? (const bf16*)nullptr : (const bf16*)(Lg + CD_X), (const float*)(Lg + CD_C), (const float*)(Lg + CD_E), (const float*)(Lg + CD_F), nullptr, XR + (size_t)row * DM, Hb + (size_t)row * DM, (LAS float*)lds, tid); }
            for (int sr = bid + G; sr < MS; sr += G) {
#else
            for (int sr = bid; sr < MS; sr += G) {
#endif
                __syncthreads();
                const int row = MP + sr; const float* md = MOD + ((size_t)l * 12 + mod_row_of(row)) * NMOD;
                coop_row(Tb + (size_t)row * DM, x_s + (size_t)sr * DM, (l == 0) ? (const bf16*)nullptr : XR + (size_t)row * DM, md + 2 * DM, md + 4 * DM, md + 3 * DM, nullptr, XR + (size_t)row * DM, Hb + (size_t)row * DM, (LAS float*)lds, tid);
            }
        }
        SEAM(pb + 3);
        if (IN(pb + 4)) {
            { KArgs KA = kargs(); unsigned char* ws = KA->ws; TIDS(); GWS();
              SkEpiRelu2 SE{(bf16*)(ws + WS_F1) + (size_t)MP * DFF, DFF};
              mini_gemm<64, 64, 1, 2, 4, 2, SkEpiRelu2>(lds, (const bf16*)(ws + WS_H) + (size_t)MP * DM, DM, MS, (const bf16*)(ws + WS_WUP) + (size_t)l * DFF * DM, DFF, DM, tid, bid, G, SE); }
            KArgs KA = kargs(); unsigned char* ws = KA->ws;
            pg8::Gemm g{(const bf16*)(ws + WS_H), (const bf16*)(ws + WS_WUP) + (size_t)l * DFF * DM, MP, DFF, DM}; pg8::StaticOrder S; { int G_ = gridDim.x, bid_ = blockIdx.x; asm volatile("" : "+s"(G_), "+s"(bid_)); S.init(MP, DFF, G_, bid_, REP_E); }
            pg8::EpiRelu2 E{(bf16*)(ws + WS_F1), DFF};
            pg8::gemm_phase<pg8::EpiRelu2, pg8::StaticOrder, true, true>(lds, g, S, E, wave0 * 64 + hw_lane());
        }
        SEAM(pb + 4);
        if (IN(pb + 5)) {
            { KArgs KA = kargs(); unsigned char* ws = KA->ws; TIDS(); GWS();
              SkEpiBf16 SE{(bf16*)(ws + WS_T) + (size_t)MP * DM, DM};
              mini_gemm<32, 32, 1, 1, 8, 4, SkEpiBf16>(lds, (const bf16*)(ws + WS_F1) + (size_t)MP * DFF, DFF, MS, (const bf16*)(ws + WS_WDN) + (size_t)l * DM * DFF, DM, DFF, tid, bid, G, SE); }
            KArgs KA = kargs(); unsigned char* ws = KA->ws;
            pg8::Gemm g{(const bf16*)(ws + WS_F1), (const bf16*)(ws + WS_WDN) + (size_t)l * DM * DFF, MP, DM, DFF}; pg8::StaticOrder S; int G_ = gridDim.x, bid_ = blockIdx.x; asm volatile("" : "+s"(G_), "+s"(bid_)); S.init(MP, DM, G_, bid_, REP_F);
            if (FUSE_THIN && G_ == 256) {
                const float* md = (const float*)(ws + WS_MOD) + (size_t)l * 12 * NMOD; const float* md2 = (const float*)(ws + WS_MOD) + (size_t)(l + 1 < NL ? l + 1 : l) * 12 * NMOD;
                pg8::PanelRms st{(unsigned long long*)(ws + WS_XCH + (size_t)(2 * l + 1) * MiB), (unsigned*)(ws + WS_CTL) + CW_SEAM + (2 * l + 1) * 32 * 64, (unsigned*)(ws + WS_CTL), 0x780u};
                pg8::EpiFuse E{(const float*)KA->out, KA->out, (l + 1 < NL) ? (bf16*)(ws + WS_H) : (bf16*)nullptr, md + 5 * DM, md2 + DM, md2, NMOD, st};
                pg8::gemm_phase<pg8::EpiFuse, pg8::StaticOrder, false, true>(lds, g, S, E, wave0 * 64 + hw_lane());
            } else {
                pg8::EpiBf16 E{(bf16*)(ws + WS_T), DM};
                pg8::gemm_phase<pg8::EpiBf16, pg8::StaticOrder, true, true>(lds, g, S, E, wave0 * 64 + hw_lane());
            }
        }
        SEAM(pb + 5);
        if (IN(pb + 6)) {
            KArgs KA = kargs(); unsigned char* ws = KA->ws; TIDS(); GWS();
            const float* g_post_mlp = KA->in[28]; const float* g_pre_mix = KA->in[12]; float* out = KA->out;
            const float* MOD = (const float*)(ws + WS_MOD); bf16* Hb = (bf16*)(ws + WS_H); const bf16* Tb = (const bf16*)(ws + WS_T); bf16* XR = (bf16*)(ws + WS_XR);
            const bool fusedp = FUSE_THIN && G == 256;
#if COOP_SPLIT
            const bool has_s = bid < MS;
            if (has_s) { const int row = MP + bid; const float* md = MOD + ((size_t)l * 12 + mod_row_of(row)) * NMOD; const float* md2 = MOD + ((size_t)(l + 1 < NL ? l + 1 : l) * 12 + mod_row_of(row)) * NMOD;
                coop_dma(lds, Tb + (size_t)row * DM, nullptr, XR + (size_t)row * DM, md + 5 * DM, md2 + DM, md2, wave, lane); }
#endif
            for (int r4 = fusedp ? MP : gw; r4 < MP / 4; r4 += NGW) {
                const float* md = MOD + ((size_t)l * 12 + mod_row_of(4 * r4)) * NMOD;
                const float* md2 = MOD + ((size_t)(l + 1 < NL ? l + 1 : l) * 12 + mod_row_of(4 * r4)) * NMOD;
                f32x4 cv[8], ev[8], fv[8];
                ROW_LD(cv, md + 5 * DM); ROW_LD(ev, md2 + DM); ROW_LD(fv, md2);
#pragma unroll 1
                for (int ri = 0; ri < 4; ++ri) {
                    const int row = 4 * r4 + ri;
                    f32x4 tv[8], xv[8];
                    ROW_LD_BF16(tv, Tb + (size_t)row * DM); ROW_LD_BF16(xv, XR + (size_t)row * DM);
                    const float rt_ = 1.0f / sqrtf(row_sumsq(tv) * (1.0f / DM) + RMS_EPS);
#pragma unroll
                    for (int j = 0; j < 8; ++j) xv[j] = xv[j] + (tv[j] * rt_) * cv[j];
                    if (l + 1 < NL) {
                        ROW_ST_BF16(XR + (size_t)row * DM, xv);
                        const float rx = 1.0f / sqrtf(row_sumsq(xv) * (1.0f / DM) + RMS_EPS);
                        norm_store(xv, rx, ev, fv, Hb + (size_t)row * DM, lane);
                    } else {
                        f32x4* o4 = (f32x4*)(out + (size_t)row * DM) + 2 * lane;
#pragma unroll
                        for (int g = 0; g < 4; ++g) { o4[128 * g] = xv[2 * g]; o4[128 * g + 1] = xv[2 * g + 1]; }
                    }
                }
            }
#if COOP_SPLIT
            if (has_s) { const int row = MP + bid; asm volatile("s_waitcnt vmcnt(0)" ::: "memory"); __syncthreads(); const unsigned char* Lg = lds_raw + CD_BASE;
                coop_row((const bf16*)(Lg + CD_T), nullptr, (const bf16*)(Lg + CD_X), (const float*)(Lg + CD_C), (const float*)(Lg + CD_E), (const float*)(Lg + CD_F), out + (size_t)row * DM, (l + 1 < NL) ? XR + (size_t)row * DM : (bf16*)nullptr, (l + 1 < NL) ? Hb + (size_t)row * DM : (bf16*)nullptr, (LAS float*)lds, tid); }
            for (int sr = bid + G; sr < MS; sr += G) {
#else
            for (int sr = bid; sr < MS; sr += G) {
#endif
                __syncthreads();
                const int row = MP + sr; const float* md = MOD + ((size_t)l * 12 + mod_row_of(row)) * NMOD;
                const float* md2 = MOD + ((size_t)(l + 1 < NL ? l + 1 : l) * 12 + mod_row_of(row)) * NMOD;
                coop_row(Tb + (size_t)row * DM, nullptr, XR + (size_t)row * DM, md + 5 * DM, md2 + DM, md2, out + (size_t)row * DM, (l + 1 < NL) ? XR + (size_t)row * DM : (bf16*)nullptr, (l + 1 < NL) ? Hb + (size_t)row * DM : (bf16*)nullptr, (LAS float*)lds, tid);
            }
        }
        SEAM(pb + 6);
    }
#undef IN
#undef SEAM
}

#ifndef MK_SINGLE
#define MK_SINGLE 0
#endif
extern "C" void kernel_launch(void* const* d_in, const int* in_sizes, int n_in, void* d_out, int out_size, void* d_ws, size_t ws_size, hipStream_t stream) {
    static int grid = 0;
    if (grid == 0) {
        if (n_in != 29 || in_sizes[0] != MP * DM || (size_t)out_size != O_END || ws_size < WS_END) {
            fprintf(stderr, "kernel_launch: unexpected shapes: n_in %d in0 %d out %d (want %zu) ws %zu (want %zu); nothing launched\n", n_in, n_in > 0 ? in_sizes[0] : -1, out_size, (size_t)O_END, ws_size, (size_t)WS_END);
            grid = -1; return; }
        int dev = 0, cus = 0, per_cu = 0;
        if (hipGetDevice(&dev) != hipSuccess || hipDeviceGetAttribute(&cus, hipDeviceAttributeMultiprocessorCount, dev) != hipSuccess) { fprintf(stderr, "kernel_launch: device query failed\n"); grid = -1; return; }
        if (hipFuncSetAttribute((const void*)mk_fwd, hipFuncAttributeMaxDynamicSharedMemorySize, LDS_BYTES) != hipSuccess) { fprintf(stderr, "kernel_launch: hipFuncSetAttribute failed\n"); grid = -1; return; }
        if (hipOccupancyMaxActiveBlocksPerMultiprocessor(&per_cu, (const void*)mk_fwd, NWAVES * 64, LDS_BYTES) != hipSuccess || per_cu < 1)
            fprintf(stderr, "kernel_launch: note: occupancy query reports %d workgroups per CU\n", per_cu);
        (void)hipGetLastError();
        grid = cus;
    }
    if (grid < 0) return;
    if (hipMemsetAsync((char*)d_ws + WS_CTL, 0, CTL_ZERO_BYTES, stream) != hipSuccess) { fprintf(stderr, "kernel_launch: memset failed\n"); return; }
    Args a{};
    for (int i = 0; i < 29; ++i) a.in[i] = (const float*)d_in[i];
    a.out = (float*)d_out; a.ws = (unsigned char*)d_ws;
#if MK_SINGLE
    a.ph_lo = 0; a.ph_hi = N_PHASES;
    hipLaunchKernelGGL(mk_fwd, dim3(grid), dim3(NWAVES * 64), LDS_BYTES, stream, a);
#else
    for (int p = 0; p < N_PHASES; ++p) {
        a.ph_lo = p; a.ph_hi = p + 1;
        hipLaunchKernelGGL(mk_fwd, dim3(grid), dim3(NWAVES * 64), LDS_BYTES, stream, a);
    }
#endif
    const hipError_t le = hipPeekAtLastError();
    if (le != hipSuccess) fprintf(stderr, "kernel_launch: launch failed: %s\n", hipGetErrorName(le));
}
```
